# Optimizing an MI355X kernel written in HIP

```python
import math
import jax
import jax.numpy as jnp
from jax import lax
import numpy as np

D_MODEL = 2048
BATCH = 8
SEQ = 4096
DEPTH = 1

HEAD_DIM = 128
D_MIX = D_MODEL
SB_HEADS = D_MIX // (2 * HEAD_DIM)
NSA_HEADS = D_MIX // (2 * HEAD_DIM)
NSA_KV_GROUPS = 2
NSA_GROUP_SIZE = NSA_HEADS // NSA_KV_GROUPS
SB_WIDTH = SB_HEADS * HEAD_DIM
NSA_WIDTH = NSA_HEADS * HEAD_DIM
NSA_KV_WIDTH = NSA_KV_GROUPS * HEAD_DIM
N_GATES = 3
CMP_STRIDE = 16
CMP_BLOCK = 2 * CMP_STRIDE
CMP_HIDDEN = 256
SEL_BLOCK = 64
SEL_TOP_N = 16
WINDOW = 512
SB_Q_BLOCK = 128
NSA_Q_BLOCK = 32
REL_BUCKETS = 32
REL_MAX_EXACT = 16
REL_MAX_DISTANCE = 1024
RMS_EPS = 1e-6
SEL_FORCE = 1e9
MASK_VALUE = -1e30
SPLIT_SIZES = (SB_WIDTH,) * 4 + (NSA_WIDTH,) + (NSA_KV_WIDTH,) * 6 + (N_GATES * NSA_HEADS, NSA_WIDTH)
D_IN_PROJ = sum(SPLIT_SIZES)

kernel_name = 'hybrid_stickbreaking_nsa_layer'


def rms_norm(x, g):
    xf = x.astype(jnp.float32)
    y = xf * lax.rsqrt(jnp.mean(xf * xf, axis=-1, keepdims=True) + RMS_EPS)
    return (y * g.astype(jnp.float32)).astype(x.dtype)


def rel_bucket(dist):
    n = jnp.maximum(dist, 0)
    nf = jnp.maximum(n, 1).astype(jnp.float32)
    large = REL_MAX_EXACT + (jnp.log(nf / REL_MAX_EXACT)
                             / math.log(REL_MAX_DISTANCE / REL_MAX_EXACT)
                             * (REL_BUCKETS - REL_MAX_EXACT)).astype(jnp.int32)
    large = jnp.minimum(large, REL_BUCKETS - 1)
    return jnp.where(n < REL_MAX_EXACT, n, large)


def masked_softmax(scores, mask):
    s = jnp.where(mask, scores.astype(jnp.float32), MASK_VALUE)
    return jnp.where(mask, jax.nn.softmax(s, axis=-1), 0.0)


def stick_breaking_attention(q, k, v):
    b, s, h, d = q.shape
    nqb = s // SB_Q_BLOCK
    q_blocks = q.reshape(b, nqb, SB_Q_BLOCK, h, d).transpose(1, 0, 2, 3, 4)
    vf = v.astype(jnp.float32)
    key_pos = jnp.arange(s)
    scale = 1.0 / math.sqrt(d)

    def block(args):
        q_blk, i = args
        t = i * SB_Q_BLOCK + jnp.arange(SB_Q_BLOCK)
        z = jnp.einsum('bthd,bshd->bhts', q_blk, k).astype(jnp.float32) * scale
        mask = key_pos[None, :] < t[:, None]
        log_beta = jax.nn.log_sigmoid(z)
        log_rest = jnp.where(mask, jax.nn.log_sigmoid(-z), 0.0)
        between = lax.cumsum(log_rest, axis=3, reverse=True) - log_rest
        a = jnp.where(mask, jnp.exp(log_beta + between), 0.0)
        return jnp.einsum('bhts,bshd->bthd', a, vf)

    out = lax.map(block, (q_blocks, jnp.arange(nqb)))
    return out.transpose(1, 0, 2, 3, 4).reshape(b, s, h * d).astype(q.dtype)


def compress_kv(kv, pos, w1, w2):
    b, s, g, d = kv.shape
    chunks = kv.reshape(b, s // CMP_STRIDE, CMP_STRIDE, g, d)
    blocks = jnp.concatenate([chunks[:, :-1], chunks[:, 1:]], axis=2)
    blocks = blocks + pos[None, None, :, None, :]
    hid = jax.nn.gelu(jnp.einsum('bnlgd,lde->bnge', blocks, w1))
    return jnp.einsum('bnge,ef->bngf', hid, w2)


def native_sparse_attention(q, k_cmp, v_cmp, k_sel, v_sel, k_win, v_win, gate_logits,
                            cmp_k_pos, cmp_k_w1, cmp_k_w2, cmp_v_pos, cmp_v_w1, cmp_v_w2,
                            rel_bias):
    b, s, g, r, d = q.shape
    scale = 1.0 / math.sqrt(d)
    kc = compress_kv(k_cmp, cmp_k_pos, cmp_k_w1, cmp_k_w2)
    vc = compress_kv(v_cmp, cmp_v_pos, cmp_v_w1, cmp_v_w2)
    nb = kc.shape[1]
    cmp_end = jnp.arange(nb) * CMP_STRIDE + CMP_BLOCK - 1
    nsel = s // SEL_BLOCK
    n_top = min(SEL_TOP_N, nsel)
    ci = np.arange(nb)[:, None] * CMP_STRIDE
    sj = np.arange(nsel)[None, :] * SEL_BLOCK
    overlap = jnp.asarray(((ci < sj + SEL_BLOCK) & (ci + CMP_BLOCK > sj)).astype(np.float32))
    ks_blocks = k_sel.reshape(b, nsel, SEL_BLOCK, g, d).transpose(0, 3, 1, 2, 4)
    vs_blocks = v_sel.reshape(b, nsel, SEL_BLOCK, g, d).transpose(0, 3, 1, 2, 4)
    kw_pad = jnp.pad(k_win, ((0, 0), (WINDOW, 0), (0, 0), (0, 0)))
    vw_pad = jnp.pad(v_win, ((0, 0), (WINDOW, 0), (0, 0), (0, 0)))
    win_len = NSA_Q_BLOCK + WINDOW
    bias_tbl = rel_bias.astype(jnp.float32).reshape(REL_BUCKETS, g, r).transpose(1, 2, 0)
    gather_blocks = jax.vmap(jax.vmap(lambda blk, idx: blk[idx]))

    nqb = s // NSA_Q_BLOCK
    q_blocks = q.reshape(b, nqb, NSA_Q_BLOCK, g, r, d).transpose(1, 0, 2, 3, 4, 5)
    g_blocks = gate_logits.reshape(b, nqb, NSA_Q_BLOCK, g, r, N_GATES).transpose(1, 0, 2, 3, 4, 5)

    def step(args):
        q_blk, g_blk, i = args
        start = i * NSA_Q_BLOCK
        t = start + jnp.arange(NSA_Q_BLOCK)
        bias_c = rel_bias[rel_bucket(t[:, None] - cmp_end[None, :])]
        bias_c = bias_c.transpose(2, 0, 1).reshape(g, r, NSA_Q_BLOCK, nb)
        sc = jnp.einsum('btgrd,bngd->bgrtn', q_blk, kc) * scale + bias_c
        p_c = masked_softmax(sc, cmp_end[None, :] <= t[:, None])
        o_c = jnp.einsum('bgrtn,bngd->btgrd', p_c, vc)
        imp = jnp.einsum('bgrtn,nj->bgtj', p_c, overlap)
        j = jnp.arange(nsel)[None, :]
        cur = (t // SEL_BLOCK)[:, None]
        valid = j * SEL_BLOCK <= t[:, None]
        forced = (j == 0) | (j == cur) | (j == cur - 1)
        score = jnp.where(valid, jnp.where(forced, SEL_FORCE, imp), -SEL_FORCE)
        _, idx = lax.top_k(score, n_top)
        ks_g = gather_blocks(ks_blocks, idx)
        vs_g = gather_blocks(vs_blocks, idx)
        key_pos = idx[..., None] * SEL_BLOCK + jnp.arange(SEL_BLOCK)
        dist = t[None, None, :, None, None] - key_pos
        bias_s = jnp.einsum('bgtnlk,grk->bgtrnl',
                            jax.nn.one_hot(rel_bucket(dist), REL_BUCKETS, dtype=jnp.float32), bias_tbl)
        ss = jnp.einsum('bgtrd,bgtnld->bgtrnl', q_blk.transpose(0, 2, 1, 3, 4), ks_g) * scale + bias_s
        n_keys = n_top * SEL_BLOCK
        p_s = masked_softmax(ss.reshape(b, g, NSA_Q_BLOCK, r, n_keys),
                             (dist >= 0).reshape(b, g, NSA_Q_BLOCK, 1, n_keys))
        o_s = jnp.einsum('bgtrm,bgtmd->btgrd', p_s, vs_g.reshape(b, g, NSA_Q_BLOCK, n_keys, d))
        kw = lax.dynamic_slice_in_dim(kw_pad, start, win_len, axis=1)
        vw = lax.dynamic_slice_in_dim(vw_pad, start, win_len, axis=1)
        win_pos = start - WINDOW + jnp.arange(win_len)
        diff = t[:, None] - win_pos[None, :]
        mask_w = (win_pos[None, :] >= 0) & (diff >= 0) & (diff < WINDOW)
        bias_w = rel_bias[rel_bucket(diff)].transpose(2, 0, 1).reshape(g, r, NSA_Q_BLOCK, win_len)
        sw = jnp.einsum('btgrd,bsgd->bgrts', q_blk, kw) * scale + bias_w
        p_w = masked_softmax(sw, mask_w)
        o_w = jnp.einsum('bgrts,bsgd->btgrd', p_w, vw)
        gate = jax.nn.sigmoid(g_blk.astype(jnp.float32))
        return gate[..., 0:1] * o_c + gate[..., 1:2] * o_s + gate[..., 2:3] * o_w

    out = lax.map(step, (q_blocks, g_blocks, jnp.arange(nqb)))
    return out.transpose(1, 0, 2, 3, 4, 5).reshape(b, s, g * r * d).astype(q.dtype)


def setup_inputs(seed: int = 0) -> dict:
    key = jax.random.key(seed)
    ks = jax.random.split(key, 16)
    f32 = jnp.float32
    nrm = lambda k, shape, sc: jax.random.normal(k, shape, f32) * sc
    return {
        'x': nrm(ks[0], (BATCH, SEQ, D_MODEL), 1.0),
        'norm_in': 1.0 + nrm(ks[1], (DEPTH, D_MODEL), 0.05),
        'w_in': nrm(ks[2], (DEPTH, D_MODEL, D_IN_PROJ), D_MODEL ** -0.5),
        'cmp_k_pos': nrm(ks[3], (DEPTH, CMP_BLOCK, HEAD_DIM), 0.5),
        'cmp_k_w1': nrm(ks[4], (DEPTH, CMP_BLOCK, HEAD_DIM, CMP_HIDDEN), (CMP_BLOCK * HEAD_DIM) ** -0.5),
        'cmp_k_w2': nrm(ks[5], (DEPTH, CMP_HIDDEN, HEAD_DIM), CMP_HIDDEN ** -0.5),
        'cmp_v_pos': nrm(ks[6], (DEPTH, CMP_BLOCK, HEAD_DIM), 0.5),
        'cmp_v_w1': nrm(ks[7], (DEPTH, CMP_BLOCK, HEAD_DIM, CMP_HIDDEN), (CMP_BLOCK * HEAD_DIM) ** -0.5),
        'cmp_v_w2': nrm(ks[8], (DEPTH, CMP_HIDDEN, HEAD_DIM), CMP_HIDDEN ** -0.5),
        'rel_bias': nrm(ks[9], (REL_BUCKETS, NSA_HEADS), 0.5),
        'norm_sb': 1.0 + nrm(ks[10], (DEPTH, SB_WIDTH), 0.05),
        'norm_nsa': 1.0 + nrm(ks[11], (DEPTH, NSA_WIDTH), 0.05),
        'w_out': nrm(ks[12], (DEPTH, D_MIX, D_MODEL), D_MIX ** -0.5),
        'norm_final': 1.0 + nrm(ks[13], (D_MODEL,), 0.05),
    }


def reference(x, norm_in, w_in, cmp_k_pos, cmp_k_w1, cmp_k_w2, cmp_v_pos, cmp_v_w1, cmp_v_w2,
              rel_bias, norm_sb, norm_nsa, w_out, norm_final):
    b, s, _ = x.shape
    split_points = [int(p) for p in np.cumsum(SPLIT_SIZES)[:-1]]
    g, r = NSA_KV_GROUPS, NSA_GROUP_SIZE
    h = x
    for layer in range(DEPTH):
        xn = rms_norm(h, norm_in[layer])
        proj = xn @ w_in[layer]
        (sb_q, sb_k, sb_v, sb_z, n_q, n_kc, n_vc, n_ks, n_vs, n_kw, n_vw,
         n_gate, n_z) = jnp.split(proj, split_points, axis=-1)
        sb_heads = lambda a: a.reshape(b, s, SB_HEADS, HEAD_DIM)
        kv_heads = lambda a: a.reshape(b, s, g, HEAD_DIM)
        o_sb = stick_breaking_attention(sb_heads(sb_q), sb_heads(sb_k), sb_heads(sb_v))
        o_nsa = native_sparse_attention(
            n_q.reshape(b, s, g, r, HEAD_DIM), kv_heads(n_kc), kv_heads(n_vc), kv_heads(n_ks),
            kv_heads(n_vs), kv_heads(n_kw), kv_heads(n_vw), n_gate.reshape(b, s, g, r, N_GATES),
            cmp_k_pos[layer], cmp_k_w1[layer], cmp_k_w2[layer],
            cmp_v_pos[layer], cmp_v_w1[layer], cmp_v_w2[layer], rel_bias)
        y_sb = rms_norm(o_sb, norm_sb[layer]) * jax.nn.silu(sb_z)
        y_nsa = rms_norm(o_nsa, norm_nsa[layer]) * jax.nn.silu(n_z)
        h = h + jnp.concatenate([y_sb, y_nsa], axis=-1) @ w_out[layer]
    return rms_norm(h, norm_final)
```

```cpp
#include <hip/hip_runtime.h>
#include <cstdio>
#include <cstdint>

typedef _Float16 h16;
typedef unsigned long long u64;

constexpr int NB = 8, S = 4096, D = 2048, M = NB * S;
constexpr int HD = 128, NHEAD = 8, NG = 2, NR = 4;
constexpr int NPROJ = 7704, LDP = 7936;
constexpr int C_SBQ = 0, C_SBK = 1024, C_SBV = 2048, C_SBZ = 3072, C_NQ = 4096, C_KC = 5120, C_VC = 5376, C_KS = 5632, C_VS = 5888,
              C_KW = 6144, C_VW = 6400, C_NZ = 6656, C_GATE = 7680;
constexpr int NCB = 255, NCBP = 256;
constexpr float RMS_EPS = 1e-6f;

constexpr size_t MiB = 1u << 20;
constexpr size_t WS_CTL = 0;
constexpr size_t WS_XN = 1 * MiB;
constexpr size_t WS_WINT = WS_XN + (size_t)M * D * 2;
constexpr size_t WS_WOUTT = WS_WINT + (size_t)LDP * D * 2;
constexpr size_t WS_PROJ = WS_WOUTT + (size_t)D * D * 2;
constexpr size_t WS_KCC = WS_PROJ + (size_t)M * LDP * 2;
constexpr size_t WS_VCC = WS_KCC + (size_t)NB * NG * NCBP * HD * 2;
constexpr size_t WS_SEL = WS_VCC + (size_t)NB * NG * NCBP * HD * 2;
constexpr size_t WS_OC = WS_SEL + (size_t)M * NG * 8;
constexpr size_t WS_END = WS_OC + (size_t)M * 1024 * 4;

__device__ __forceinline__ int src_col(int c) { return c < 6656 ? c : (c < 7680 ? c + 24 : (c < NPROJ ? c - 1024 : -1)); }

__device__ __forceinline__ int rel_bucket(int dist) {
    if (dist < 16) return dist < 0 ? 0 : dist;
    int b = 16;
    b += dist >= 21; b += dist >= 27; b += dist >= 35; b += dist >= 46; b += dist >= 59; b += dist >= 77; b += dist >= 99; b += dist >= 128;
    b += dist >= 166; b += dist >= 216; b += dist >= 280; b += dist >= 363; b += dist >= 470; b += dist >= 609; b += dist >= 790;
    return b;
}
__device__ __forceinline__ float wave_sum(float v) {
#pragma unroll
    for (int o = 1; o < 64; o <<= 1) v += __shfl_xor(v, o);
    return v;
}
__device__ __forceinline__ float wave_max(float v) {
#pragma unroll
    for (int o = 1; o < 64; o <<= 1) v = fmaxf(v, __shfl_xor(v, o));
    return v;
}

__global__ void __launch_bounds__(256) k_rmsnorm_in(const float* __restrict__ x, const float* __restrict__ g, h16* __restrict__ xn) {
    const int lane = threadIdx.x & 63, w = (blockIdx.x * blockDim.x + threadIdx.x) >> 6, nw = (gridDim.x * blockDim.x) >> 6;
    for (int m = w; m < M; m += nw) {
        const float4* xr = (const float4*)(x + (size_t)m * D);
        float4 v[8]; float s = 0.f;
#pragma unroll
        for (int j = 0; j < 8; ++j) { v[j] = xr[lane + 64 * j]; s += v[j].x * v[j].x + v[j].y * v[j].y + v[j].z * v[j].z + v[j].w * v[j].w; }
        const float r = rsqrtf(wave_sum(s) * (1.f / D) + RMS_EPS);
#pragma unroll
        for (int j = 0; j < 8; ++j) {
            const float4 gg = ((const float4*)g)[lane + 64 * j];
            h16* o = xn + (size_t)m * D + 4 * (lane + 64 * j);
            o[0] = (h16)(v[j].x * r * gg.x); o[1] = (h16)(v[j].y * r * gg.y); o[2] = (h16)(v[j].z * r * gg.z); o[3] = (h16)(v[j].w * r * gg.w);
        }
    }
}
__global__ void __launch_bounds__(256) k_transpose_w(const float* __restrict__ W, h16* __restrict__ WT, int K, int ldw, int N_out, int remap) {
    __shared__ float t[32][33];
    const int k0 = blockIdx.x * 32, n0 = blockIdx.y * 32, tx = threadIdx.x & 31, ty = threadIdx.x >> 5;
    for (int i = ty; i < 32; i += 8) { const int n = n0 + tx; const int sc = remap ? src_col(n) : n; t[i][tx] = (sc >= 0) ? W[(size_t)(k0 + i) * ldw + sc] : 0.f; }
    __syncthreads();
    for (int i = ty; i < 32; i += 8) WT[(size_t)(n0 + i) * K + k0 + tx] = (h16)t[tx][i];
}

template <int MODE>
__global__ void __launch_bounds__(256) k_gemm_naive(const h16* __restrict__ A, const h16* __restrict__ Bt, void* __restrict__ Cv, const float* __restrict__ resid, int K, int ldc) {
    __shared__ float As[32][68], Bs[32][68];
    const int tx = threadIdx.x & 15, ty = threadIdx.x >> 4, m0 = blockIdx.y * 64, n0 = blockIdx.x * 64;
    float acc[4][4] = {};
    for (int k0 = 0; k0 < K; k0 += 32) {
        for (int i = threadIdx.x; i < 64 * 32; i += 256) { const int r = i >> 5, c = i & 31; As[c][r] = (float)A[(size_t)(m0 + r) * K + k0 + c]; Bs[c][r] = (float)Bt[(size_t)(n0 + r) * K + k0 + c]; }
        __syncthreads();
#pragma unroll 8
        for (int kk = 0; kk < 32; ++kk) {
            const float4 a = *(const float4*)&As[kk][ty * 4], b = *(const float4*)&Bs[kk][tx * 4];
            const float av[4] = {a.x, a.y, a.z, a.w}, bv[4] = {b.x, b.y, b.z, b.w};
#pragma unroll
            for (int i = 0; i < 4; ++i)
#pragma unroll
                for (int j = 0; j < 4; ++j) acc[i][j] += av[i] * bv[j];
        }
        __syncthreads();
    }
#pragma unroll
    for (int i = 0; i < 4; ++i)
#pragma unroll
        for (int j = 0; j < 4; ++j) {
            const size_t o = (size_t)(m0 + ty * 4 + i) * ldc + n0 + tx * 4 + j;
            if (MODE == 0) ((h16*)Cv)[o] = (h16)acc[i][j]; else ((float*)Cv)[o] = resid[o] + acc[i][j];
        }
}

__global__ void __launch_bounds__(256) k_compress(const h16* __restrict__ proj, const float* __restrict__ posk, const float* __restrict__ w1k, const float* __restrict__ w2k,
                                                  const float* __restrict__ posv, const float* __restrict__ w1v, const float* __restrict__ w2v, h16* __restrict__ kcc, h16* __restrict__ vcc) {
    __shared__ float in[32 * 128]; __shared__ float hid[256];
    const int n = blockIdx.x, g = blockIdx.y & 1, kv = blockIdx.y >> 1, b = blockIdx.z, e = threadIdx.x;
    const float* pos = kv ? posv : posk; const float* w1 = kv ? w1v : w1k; const float* w2 = kv ? w2v : w2k; h16* out = kv ? vcc : kcc;
    const int col0 = (kv ? C_VC : C_KC) + g * HD;
    for (int i = e; i < 32 * 128; i += 256) { const int l = i >> 7, d = i & 127; in[i] = (float)proj[(size_t)(b * S + 16 * n + l) * LDP + col0 + d] + pos[i]; }
    __syncthreads();
    float acc = 0.f;
    for (int i = 0; i < 32 * 128; ++i) acc += in[i] * w1[(size_t)i * 256 + e];
    const float u = 0.7978845608028654f * (acc + 0.044715f * acc * acc * acc);
    hid[e] = 0.5f * acc * (1.f + tanhf(u));
    __syncthreads();
    if (e < 128) { float o = 0.f; for (int i = 0; i < 256; ++i) o += hid[i] * w2[i * 128 + e]; out[((size_t)(b * NG + g) * NCBP + n) * HD + e] = (h16)o; }
}

__global__ void __launch_bounds__(64) k_nsa_cmp(const h16* __restrict__ proj, const h16* __restrict__ kcc, const h16* __restrict__ vcc, const float* __restrict__ rel_bias,
                                                float* __restrict__ oc, u64* __restrict__ sel) {
    __shared__ float q[128]; __shared__ float P[4][256];
    const int t = blockIdx.x, g = blockIdx.y, b = blockIdx.z, lane = threadIdx.x; const size_t m = (size_t)b * S + t;
    const int nvalid = t < 31 ? 0 : min((t - 31) / 16 + 1, NCB);
    const h16* kc = kcc + (size_t)(b * NG + g) * NCBP * HD; const h16* vc = vcc + (size_t)(b * NG + g) * NCBP * HD;
    for (int r = 0; r < 4; ++r) {
        const int hh = g * 4 + r;
        __syncthreads();
        q[lane] = (float)proj[m * LDP + C_NQ + hh * HD + lane]; q[lane + 64] = (float)proj[m * LDP + C_NQ + hh * HD + lane + 64];
        __syncthreads();
        float sc[4]; float mx = -1e30f;
#pragma unroll
        for (int i = 0; i < 4; ++i) { const int n = lane + 64 * i; sc[i] = -1e30f;
            if (n < nvalid) { float s = 0.f; for (int d = 0; d < 128; ++d) s += q[d] * (float)kc[(size_t)n * HD + d];
                sc[i] = s * 0.08838834764831845f + rel_bias[rel_bucket(t - (16 * n + 31)) * NHEAD + hh]; }
            mx = fmaxf(mx, sc[i]); }
        mx = wave_max(mx); float l = 0.f;
#pragma unroll
        for (int i = 0; i < 4; ++i) { const int n = lane + 64 * i; sc[i] = (n < nvalid) ? __expf(sc[i] - mx) : 0.f; l += sc[i]; }
        l = wave_sum(l); const float inv = nvalid > 0 ? 1.f / l : 0.f;
#pragma unroll
        for (int i = 0; i < 4; ++i) P[r][lane + 64 * i] = sc[i] * inv;
        __syncthreads();
        float o0 = 0.f, o1 = 0.f;
        for (int n = 0; n < nvalid; ++n) { const float p = P[r][n]; o0 += p * (float)vc[(size_t)n * HD + lane]; o1 += p * (float)vc[(size_t)n * HD + lane + 64]; }
        oc[m * 1024 + hh * HD + lane] = o0; oc[m * 1024 + hh * HD + lane + 64] = o1;
    }
    __syncthreads();
    const int j = lane; float imp = 0.f;
    for (int r = 0; r < 4; ++r) for (int n = 4 * j - 1; n <= 4 * j + 3; ++n) if (n >= 0 && n < NCB) imp += P[r][n];
    const int cur = t >> 6; const bool valid = j * 64 <= t, forced = (j == 0) || (j == cur) || (j == cur - 1);
    const float score = valid ? (forced ? 1e9f : imp) : -1e9f;
    int rank = 0;
    for (int i = 0; i < 64; ++i) { const float si = __shfl(score, i); rank += (si > score) || (si == score && i < j); }
    const u64 mask = __ballot(rank < 16);
    if (lane == 0) sel[m * NG + g] = mask;
}

__global__ void __launch_bounds__(128) k_nsa_selwin(const h16* __restrict__ proj, const float* __restrict__ rel_bias, const u64* __restrict__ sel, const float* __restrict__ oc, float* __restrict__ onsa) {
    __shared__ h16 Kt[64 * 128]; __shared__ h16 Vt[64 * 128]; __shared__ float bt[1024];
    const int cur = blockIdx.x, hh = blockIdx.y, b = blockIdx.z, g = hh >> 2, tid = threadIdx.x, t = cur * 64 + (tid >> 1), d0 = (tid & 1) * 64; const size_t m = (size_t)b * S + t;
    for (int i = tid; i < 1024; i += 128) bt[i] = rel_bias[rel_bucket(i) * NHEAD + hh];
    __syncthreads();
    float q[64];
#pragma unroll
    for (int d = 0; d < 64; ++d) q[d] = (float)proj[m * LDP + C_NQ + hh * HD + d0 + d] * 0.08838834764831845f;
    const u64 mysel = sel[m * NG + g];
    const float g0 = 1.f / (1.f + __expf(-(float)proj[m * LDP + C_GATE + hh * 3 + 0])), g1 = 1.f / (1.f + __expf(-(float)proj[m * LDP + C_GATE + hh * 3 + 1])), g2 = 1.f / (1.f + __expf(-(float)proj[m * LDP + C_GATE + hh * 3 + 2]));
    for (int br = 0; br < 2; ++br) {
        float o[64];
#pragma unroll
        for (int d = 0; d < 64; ++d) o[d] = 0.f;
        float mx = -1e30f, l = 0.f;
        const int kcol = (br ? C_KW : C_KS) + g * HD, vcol = (br ? C_VW : C_VS) + g * HD;
        const int j0 = br ? max(0, cur - 8) : 0;
        for (int j = j0; j <= cur; ++j) {
            const bool act = br ? true : ((mysel >> j) & 1ull) != 0ull;
            if (!__syncthreads_or(act ? 1 : 0)) continue;
            for (int i = tid; i < 64 * 128 / 8; i += 128) { const int r = i >> 4, c = (i & 15) * 8; const size_t row = (size_t)(b * S + j * 64 + r) * LDP;
                *(uint4*)&Kt[r * 128 + c] = *(const uint4*)&proj[row + kcol + c]; *(uint4*)&Vt[r * 128 + c] = *(const uint4*)&proj[row + vcol + c]; }
            __syncthreads();
            for (int c0 = 0; c0 < 64; c0 += 16) {
                float sc[16]; float cm = -1e30f;
#pragma unroll
                for (int kk = 0; kk < 16; ++kk) { const int pos = j * 64 + c0 + kk, dist = t - pos; const bool ok = act && dist >= 0 && (br == 0 || dist < 512);
                    float s = 0.f;
#pragma unroll
                    for (int d = 0; d < 64; ++d) s += q[d] * (float)Kt[(c0 + kk) * 128 + d0 + d];
                    s += __shfl_xor(s, 1);
                    s += bt[min(max(dist, 0), 1023)];
                    sc[kk] = ok ? s : -1e30f; cm = fmaxf(cm, sc[kk]); }
                if (cm > -1e29f) {
                    const float mn = fmaxf(mx, cm), al = __expf(mx - mn); mx = mn; l *= al;
#pragma unroll
                    for (int d = 0; d < 64; ++d) o[d] *= al;
#pragma unroll
                    for (int kk = 0; kk < 16; ++kk) { const float p = sc[kk] > -1e29f ? __expf(sc[kk] - mn) : 0.f; l += p;
#pragma unroll
                        for (int d = 0; d < 64; ++d) o[d] += p * (float)Vt[(c0 + kk) * 128 + d0 + d]; }
                }
            }
        }
        const float inv = 1.f / l;
        float* dst = onsa + m * 1024 + hh * HD + d0; const float* ocr = oc + m * 1024 + hh * HD + d0;
        if (br == 0) {
#pragma unroll
            for (int d = 0; d < 64; ++d) dst[d] = g0 * ocr[d] + g1 * o[d] * inv;
        } else {
#pragma unroll
            for (int d = 0; d < 64; ++d) dst[d] += g2 * o[d] * inv;
        }
    }
}

__global__ void __launch_bounds__(128) k_sb_naive(const h16* __restrict__ proj, float* __restrict__ osb) {
    __shared__ h16 Kt[64 * 128]; __shared__ h16 Vt[64 * 128];
    const int cur = blockIdx.x, h = blockIdx.y, b = blockIdx.z, tid = threadIdx.x, t = cur * 64 + (tid >> 1), d0 = (tid & 1) * 64; const size_t m = (size_t)b * S + t;
    float q[64], o[64];
#pragma unroll
    for (int d = 0; d < 64; ++d) { q[d] = (float)proj[m * LDP + C_SBQ + h * HD + d0 + d] * 0.08838834764831845f; o[d] = 0.f; }
    float cum = 0.f;
    for (int j = cur; j >= 0; --j) {
        __syncthreads();
        for (int i = tid; i < 64 * 128 / 8; i += 128) { const int r = i >> 4, c = (i & 15) * 8; const size_t row = (size_t)(b * S + j * 64 + r) * LDP;
            *(uint4*)&Kt[r * 128 + c] = *(const uint4*)&proj[row + C_SBK + h * HD + c]; *(uint4*)&Vt[r * 128 + c] = *(const uint4*)&proj[row + C_SBV + h * HD + c]; }
        __syncthreads();
        for (int kk = 63; kk >= 0; --kk) {
            const int pos = j * 64 + kk;
            float z = 0.f;
#pragma unroll
            for (int d = 0; d < 64; ++d) z += q[d] * (float)Kt[kk * 128 + d0 + d];
            z += __shfl_xor(z, 1);
            const float sp = fmaxf(z, 0.f) + log1pf(__expf(-fabsf(z)));
            const float log_rest = -sp, log_beta = z - sp;
            const float a = (pos < t) ? __expf(log_beta + cum) : 0.f;
            if (pos < t) cum += log_rest;
#pragma unroll
            for (int d = 0; d < 64; ++d) o[d] += a * (float)Vt[kk * 128 + d0 + d];
        }
    }
#pragma unroll
    for (int d = 0; d < 64; ++d) osb[m * 1024 + h * HD + d0 + d] = o[d];
}

__global__ void __launch_bounds__(256) k_make_y(const float* __restrict__ osb, const float* __restrict__ onsa, const h16* __restrict__ proj, const float* __restrict__ gsb, const float* __restrict__ gnsa, h16* __restrict__ y) {
    const int lane = threadIdx.x & 63, w = (blockIdx.x * blockDim.x + threadIdx.x) >> 6, nw = (gridDim.x * blockDim.x) >> 6;
    for (int i = w; i < 2 * M; i += nw) {
        const int m = i >> 1, part = i & 1;
        const float* src = (part ? onsa : osb) + (size_t)m * 1024; const float* gg = part ? gnsa : gsb; const h16* zz = proj + (size_t)m * LDP + (part ? C_NZ : C_SBZ);
        float v[16]; float s = 0.f;
#pragma unroll
        for (int j = 0; j < 16; ++j) { v[j] = src[lane + 64 * j]; s += v[j] * v[j]; }
        const float r = rsqrtf(wave_sum(s) * (1.f / 1024.f) + RMS_EPS);
#pragma unroll
        for (int j = 0; j < 16; ++j) { const int c = lane + 64 * j; const float z = (float)zz[c]; y[(size_t)m * D + part * 1024 + c] = (h16)(v[j] * r * gg[c] * (z / (1.f + __expf(-z)))); }
    }
}
__global__ void __launch_bounds__(256) k_final_norm(float* __restrict__ out, const float* __restrict__ g) {
    const int lane = threadIdx.x & 63, w = (blockIdx.x * blockDim.x + threadIdx.x) >> 6, nw = (gridDim.x * blockDim.x) >> 6;
    for (int m = w; m < M; m += nw) {
        float4* xr = (float4*)(out + (size_t)m * D);
        float4 v[8]; float s = 0.f;
#pragma unroll
        for (int j = 0; j < 8; ++j) { v[j] = xr[lane + 64 * j]; s += v[j].x * v[j].x + v[j].y * v[j].y + v[j].z * v[j].z + v[j].w * v[j].w; }
        const float r = rsqrtf(wave_sum(s) * (1.f / D) + RMS_EPS);
#pragma unroll
        for (int j = 0; j < 8; ++j) { const float4 gg = ((const float4*)g)[lane + 64 * j]; xr[lane + 64 * j] = make_float4(v[j].x * r * gg.x, v[j].y * r * gg.y, v[j].z * r * gg.z, v[j].w * r * gg.w); }
    }
}

extern "C" void kernel_launch(void* const* d_in, const int* in_sizes, int n_in, void* d_out, int out_size, void* d_ws, size_t ws_size, hipStream_t stream) {
    if (n_in != 14 || in_sizes[0] != M * D || out_size != M * D || ws_size < WS_END) { fprintf(stderr, "kernel_launch: unexpected shapes (n_in %d in0 %d out %d ws %zu need %zu)\n", n_in, n_in > 0 ? in_sizes[0] : -1, out_size, ws_size, (size_t)WS_END); return; }
    const float* x = (const float*)d_in[0]; const float* norm_in = (const float*)d_in[1]; const float* w_in = (const float*)d_in[2];
    const float* kpos = (const float*)d_in[3]; const float* kw1 = (const float*)d_in[4]; const float* kw2 = (const float*)d_in[5];
    const float* vpos = (const float*)d_in[6]; const float* vw1 = (const float*)d_in[7]; const float* vw2 = (const float*)d_in[8];
    const float* rel_bias = (const float*)d_in[9]; const float* norm_sb = (const float*)d_in[10]; const float* norm_nsa = (const float*)d_in[11];
    const float* w_out = (const float*)d_in[12]; const float* norm_final = (const float*)d_in[13];
    unsigned char* ws = (unsigned char*)d_ws; float* out = (float*)d_out;
    h16* XN = (h16*)(ws + WS_XN); h16* WINT = (h16*)(ws + WS_WINT); h16* WOUTT = (h16*)(ws + WS_WOUTT); h16* PROJ = (h16*)(ws + WS_PROJ);
    h16* KCC = (h16*)(ws + WS_KCC); h16* VCC = (h16*)(ws + WS_VCC); u64* SEL = (u64*)(ws + WS_SEL); float* OC = (float*)(ws + WS_OC);
    float* OSB = out; float* ONSA = out + (size_t)M * 1024;

    k_rmsnorm_in<<<2048, 256, 0, stream>>>(x, norm_in, XN);
    k_transpose_w<<<dim3(D / 32, LDP / 32), 256, 0, stream>>>(w_in, WINT, D, NPROJ, LDP, 1);
    k_transpose_w<<<dim3(D / 32, D / 32), 256, 0, stream>>>(w_out, WOUTT, D, D, D, 0);
    k_gemm_naive<0><<<dim3(LDP / 64, M / 64), 256, 0, stream>>>(XN, WINT, PROJ, nullptr, D, LDP);
    k_compress<<<dim3(NCB, 4, NB), 256, 0, stream>>>(PROJ, kpos, kw1, kw2, vpos, vw1, vw2, KCC, VCC);
    k_sb_naive<<<dim3(S / 64, NHEAD, NB), 128, 0, stream>>>(PROJ, OSB);
    k_nsa_cmp<<<dim3(S, NG, NB), 64, 0, stream>>>(PROJ, KCC, VCC, rel_bias, OC, SEL);
    k_nsa_selwin<<<dim3(S / 64, NHEAD, NB), 128, 0, stream>>>(PROJ, rel_bias, SEL, OC, ONSA);
    k_make_y<<<2048, 256, 0, stream>>>(OSB, ONSA, PROJ, norm_sb, norm_nsa, XN  );
    k_gemm_naive<1><<<dim3(D / 64, M / 64), 256, 0, stream>>>(XN, WOUTT, out, x, D, D);
    k_final_norm<<<2048, 256, 0, stream>>>(out, norm_final);
}
```

```cpp
#include <hip/hip_runtime.h>
#include <cstdio>
#include <cstdint>

typedef _Float16 h16;
typedef unsigned long long u64;

constexpr int NB = 8, S = 4096, D = 2048, M = NB * S;
constexpr int HD = 128, NHEAD = 8, NG = 2, NR = 4;
constexpr int NPROJ = 7704, LDP = 7936;
constexpr int C_SBQ = 0, C_SBK = 1024, C_SBV = 2048, C_SBZ = 3072, C_NQ = 4096, C_KC = 5120, C_VC = 5376, C_KS = 5632, C_VS = 5888,
              C_KW = 6144, C_VW = 6400, C_NZ = 6656, C_GATE = 7680;
constexpr int NCB = 255, NCBP = 256;
constexpr float RMS_EPS = 1e-6f;
constexpr float QSCALE = 0.08838834764831845f * 1.4426950408889634f;
constexpr float QMUL = 0.6931471805599453f;

constexpr size_t MiB = 1u << 20;
constexpr size_t WS_CTL = 0;
constexpr size_t WS_XN = 1 * MiB;
constexpr size_t WS_WINT = WS_XN + (size_t)M * D * 2;
constexpr size_t WS_WOUTT = WS_WINT + (size_t)LDP * D * 2;
constexpr size_t WS_PROJ = WS_WOUTT + (size_t)D * D * 2;
constexpr size_t WS_KCC = WS_PROJ + (size_t)M * LDP * 2;
constexpr size_t WS_VCC = WS_KCC + (size_t)NB * NG * NCBP * HD * 2;
constexpr size_t WS_SEL = WS_VCC + (size_t)NB * NG * NCBP * HD * 2;
constexpr size_t WS_OC = WS_SEL + (size_t)M * NG * 8;
constexpr size_t WS_SSQ = WS_OC + (size_t)M * 1024 * 4;
constexpr size_t WS_END = WS_SSQ + (size_t)M * 32 * 4;

__device__ __forceinline__ int src_col(int c) { return c < 6656 ? c : (c < 7680 ? c + 24 : (c < NPROJ ? c - 1024 : -1)); }

__device__ __forceinline__ int rel_bucket(int dist) {
    if (dist < 16) return dist < 0 ? 0 : dist;
    int b = 16;
    b += dist >= 21; b += dist >= 27; b += dist >= 35; b += dist >= 46; b += dist >= 59; b += dist >= 77; b += dist >= 99; b += dist >= 128;
    b += dist >= 166; b += dist >= 216; b += dist >= 280; b += dist >= 363; b += dist >= 470; b += dist >= 609; b += dist >= 790;
    return b;
}
__device__ __forceinline__ float wave_sum(float v) {
#pragma unroll
    for (int o = 1; o < 64; o <<= 1) v += __shfl_xor(v, o);
    return v;
}
__device__ __forceinline__ float wave_max(float v) {
#pragma unroll
    for (int o = 1; o < 64; o <<= 1) v = fmaxf(v, __shfl_xor(v, o));
    return v;
}

__global__ void __launch_bounds__(256) k_rmsnorm_in(const float* __restrict__ x, const float* __restrict__ g, h16* __restrict__ xn) {
    const int lane = threadIdx.x & 63, w = (blockIdx.x * blockDim.x + threadIdx.x) >> 6, nw = (gridDim.x * blockDim.x) >> 6;
    for (int m = w; m < M; m += nw) {
        const float4* xr = (const float4*)(x + (size_t)m * D);
        float4 v[8]; float s = 0.f;
#pragma unroll
        for (int j = 0; j < 8; ++j) { v[j] = xr[lane + 64 * j]; s += v[j].x * v[j].x + v[j].y * v[j].y + v[j].z * v[j].z + v[j].w * v[j].w; }
        const float r = rsqrtf(wave_sum(s) * (1.f / D) + RMS_EPS);
#pragma unroll
        for (int j = 0; j < 8; ++j) {
            const float4 gg = ((const float4*)g)[lane + 64 * j];
            h16* o = xn + (size_t)m * D + 4 * (lane + 64 * j);
            o[0] = (h16)(v[j].x * r * gg.x); o[1] = (h16)(v[j].y * r * gg.y); o[2] = (h16)(v[j].z * r * gg.z); o[3] = (h16)(v[j].w * r * gg.w);
        }
    }
}
__global__ void __launch_bounds__(256) k_transpose_w(const float* __restrict__ W, h16* __restrict__ WT, int K, int ldw, int N_out, int remap) {
    __shared__ float t[32][33];
    const int k0 = blockIdx.x * 32, n0 = blockIdx.y * 32, tx = threadIdx.x & 31, ty = threadIdx.x >> 5;
    for (int i = ty; i < 32; i += 8) { const int n = n0 + tx; const int sc = remap ? src_col(n) : n; t[i][tx] = (sc >= 0) ? W[(size_t)(k0 + i) * ldw + sc] : 0.f; }
    __syncthreads();
    for (int i = ty; i < 32; i += 8) WT[(size_t)(n0 + i) * K + k0 + tx] = (h16)t[tx][i];
}

template <int MODE>
__global__ void __launch_bounds__(256) k_gemm_naive(const h16* __restrict__ A, const h16* __restrict__ Bt, void* __restrict__ Cv, const float* __restrict__ resid, int K, int ldc) {
    __shared__ float As[32][68], Bs[32][68];
    const int tx = threadIdx.x & 15, ty = threadIdx.x >> 4, m0 = blockIdx.y * 64, n0 = blockIdx.x * 64;
    float acc[4][4] = {};
    for (int k0 = 0; k0 < K; k0 += 32) {
        for (int i = threadIdx.x; i < 64 * 32; i += 256) { const int r = i >> 5, c = i & 31; As[c][r] = (float)A[(size_t)(m0 + r) * K + k0 + c]; Bs[c][r] = (float)Bt[(size_t)(n0 + r) * K + k0 + c]; }
        __syncthreads();
#pragma unroll 8
        for (int kk = 0; kk < 32; ++kk) {
            const float4 a = *(const float4*)&As[kk][ty * 4], b = *(const float4*)&Bs[kk][tx * 4];
            const float av[4] = {a.x, a.y, a.z, a.w}, bv[4] = {b.x, b.y, b.z, b.w};
#pragma unroll
            for (int i = 0; i < 4; ++i)
#pragma unroll
                for (int j = 0; j < 4; ++j) acc[i][j] += av[i] * bv[j];
        }
        __syncthreads();
    }
#pragma unroll
    for (int i = 0; i < 4; ++i)
#pragma unroll
        for (int j = 0; j < 4; ++j) {
            const size_t o = (size_t)(m0 + ty * 4 + i) * ldc + n0 + tx * 4 + j;
            if (MODE == 0) ((h16*)Cv)[o] = (h16)acc[i][j]; else ((float*)Cv)[o] = resid[o] + acc[i][j];
        }
}

__global__ void __launch_bounds__(256) k_compress(const h16* __restrict__ proj, const float* __restrict__ posk, const float* __restrict__ w1k, const float* __restrict__ w2k,
                                                  const float* __restrict__ posv, const float* __restrict__ w1v, const float* __restrict__ w2v, h16* __restrict__ kcc, h16* __restrict__ vcc) {
    __shared__ float in[32 * 128]; __shared__ float hid[256];
    const int n = blockIdx.x, g = blockIdx.y & 1, kv = blockIdx.y >> 1, b = blockIdx.z, e = threadIdx.x;
    const float* pos = kv ? posv : posk; const float* w1 = kv ? w1v : w1k; const float* w2 = kv ? w2v : w2k; h16* out = kv ? vcc : kcc;
    const int col0 = (kv ? C_VC : C_KC) + g * HD;
    for (int i = e; i < 32 * 128; i += 256) { const int l = i >> 7, d = i & 127; in[i] = (float)proj[(size_t)(b * S + 16 * n + l) * LDP + col0 + d] + pos[i]; }
    __syncthreads();
    float acc = 0.f;
    for (int i = 0; i < 32 * 128; ++i) acc += in[i] * w1[(size_t)i * 256 + e];
    const float u = 0.7978845608028654f * (acc + 0.044715f * acc * acc * acc);
    hid[e] = 0.5f * acc * (1.f + tanhf(u));
    __syncthreads();
    if (e < 128) { float o = 0.f; for (int i = 0; i < 256; ++i) o += hid[i] * w2[i * 128 + e]; out[((size_t)(b * NG + g) * NCBP + n) * HD + e] = (h16)o; }
}

__global__ void __launch_bounds__(64) k_nsa_cmp(const h16* __restrict__ proj, const h16* __restrict__ kcc, const h16* __restrict__ vcc, const float* __restrict__ rel_bias,
                                                float* __restrict__ oc, u64* __restrict__ sel) {
    __shared__ float q[128]; __shared__ float P[4][256];
    const int t = blockIdx.x, g = blockIdx.y, b = blockIdx.z, lane = threadIdx.x; const size_t m = (size_t)b * S + t;
    const int nvalid = t < 31 ? 0 : min((t - 31) / 16 + 1, NCB);
    const h16* kc = kcc + (size_t)(b * NG + g) * NCBP * HD; const h16* vc = vcc + (size_t)(b * NG + g) * NCBP * HD;
    for (int r = 0; r < 4; ++r) {
        const int hh = g * 4 + r;
        __syncthreads();
        q[lane] = (float)proj[m * LDP + C_NQ + hh * HD + lane]; q[lane + 64] = (float)proj[m * LDP + C_NQ + hh * HD + lane + 64];
        __syncthreads();
        float sc[4]; float mx = -1e30f;
#pragma unroll
        for (int i = 0; i < 4; ++i) { const int n = lane + 64 * i; sc[i] = -1e30f;
            if (n < nvalid) { float s = 0.f; for (int d = 0; d < 128; ++d) s += q[d] * (float)kc[(size_t)n * HD + d];
                sc[i] = s * QMUL + rel_bias[rel_bucket(t - (16 * n + 31)) * NHEAD + hh]; }
            mx = fmaxf(mx, sc[i]); }
        mx = wave_max(mx); float l = 0.f;
#pragma unroll
        for (int i = 0; i < 4; ++i) { const int n = lane + 64 * i; sc[i] = (n < nvalid) ? __expf(sc[i] - mx) : 0.f; l += sc[i]; }
        l = wave_sum(l); const float inv = nvalid > 0 ? 1.f / l : 0.f;
#pragma unroll
        for (int i = 0; i < 4; ++i) P[r][lane + 64 * i] = sc[i] * inv;
        __syncthreads();
        float o0 = 0.f, o1 = 0.f;
        for (int n = 0; n < nvalid; ++n) { const float p = P[r][n]; o0 += p * (float)vc[(size_t)n * HD + lane]; o1 += p * (float)vc[(size_t)n * HD + lane + 64]; }
        oc[m * 1024 + hh * HD + lane] = o0; oc[m * 1024 + hh * HD + lane + 64] = o1;
    }
    __syncthreads();
    const int j = lane; float imp = 0.f;
    for (int r = 0; r < 4; ++r) for (int n = 4 * j - 1; n <= 4 * j + 3; ++n) if (n >= 0 && n < NCB) imp += P[r][n];
    const int cur = t >> 6; const bool valid = j * 64 <= t, forced = (j == 0) || (j == cur) || (j == cur - 1);
    const float score = valid ? (forced ? 1e9f : imp) : -1e9f;
    int rank = 0;
    for (int i = 0; i < 64; ++i) { const float si = __shfl(score, i); rank += (si > score) || (si == score && i < j); }
    const u64 mask = __ballot(rank < 16);
    if (lane == 0) sel[m * NG + g] = mask;
}

__global__ void __launch_bounds__(128) k_nsa_selwin(const h16* __restrict__ proj, const float* __restrict__ rel_bias, const u64* __restrict__ sel, const float* __restrict__ oc, float* __restrict__ onsa) {
    __shared__ h16 Kt[64 * 128]; __shared__ h16 Vt[64 * 128]; __shared__ float bt[1024];
    const int cur = blockIdx.x, hh = blockIdx.y, b = blockIdx.z, g = hh >> 2, tid = threadIdx.x, t = cur * 64 + (tid >> 1), d0 = (tid & 1) * 64; const size_t m = (size_t)b * S + t;
    for (int i = tid; i < 1024; i += 128) bt[i] = rel_bias[rel_bucket(i) * NHEAD + hh];
    __syncthreads();
    float q[64];
#pragma unroll
    for (int d = 0; d < 64; ++d) q[d] = (float)proj[m * LDP + C_NQ + hh * HD + d0 + d] * QMUL;
    const u64 mysel = sel[m * NG + g];
    const float g0 = 1.f / (1.f + __expf(-(float)proj[m * LDP + C_GATE + hh * 3 + 0])), g1 = 1.f / (1.f + __expf(-(float)proj[m * LDP + C_GATE + hh * 3 + 1])), g2 = 1.f / (1.f + __expf(-(float)proj[m * LDP + C_GATE + hh * 3 + 2]));
    for (int br = 0; br < 2; ++br) {
        float o[64];
#pragma unroll
        for (int d = 0; d < 64; ++d) o[d] = 0.f;
        float mx = -1e30f, l = 0.f;
        const int kcol = (br ? C_KW : C_KS) + g * HD, vcol = (br ? C_VW : C_VS) + g * HD;
        const int j0 = br ? max(0, cur - 8) : 0;
        for (int j = j0; j <= cur; ++j) {
            const bool act = br ? true : ((mysel >> j) & 1ull) != 0ull;
            if (!__syncthreads_or(act ? 1 : 0)) continue;
            for (int i = tid; i < 64 * 128 / 8; i += 128) { const int r = i >> 4, c = (i & 15) * 8; const size_t row = (size_t)(b * S + j * 64 + r) * LDP;
                *(uint4*)&Kt[r * 128 + c] = *(const uint4*)&proj[row + kcol + c]; *(uint4*)&Vt[r * 128 + c] = *(const uint4*)&proj[row + vcol + c]; }
            __syncthreads();
            for (int c0 = 0; c0 < 64; c0 += 16) {
                float sc[16]; float cm = -1e30f;
#pragma unroll
                for (int kk = 0; kk < 16; ++kk) { const int pos = j * 64 + c0 + kk, dist = t - pos; const bool ok = act && dist >= 0 && (br == 0 || dist < 512);
                    float s = 0.f;
#pragma unroll
                    for (int d = 0; d < 64; ++d) s += q[d] * (float)Kt[(c0 + kk) * 128 + d0 + d];
                    s += __shfl_xor(s, 1);
                    s += bt[min(max(dist, 0), 1023)];
                    sc[kk] = ok ? s : -1e30f; cm = fmaxf(cm, sc[kk]); }
                if (cm > -1e29f) {
                    const float mn = fmaxf(mx, cm), al = __expf(mx - mn); mx = mn; l *= al;
#pragma unroll
                    for (int d = 0; d < 64; ++d) o[d] *= al;
#pragma unroll
                    for (int kk = 0; kk < 16; ++kk) { const float p = sc[kk] > -1e29f ? __expf(sc[kk] - mn) : 0.f; l += p;
#pragma unroll
                        for (int d = 0; d < 64; ++d) o[d] += p * (float)Vt[(c0 + kk) * 128 + d0 + d]; }
                }
            }
        }
        const float inv = 1.f / l;
        float* dst = onsa + m * 1024 + hh * HD + d0; const float* ocr = oc + m * 1024 + hh * HD + d0;
        if (br == 0) {
#pragma unroll
            for (int d = 0; d < 64; ++d) dst[d] = g0 * ocr[d] + g1 * o[d] * inv;
        } else {
#pragma unroll
            for (int d = 0; d < 64; ++d) dst[d] += g2 * o[d] * inv;
        }
    }
}

__global__ void __launch_bounds__(128) k_sb_naive(const h16* __restrict__ proj, float* __restrict__ osb) {
    __shared__ h16 Kt[64 * 128]; __shared__ h16 Vt[64 * 128];
    const int cur = blockIdx.x, h = blockIdx.y, b = blockIdx.z, tid = threadIdx.x, t = cur * 64 + (tid >> 1), d0 = (tid & 1) * 64; const size_t m = (size_t)b * S + t;
    float q[64], o[64];
#pragma unroll
    for (int d = 0; d < 64; ++d) { q[d] = (float)proj[m * LDP + C_SBQ + h * HD + d0 + d] * QMUL; o[d] = 0.f; }
    float cum = 0.f;
    for (int j = cur; j >= 0; --j) {
        __syncthreads();
        for (int i = tid; i < 64 * 128 / 8; i += 128) { const int r = i >> 4, c = (i & 15) * 8; const size_t row = (size_t)(b * S + j * 64 + r) * LDP;
            *(uint4*)&Kt[r * 128 + c] = *(const uint4*)&proj[row + C_SBK + h * HD + c]; *(uint4*)&Vt[r * 128 + c] = *(const uint4*)&proj[row + C_SBV + h * HD + c]; }
        __syncthreads();
        for (int kk = 63; kk >= 0; --kk) {
            const int pos = j * 64 + kk;
            float z = 0.f;
#pragma unroll
            for (int d = 0; d < 64; ++d) z += q[d] * (float)Kt[kk * 128 + d0 + d];
            z += __shfl_xor(z, 1);
            const float sp = fmaxf(z, 0.f) + log1pf(__expf(-fabsf(z)));
            const float log_rest = -sp, log_beta = z - sp;
            const float a = (pos < t) ? __expf(log_beta + cum) : 0.f;
            if (pos < t) cum += log_rest;
#pragma unroll
            for (int d = 0; d < 64; ++d) o[d] += a * (float)Vt[kk * 128 + d0 + d];
        }
    }
#pragma unroll
    for (int d = 0; d < 64; ++d) osb[m * 1024 + h * HD + d0 + d] = o[d];
}

__global__ void __launch_bounds__(256) k_make_y(const float* __restrict__ osb, const float* __restrict__ onsa, const h16* __restrict__ proj, const float* __restrict__ gsb, const float* __restrict__ gnsa, h16* __restrict__ y) {
    const int lane = threadIdx.x & 63, w = (blockIdx.x * blockDim.x + threadIdx.x) >> 6, nw = (gridDim.x * blockDim.x) >> 6;
    for (int i = w; i < 2 * M; i += nw) {
        const int m = i >> 1, part = i & 1;
        const float* src = (part ? onsa : osb) + (size_t)m * 1024; const float* gg = part ? gnsa : gsb; const h16* zz = proj + (size_t)m * LDP + (part ? C_NZ : C_SBZ);
        float v[16]; float s = 0.f;
#pragma unroll
        for (int j = 0; j < 16; ++j) { v[j] = src[lane + 64 * j]; s += v[j] * v[j]; }
        const float r = rsqrtf(wave_sum(s) * (1.f / 1024.f) + RMS_EPS);
#pragma unroll
        for (int j = 0; j < 16; ++j) { const int c = lane + 64 * j; const float z = (float)zz[c]; y[(size_t)m * D + part * 1024 + c] = (h16)(v[j] * r * gg[c] * (z / (1.f + __expf(-z)))); }
    }
}
__global__ void __launch_bounds__(256) k_final_norm(float* __restrict__ out, const float* __restrict__ g) {
    const int lane = threadIdx.x & 63, w = (blockIdx.x * blockDim.x + threadIdx.x) >> 6, nw = (gridDim.x * blockDim.x) >> 6;
    for (int m = w; m < M; m += nw) {
        float4* xr = (float4*)(out + (size_t)m * D);
        float4 v[8]; float s = 0.f;
#pragma unroll
        for (int j = 0; j < 8; ++j) { v[j] = xr[lane + 64 * j]; s += v[j].x * v[j].x + v[j].y * v[j].y + v[j].z * v[j].z + v[j].w * v[j].w; }
        const float r = rsqrtf(wave_sum(s) * (1.f / D) + RMS_EPS);
#pragma unroll
        for (int j = 0; j < 8; ++j) { const float4 gg = ((const float4*)g)[lane + 64 * j]; xr[lane + 64 * j] = make_float4(v[j].x * r * gg.x, v[j].y * r * gg.y, v[j].z * r * gg.z, v[j].w * r * gg.w); }
    }
}

namespace pg8 {
#define PG8_LAS __attribute__((address_space(3)))
typedef unsigned short bf16_t;
typedef _Float16 bf16x8 __attribute__((ext_vector_type(8)));
typedef float f32x4 __attribute__((ext_vector_type(4)));
typedef unsigned u32x4 __attribute__((ext_vector_type(4)));
constexpr int BM = 256, BK = 64, HALF = 128, HTB = HALF * BK * 2  , STAGE_BYTES = 8 * HTB, NXCD = 8, WGM = 8;

__host__ __device__ __forceinline__ int lds_byte(int r, int c) { const int st = (r >> 4) * 2 + (c >> 5), rr = r & 15, cc = c & 31, ob = rr * 64 + cc * 2; return st * 1024 + (ob ^ (((ob >> 9) & 1) << 5)); }
__host__ __device__ __forceinline__ void stage_rc(int b, int& R, int& C) { const int st = b / 1024, sb = b % 1024, swz = sb ^ (((sb >> 9) & 1) << 5); R = (st >> 1) * 16 + swz / 64; C = (st & 1) * 32 + (swz % 64) / 2; }
__host__ __device__ __forceinline__ int perm32(int rho) { const int n = rho >> 4, i = rho & 15; return 8 * (i >> 2) + 4 * n + (i & 3); }

struct Unit { int pm, pn; };
struct Gemm { const bf16_t* A; const bf16_t* Bt; int M, N, K; };

struct StaticOrder {
    int nM, nN, nwg, G, c;
    __host__ __device__ void init(int M, int N, int G_, int c_) { nM = M / BM; nN = N / BM; nwg = nM * nN; G = G_; c = c_; }
    __host__ __device__ bool next(int i, Unit& u) const {
        const long L = (long)i * G + c; if (L >= nwg) return false;
        int wgid = (int)L; { const int q = nwg / NXCD, r = nwg % NXCD, xcd = wgid % NXCD, off = wgid / NXCD; wgid = (xcd < r ? xcd * (q + 1) : r * (q + 1) + (xcd - r) * q) + off; }
        const int nig = WGM * nN, gid = wgid / nig, fm = gid * WGM, gsz = (nM - fm) < WGM ? (nM - fm) : WGM;
        u.pm = fm + ((wgid % nig) % gsz); u.pn = (wgid % nig) / gsz; return true;
    }
    __device__ __forceinline__ void a_ready(const Unit&) const {}
    __device__ __forceinline__ void done(const Unit&) const {}
};

struct EpiF16 {
    static constexpr bool PERM = true, AFTER_DRAIN = false;
    _Float16* O; int ldc; float qscale;
    __device__ __forceinline__ void operator()(const f32x4 (&acc)[2][2][4][2], const Unit& u, int wr, int wc, int fr, int fq) const {
        const int row0 = u.pm * BM + wr * 64 + fr, col0 = u.pn * BM + wc * 32 + 8 * fq;
        const float s = (u.pn < 4 || (u.pn >= 16 && u.pn < 20)) ? qscale : 1.0f;
#pragma unroll
        for (int ai = 0; ai < 2; ++ai)
#pragma unroll
            for (int m = 0; m < 4; ++m) { _Float16* rowp = O + (size_t)(row0 + ai * HALF + m * 16) * ldc + col0;
#pragma unroll
                for (int bj = 0; bj < 2; ++bj) { const f32x4 v0 = acc[ai][bj][m][0] * s, v1 = acc[ai][bj][m][1] * s;
                    bf16x8 w; w[0] = (_Float16)v0[0]; w[1] = (_Float16)v0[1]; w[2] = (_Float16)v0[2]; w[3] = (_Float16)v0[3]; w[4] = (_Float16)v1[0]; w[5] = (_Float16)v1[1]; w[6] = (_Float16)v1[2]; w[7] = (_Float16)v1[3];
                    *(bf16x8*)(rowp + bj * HALF) = w; } }
    }
};
struct EpiResF32 {
    static constexpr bool PERM = false, AFTER_DRAIN = false;
    const float* resid; float* C; int ldc; float* ssq;
    __device__ __forceinline__ void operator()(const f32x4 (&acc)[2][2][4][2], const Unit& u, int wr, int wc, int fr, int fq) const {
        const int row0 = u.pm * BM + wr * 64 + fr, col0 = u.pn * BM + wc * 32 + 4 * fq;
#pragma unroll
        for (int ai = 0; ai < 2; ++ai)
#pragma unroll
            for (int m = 0; m < 4; ++m) { const int row = row0 + ai * HALF + m * 16; const size_t off = (size_t)row * ldc + col0; float q = 0.f;
#pragma unroll
                for (int bj = 0; bj < 2; ++bj)
#pragma unroll
                    for (int n = 0; n < 2; ++n) { const f32x4 h = *(const f32x4*)(resid + off + bj * HALF + n * 16) + acc[ai][bj][m][n]; *(f32x4*)(C + off + bj * HALF + n * 16) = h;
                        q += (h[0] * h[0] + h[1] * h[1]) + (h[2] * h[2] + h[3] * h[3]); }
                q += __shfl_xor(q, 16); q += __shfl_xor(q, 32);
                if (fq == 0) ssq[(size_t)row * 32 + 4 * u.pn + wc] = q; }
    }
};
template <class Epi, class Sched, bool ALIGN_EPI = false, bool SP2 = false>
__device__ __forceinline__ void gemm_phase(PG8_LAS unsigned char* lds, const Gemm g, const Sched& S, const Epi& E) {
    const int tid = threadIdx.x, wid = __builtin_amdgcn_readfirstlane(tid >> 6), lane = tid & 63, wr = wid >> 2, wc = wid & 3, fr = lane & 15, fq = lane >> 4;
    const int K = g.K, nt = K / BK;
    unsigned voffA[2], voffB[2];
#pragma unroll
    for (int i = 0; i < 2; ++i) { int R, C; stage_rc(tid * 16 + i * 8192, R, C); const int Rb = Epi::PERM ? ((R & ~31) + perm32(R & 31)) : R;
        voffA[i] = (unsigned)(R * K + C) * 2u; voffB[i] = (unsigned)(Rb * K + C) * 2u; }
    const size_t kstep = (size_t)(BK * 2);
    const size_t hstep = (size_t)HALF * K * 2;
    const size_t tstep = 2 * hstep;
    const unsigned ldsw = (unsigned)wid * 1024u;
    const int aoff = lds_byte(wr * 64 + fr, fq * 8), boff = lds_byte(wc * 32 + fr, fq * 8);
#define PG8_SA(b, h) (((b) * 2 + (h)) * HTB)
#define PG8_SB(b, h) ((4 + (b) * 2 + (h)) * HTB)
#define PG8_STAGE(bufoff, gbase, voff) do { _Pragma("unroll") for (int _i = 0; _i < 2; ++_i) \
        __builtin_amdgcn_global_load_lds((const unsigned*)((const char*)(gbase) + (voff)[_i]), (PG8_LAS unsigned*)(lds + (bufoff) + ldsw + _i * 8192), 16, 0, 0); } while (0)
#define PG8_LDA(dst, b, h) do { _Pragma("unroll") for (int m = 0; m < 4; ++m) _Pragma("unroll") for (int k = 0; k < 2; ++k) dst[m][k] = *(const PG8_LAS bf16x8*)(lds + PG8_SA(b, h) + aoff + m * 2048 + k * 1024); } while (0)
#define PG8_LDB(dst, b, h) do { _Pragma("unroll") for (int n = 0; n < 2; ++n) _Pragma("unroll") for (int k = 0; k < 2; ++k) dst[n][k] = *(const PG8_LAS bf16x8*)(lds + PG8_SB(b, h) + boff + n * 2048 + k * 1024); } while (0)
#define PG8_MMA(ai, bj, At, Bt) do { __builtin_amdgcn_s_setprio(1); _Pragma("unroll") for (int m = 0; m < 4; ++m) _Pragma("unroll") for (int n = 0; n < 2; ++n) _Pragma("unroll") for (int k = 0; k < 2; ++k) \
        acc[ai][bj][m][n] = __builtin_amdgcn_mfma_f32_16x16x32_f16(Bt[n][k], At[m][k], acc[ai][bj][m][n], 0, 0, 0); __builtin_amdgcn_s_setprio(0); } while (0)
#define PG8_WAIT_V(n) asm volatile("s_waitcnt vmcnt(" #n ")" ::: "memory")
#define PG8_WAIT_L(n) asm volatile("s_waitcnt lgkmcnt(" #n ")" ::: "memory")
#define PG8_BAR __builtin_amdgcn_s_barrier()
#define PG8_SCHED __builtin_amdgcn_sched_barrier(0)
    Unit cur, nxt; int ui = 0;
    if (!S.next(0, cur)) return;
    f32x4 acc[2][2][4][2];
#pragma unroll
    for (int a = 0; a < 2; ++a)
#pragma unroll
        for (int b = 0; b < 2; ++b)
#pragma unroll
            for (int m = 0; m < 4; ++m)
#pragma unroll
                for (int n = 0; n < 2; ++n) acc[a][b][m][n] = (f32x4){0.f, 0.f, 0.f, 0.f};
    bf16x8 At[4][2], B0[2][2], B1[2][2];
    const char* cA = (const char*)g.A + (size_t)cur.pm * tstep; const char* cB = (const char*)g.Bt + (size_t)cur.pn * tstep;
    S.a_ready(cur);
    if constexpr (SP2) {
        PG8_STAGE(PG8_SB(0, 0), cB, voffB); PG8_STAGE(PG8_SB(0, 1), cB + hstep, voffB); PG8_STAGE(PG8_SA(0, 0), cA, voffA); PG8_STAGE(PG8_SA(0, 1), cA + hstep, voffA);
        if (wr == 1) PG8_BAR;
        PG8_WAIT_V(2); PG8_BAR;
        PG8_STAGE(PG8_SB(1, 0), cB + kstep, voffB); PG8_STAGE(PG8_SA(1, 0), cA + kstep, voffA); PG8_STAGE(PG8_SB(1, 1), cB + hstep + kstep, voffB);
        PG8_WAIT_V(6); PG8_BAR;
    } else {
        PG8_STAGE(PG8_SB(0, 0), cB, voffB); PG8_STAGE(PG8_SA(0, 0), cA, voffA); PG8_STAGE(PG8_SB(0, 1), cB + hstep, voffB); PG8_STAGE(PG8_SA(0, 1), cA + hstep, voffA);
        if (wr == 1) PG8_BAR;
        PG8_WAIT_V(4); PG8_BAR;
        PG8_STAGE(PG8_SB(1, 0), cB + kstep, voffB); PG8_STAGE(PG8_SA(1, 0), cA + kstep, voffA); PG8_STAGE(PG8_SB(1, 1), cB + hstep + kstep, voffB);
        PG8_WAIT_V(6); PG8_BAR;
    }
    for (;;) {
        const bool has_next = S.next(ui + 1, nxt);
        const char* nA = has_next ? (const char*)g.A + (size_t)nxt.pm * tstep : cA; const char* nB = has_next ? (const char*)g.Bt + (size_t)nxt.pn * tstep : cB;
        for (int t = 0; t < nt; t += 2) {
            const bool last = (t == nt - 2);
            const char* a1 = cA + (size_t)(t + 1) * kstep;
            const char* a2 = last ? nA : cA + (size_t)(t + 2) * kstep; const char* b2 = last ? nB : cB + (size_t)(t + 2) * kstep;
            const char* a3 = a2 + kstep; const char* b3 = b2 + kstep;
            if (last && has_next) S.a_ready(nxt);
            if constexpr (SP2) {
            PG8_LDB(B0, 0, 0); PG8_LDB(B1, 0, 1); PG8_SCHED; PG8_LDA(At, 0, 0); PG8_STAGE(PG8_SA(1, 1), a1 + hstep, voffA);
            PG8_WAIT_V(8); PG8_WAIT_L(0); PG8_BAR; PG8_MMA(0, 0, At, B0); PG8_MMA(0, 1, At, B1); PG8_BAR; PG8_SCHED;
            PG8_LDA(At, 0, 1); PG8_STAGE(PG8_SB(0, 0), b2, voffB); PG8_STAGE(PG8_SB(0, 1), b2 + hstep, voffB); PG8_STAGE(PG8_SA(0, 0), a2, voffA);
            PG8_WAIT_V(8); PG8_WAIT_L(0); PG8_BAR; PG8_MMA(1, 0, At, B0); PG8_MMA(1, 1, At, B1); PG8_BAR; PG8_SCHED;
            PG8_LDB(B0, 1, 0); PG8_LDB(B1, 1, 1); PG8_SCHED; PG8_LDA(At, 1, 0); PG8_STAGE(PG8_SA(0, 1), a2 + hstep, voffA);
            PG8_WAIT_V(8); PG8_WAIT_L(0); PG8_BAR; PG8_MMA(0, 0, At, B0); PG8_MMA(0, 1, At, B1); PG8_BAR; PG8_SCHED;
            PG8_LDA(At, 1, 1); PG8_STAGE(PG8_SB(1, 0), b3, voffB); PG8_STAGE(PG8_SB(1, 1), b3 + hstep, voffB); PG8_STAGE(PG8_SA(1, 0), a3, voffA);
            PG8_WAIT_V(8); PG8_WAIT_L(0); PG8_BAR; PG8_MMA(1, 0, At, B0); PG8_MMA(1, 1, At, B1); PG8_BAR; PG8_SCHED;
            } else {
            PG8_LDB(B0, 0, 0); PG8_SCHED; PG8_LDA(At, 0, 0); PG8_STAGE(PG8_SA(1, 1), a1 + hstep, voffA);
            PG8_WAIT_L(8); PG8_BAR; PG8_WAIT_L(0); PG8_MMA(0, 0, At, B0); PG8_BAR; PG8_SCHED;
            PG8_LDB(B1, 0, 1); PG8_STAGE(PG8_SB(0, 0), b2, voffB);
            PG8_BAR; PG8_WAIT_L(0); PG8_MMA(0, 1, At, B1); PG8_BAR;
            PG8_LDA(At, 0, 1); PG8_STAGE(PG8_SA(0, 0), a2, voffA);
            PG8_BAR; PG8_WAIT_L(0); PG8_MMA(1, 0, At, B0); PG8_BAR; PG8_SCHED;
            PG8_STAGE(PG8_SB(0, 1), b2 + hstep, voffB);
            PG8_WAIT_V(6); PG8_BAR; PG8_MMA(1, 1, At, B1); PG8_BAR;
            PG8_LDB(B0, 1, 0); PG8_SCHED; PG8_LDA(At, 1, 0); PG8_STAGE(PG8_SA(0, 1), a2 + hstep, voffA);
            PG8_WAIT_L(8); PG8_BAR; PG8_WAIT_L(0); PG8_MMA(0, 0, At, B0); PG8_BAR; PG8_SCHED;
            PG8_LDB(B1, 1, 1); PG8_STAGE(PG8_SB(1, 0), b3, voffB);
            PG8_BAR; PG8_WAIT_L(0); PG8_MMA(0, 1, At, B1); PG8_BAR;
            PG8_LDA(At, 1, 1); PG8_STAGE(PG8_SA(1, 0), a3, voffA);
            PG8_BAR; PG8_WAIT_L(0); PG8_MMA(1, 0, At, B0); PG8_BAR; PG8_SCHED;
            PG8_STAGE(PG8_SB(1, 1), b3 + hstep, voffB);
            PG8_WAIT_V(6); PG8_BAR; PG8_MMA(1, 1, At, B1); PG8_BAR;
            }
        }
        if constexpr (ALIGN_EPI) { if (wr == 0) PG8_BAR; }
        if constexpr (!Epi::AFTER_DRAIN) { E(acc, cur, wr, wc, fr, fq); S.done(cur); }
        if (!has_next) break;
#pragma unroll
        for (int a = 0; a < 2; ++a)
#pragma unroll
            for (int b = 0; b < 2; ++b)
#pragma unroll
                for (int m = 0; m < 4; ++m)
#pragma unroll
                    for (int n = 0; n < 2; ++n) acc[a][b][m][n] = (f32x4){0.f, 0.f, 0.f, 0.f};
        cur = nxt; cA = nA; cB = nB; ++ui;
        if constexpr (ALIGN_EPI) { if (wr == 1) PG8_BAR; }
    }
    PG8_WAIT_V(0);
    if constexpr (!ALIGN_EPI) { if (wr == 0) PG8_BAR; }
    PG8_BAR;
    if constexpr (Epi::AFTER_DRAIN) { E.fused(acc, cur, wr, wc, fr, fq, lds, wid, lane); S.done(cur); }
#undef PG8_SA
#undef PG8_SB
#undef PG8_STAGE
#undef PG8_LDA
#undef PG8_LDB
#undef PG8_MMA
#undef PG8_WAIT_V
#undef PG8_WAIT_L
#undef PG8_BAR
#undef PG8_SCHED
}
}

#define GAS __attribute__((address_space(1)))
#define LAS __attribute__((address_space(3)))
typedef unsigned v4u __attribute__((ext_vector_type(4)));
#define LDS_WAIT() asm volatile("s_waitcnt lgkmcnt(0)" ::: "memory")
#define VM_WAIT() asm volatile("s_waitcnt vmcnt(0)" ::: "memory")
constexpr int NWAVES = 8, NTHR = NWAVES * 64;
constexpr int RING_OFF = 0, RING_BYTES = 131072;
constexpr int LDSCTL_OFF = RING_BYTES, MISC_OFF = LDSCTL_OFF + 320;
constexpr int LDS_BYTES = 147456;
constexpr int CW_BAR = 4096;
constexpr size_t CTL_ZERO_BYTES = 65536;

#define XB_TMO      128
#define XB_XCNT(j)  (256  + 64 * (j))
#define XB_XSUB(j)  (1280 + 64 * (j))
#define XB_XGEN(j)  (2304 + 64 * (j))
#define XB_TOP      3328
#define XB_TOPGEN   3392
#define XCD_BAR_WORDS 3456
#define XB_SPIN_CAP (1u << 18)

__device__ __forceinline__ unsigned xb_ld(unsigned* p)              { return __hip_atomic_load(p, __ATOMIC_RELAXED, __HIP_MEMORY_SCOPE_AGENT); }
__device__ __forceinline__ unsigned xb_add(unsigned* p, unsigned v) { return __hip_atomic_fetch_add(p, v, __ATOMIC_RELAXED, __HIP_MEMORY_SCOPE_AGENT); }
__device__ __forceinline__ unsigned xb_xcc_id() { return (unsigned)__builtin_amdgcn_s_getreg((3 << 11) | 20) & 0xFu; }
#define XB_SPIN(cond, bar) do { unsigned _sp = 0; while (cond) { __builtin_amdgcn_s_sleep(1); \
    if ((++_sp & 255u) == 0u) { if (xb_ld(&(bar)[XB_TMO])) break; if (_sp > XB_SPIN_CAP) { atomicAdd(&(bar)[XB_TMO], 1u); break; } } } } while (0)

struct XcdBarrier {
    unsigned* bar; unsigned x;
    volatile LAS unsigned* st;
};

__device__ __forceinline__ XcdBarrier xcd_barrier_post(unsigned* bar, volatile LAS unsigned* st) {
    XcdBarrier b; b.bar = bar; b.x = xb_xcc_id(); b.st = st;
    if (threadIdx.x == 0) (void)xb_add(&bar[XB_XCNT(b.x)], 1u);
    return b;
}
__device__ __forceinline__ void xcd_barrier_complete(unsigned* bar, unsigned x, unsigned& nloc, unsigned& nx) {
    const unsigned G = gridDim.x * gridDim.y * gridDim.z;
    unsigned sum, cnt, mine, sp = 0u;
    for (;;) {
        sum = 0u; cnt = 0u; mine = 0u;
#pragma unroll
        for (unsigned j = 0; j < 16; ++j) { const unsigned c = xb_ld(&bar[XB_XCNT(j)]); sum += c; cnt += (c > 0u) ? 1u : 0u; mine = (j == x) ? c : mine; }
        if (sum == G) break;
        __builtin_amdgcn_s_sleep(1);
        if ((++sp & 255u) == 0u) { if (xb_ld(&bar[XB_TMO])) break; if (sp > XB_SPIN_CAP) { atomicAdd(&bar[XB_TMO], 1u); break; } }
    }
    nloc = mine > 0u ? mine : 1u; nx = cnt > 0u ? cnt : 1u;
}

__device__ __forceinline__ void xcd_barrier(const XcdBarrier& b) {
    asm volatile("s_waitcnt vmcnt(0)" ::: "memory");
    __syncthreads();
    if (threadIdx.x == 0) {
        unsigned* bar = b.bar;
        __builtin_amdgcn_s_waitcnt(0);
        unsigned nloc = b.st[0], nx = b.st[1];
        if (nloc == 0u) { xcd_barrier_complete(bar, b.x, nloc, nx); b.st[0] = nloc; b.st[1] = nx; }
        const unsigned old = xb_add(&bar[XB_XSUB(b.x)], 1u);
        const unsigned gen = old / nloc;
        if (old + 1u == (gen + 1u) * nloc) {
            __builtin_amdgcn_fence(__ATOMIC_RELEASE, "agent");
            asm volatile("s_waitcnt vmcnt(0)" ::: "memory");
            const unsigned og = xb_add(&bar[XB_TOP], 1u);
            const unsigned tg = og / nx;
            if (og + 1u == (tg + 1u) * nx) xb_add(&bar[XB_TOPGEN], 1u);
            else XB_SPIN(xb_ld(&bar[XB_TOPGEN]) == tg, bar);
            __builtin_amdgcn_fence(__ATOMIC_ACQUIRE, "agent");
            xb_add(&bar[XB_XGEN(b.x)], 1u);
            asm volatile("s_waitcnt vmcnt(0)" ::: "memory");
        } else {
            XB_SPIN(xb_ld(&bar[XB_XGEN(b.x)]) == gen, bar);
            __builtin_amdgcn_fence(__ATOMIC_ACQUIRE, "agent");
            asm volatile("s_waitcnt vmcnt(0)" ::: "memory");
        }
    }
    __syncthreads();
}

static_assert((CW_BAR + XCD_BAR_WORDS) * 4 <= (int)CTL_ZERO_BYTES, "barrier words inside the memset region");

__device__ __forceinline__ unsigned pk2h(float lo, float hi) { typedef _Float16 h2 __attribute__((ext_vector_type(2))); h2 v; v[0] = (_Float16)lo; v[1] = (_Float16)hi; return __builtin_bit_cast(unsigned, v); }

__device__ __forceinline__ void p0_transpose_item(const float* W, int K, int ldw, bool remap, h16* WT, LAS float* scr, int item, int nblk, int lane) {
    const int kb = item / nblk, nb = item % nblk, k0 = 64 * kb, n0 = 32 * nb;
    const int n = n0 + (lane & 31), sc = remap ? src_col(n) : n;
#pragma unroll 8
    for (int i = 0; i < 32; ++i) { const int kk = 2 * i + (lane >> 5); scr[kk * 33 + (lane & 31)] = sc >= 0 ? W[(size_t)(k0 + kk) * ldw + sc] : 0.f; }
    LDS_WAIT(); asm volatile("" ::: "memory");
    const int c = lane & 7;
#pragma unroll
    for (int j = 0; j < 4; ++j) { const int nn = (lane >> 3) + 8 * j; const LAS float* s = scr + (8 * c) * 33 + nn;
        v4u o; o.x = pk2h(s[0 * 33], s[1 * 33]); o.y = pk2h(s[2 * 33], s[3 * 33]); o.z = pk2h(s[4 * 33], s[5 * 33]); o.w = pk2h(s[6 * 33], s[7 * 33]);
        *(GAS v4u*)(WT + (size_t)(n0 + nn) * K + k0 + 8 * c) = o; }
    LDS_WAIT(); asm volatile("" ::: "memory");
}
typedef float f32x4v __attribute__((ext_vector_type(4)));
typedef unsigned u32x2v __attribute__((ext_vector_type(2)));
__device__ __forceinline__ void p0_rms_row(const float* xrow, const float* g, h16* orow, int lane) {
    const f32x4v* xr = (const f32x4v*)xrow + lane; const f32x4v* gr = (const f32x4v*)g + lane;
    f32x4v v[8]; float s = 0.f;
#pragma unroll
    for (int j = 0; j < 8; ++j) { v[j] = xr[64 * j]; s += (v[j][0] * v[j][0] + v[j][1] * v[j][1]) + (v[j][2] * v[j][2] + v[j][3] * v[j][3]); }
    const float r = rsqrtf(wave_sum(s) * (1.f / D) + RMS_EPS);
    u32x2v* o8 = (u32x2v*)orow + lane;
#pragma unroll
    for (int j = 0; j < 8; ++j) { const f32x4v gg = gr[64 * j]; u32x2v w; w[0] = pk2h(v[j][0] * r * gg[0], v[j][1] * r * gg[1]); w[1] = pk2h(v[j][2] * r * gg[2], v[j][3] * r * gg[3]); o8[64 * j] = w; }
}

struct Args { const float* in[14]; float* out; unsigned char* ws; int ph_lo, ph_hi; };

__global__ void __launch_bounds__(NTHR, 2) fwd(Args args) {
    extern __shared__ __attribute__((aligned(16))) unsigned char lds_raw[];
    LAS unsigned char* lds = (LAS unsigned char*)lds_raw;
    volatile LAS unsigned* MISC = (volatile LAS unsigned*)(lds + MISC_OFF);
    const int tid = threadIdx.x, lane = tid & 63, wave = __builtin_amdgcn_readfirstlane(tid >> 6);
    const int G = gridDim.x; const int bx = blockIdx.x; const int vcu = (G % 8 == 0) ? (bx % 8) * (G / 8) + bx / 8 : bx;
    unsigned char* ws = args.ws;
    unsigned* ctl = (unsigned*)(ws + WS_CTL);
    for (int u = tid; u < (LDS_BYTES - LDSCTL_OFF) / 4; u += NTHR) ((LAS unsigned*)(lds + LDSCTL_OFF))[u] = 0u;
    __syncthreads();
    XcdBarrier bar = xcd_barrier_post(ctl + CW_BAR, MISC + 8);
    const int lo = args.ph_lo, hi = args.ph_hi;
#define IN(k) (lo <= (k) && (k) < hi)
#define BOTH(k) (IN(k) && IN((k) + 1))
    h16* XN = (h16*)(ws + WS_XN); h16* WINT = (h16*)(ws + WS_WINT); h16* WOUTT = (h16*)(ws + WS_WOUTT); h16* PROJ = (h16*)(ws + WS_PROJ);

    if (IN(0)) {
        LAS float* scr = (LAS float*)(lds + RING_OFF + wave * 16384);
        const int gw = vcu * NWAVES + wave, NGW = G * NWAVES;
        constexpr int I_IN = (D / 64) * (LDP / 32), I_OUT = (D / 64) * (D / 32);
        for (int it = gw; it < I_IN + I_OUT; it += NGW) {
            if (it < I_IN) p0_transpose_item(args.in[2], D, NPROJ, true, WINT, scr, it, LDP / 32, lane);
            else p0_transpose_item(args.in[12], D, D, false, WOUTT, scr, it - I_IN, D / 32, lane);
        }
        for (int m = gw; m < M; m += NGW) p0_rms_row(args.in[0] + (size_t)m * D, args.in[1], XN + (size_t)m * D, lane);
        if (BOTH(0)) xcd_barrier(bar);
    }
    if (IN(1)) {
        pg8::Gemm g{(const pg8::bf16_t*)XN, (const pg8::bf16_t*)WINT, M, LDP, D}; pg8::StaticOrder SO; SO.init(M, LDP, G, bx);
        pg8::EpiF16 E{PROJ, LDP, QSCALE};
        pg8::gemm_phase<pg8::EpiF16, pg8::StaticOrder, true, true>(lds + RING_OFF, g, SO, E);
        if (BOTH(1)) xcd_barrier(bar);
    }
#undef IN
#undef BOTH
}

extern "C" void kernel_launch(void* const* d_in, const int* in_sizes, int n_in, void* d_out, int out_size, void* d_ws, size_t ws_size, hipStream_t stream) {
    static int grid = 0;
    if (grid == 0) {
        if (n_in != 14 || in_sizes[0] != M * D || out_size != M * D || ws_size < WS_END) { fprintf(stderr, "kernel_launch: unexpected shapes (n_in %d in0 %d out %d ws %zu need %zu)\n", n_in, n_in > 0 ? in_sizes[0] : -1, out_size, ws_size, (size_t)WS_END); grid = -1; return; }
        int dev = 0, cus = 0, per_cu = 0;
        if (hipGetDevice(&dev) != hipSuccess || hipDeviceGetAttribute(&cus, hipDeviceAttributeMultiprocessorCount, dev) != hipSuccess) { grid = -1; return; }
        if (hipFuncSetAttribute((const void*)fwd, hipFuncAttributeMaxDynamicSharedMemorySize, LDS_BYTES) != hipSuccess) { fprintf(stderr, "kernel_launch: hipFuncSetAttribute failed\n"); grid = -1; return; }
        if (hipOccupancyMaxActiveBlocksPerMultiprocessor(&per_cu, (const void*)fwd, NTHR, LDS_BYTES) != hipSuccess || per_cu < 1) { fprintf(stderr, "kernel_launch: occupancy query says %d blocks per CU\n", per_cu); grid = -1; return; }
        (void)hipGetLastError();
        grid = cus;
    }
    if (grid < 0) return;
    const float* x = (const float*)d_in[0];
    const float* kpos = (const float*)d_in[3]; const float* kw1 = (const float*)d_in[4]; const float* kw2 = (const float*)d_in[5];
    const float* vpos = (const float*)d_in[6]; const float* vw1 = (const float*)d_in[7]; const float* vw2 = (const float*)d_in[8];
    const float* rel_bias = (const float*)d_in[9]; const float* norm_sb = (const float*)d_in[10]; const float* norm_nsa = (const float*)d_in[11];
    const float* norm_final = (const float*)d_in[13];
    unsigned char* ws = (unsigned char*)d_ws; float* out = (float*)d_out;
    h16* XN = (h16*)(ws + WS_XN); h16* WOUTT = (h16*)(ws + WS_WOUTT); h16* PROJ = (h16*)(ws + WS_PROJ);
    h16* KCC = (h16*)(ws + WS_KCC); h16* VCC = (h16*)(ws + WS_VCC); u64* SEL = (u64*)(ws + WS_SEL); float* OC = (float*)(ws + WS_OC);
    float* OSB = out; float* ONSA = out + (size_t)M * 1024;

    (void)hipMemsetAsync(ws + WS_CTL, 0, CTL_ZERO_BYTES, stream);
    Args a{};
    for (int i = 0; i < 14; ++i) a.in[i] = (const float*)d_in[i];
    a.out = out; a.ws = ws; a.ph_lo = 0; a.ph_hi = 2;
    hipLaunchKernelGGL(fwd, dim3(grid), dim3(NTHR), LDS_BYTES, stream, a);
    k_compress<<<dim3(NCB, 4, NB), 256, 0, stream>>>(PROJ, kpos, kw1, kw2, vpos, vw1, vw2, KCC, VCC);
    k_sb_naive<<<dim3(S / 64, NHEAD, NB), 128, 0, stream>>>(PROJ, OSB);
    k_nsa_cmp<<<dim3(S, NG, NB), 64, 0, stream>>>(PROJ, KCC, VCC, rel_bias, OC, SEL);
    k_nsa_selwin<<<dim3(S / 64, NHEAD, NB), 128, 0, stream>>>(PROJ, rel_bias, SEL, OC, ONSA);
    k_make_y<<<2048, 256, 0, stream>>>(OSB, ONSA, PROJ, norm_sb, norm_nsa, XN  );
    k_gemm_naive<1><<<dim3(D / 64, M / 64), 256, 0, stream>>>(XN, WOUTT, out, x, D, D);
    k_final_norm<<<2048, 256, 0, stream>>>(out, norm_final);
}
```

```cpp
#include <hip/hip_runtime.h>
#include <cstdio>
#include <cstdint>

typedef _Float16 h16;
typedef unsigned long long u64;

constexpr int NB = 8, S = 4096, D = 2048, M = NB * S;
constexpr int HD = 128, NHEAD = 8, NG = 2, NR = 4;
constexpr int NPROJ = 7704, LDP = 7936;
constexpr int C_SBQ = 0, C_SBK = 1024, C_SBV = 2048, C_SBZ = 3072, C_NQ = 4096, C_KC = 5120, C_VC = 5376, C_KS = 5632, C_VS = 5888,
              C_KW = 6144, C_VW = 6400, C_NZ = 6656, C_GATE = 7680;
constexpr int NCB = 255, NCBP = 256;
constexpr float RMS_EPS = 1e-6f;
constexpr float QSCALE = 0.08838834764831845f * 1.4426950408889634f;
constexpr float QMUL = 0.6931471805599453f;

constexpr size_t MiB = 1u << 20;
constexpr size_t WS_CTL = 0;
constexpr size_t WS_XN = 1 * MiB;
constexpr size_t WS_WINT = WS_XN + (size_t)M * D * 2;
constexpr size_t WS_WOUTT = WS_WINT + (size_t)LDP * D * 2;
constexpr size_t WS_PROJ = WS_WOUTT + (size_t)D * D * 2;
constexpr size_t WS_KCC = WS_PROJ + (size_t)M * LDP * 2;
constexpr size_t WS_VCC = WS_KCC + (size_t)NB * NG * NCBP * HD * 2;
constexpr size_t WS_SEL = WS_VCC + (size_t)NB * NG * NCBP * HD * 2;
constexpr size_t WS_OC = WS_SEL + (size_t)M * NG * 8;
constexpr size_t WS_SSQ = WS_OC + (size_t)M * 1024 * 4;
constexpr size_t WS_OG = WS_SSQ + (size_t)M * 32 * 4;
constexpr size_t WS_SSQ16 = WS_OG + (size_t)M * 2048 * 2;
constexpr size_t WS_END = WS_SSQ16 + (size_t)M * 16 * 4;

__device__ __forceinline__ int src_col(int c) { return c < 6656 ? c : (c < 7680 ? c + 24 : (c < NPROJ ? c - 1024 : -1)); }

__device__ __forceinline__ int rel_bucket(int dist) {
    if (dist < 16) return dist < 0 ? 0 : dist;
    int b = 16;
    b += dist >= 21; b += dist >= 27; b += dist >= 35; b += dist >= 46; b += dist >= 59; b += dist >= 77; b += dist >= 99; b += dist >= 128;
    b += dist >= 166; b += dist >= 216; b += dist >= 280; b += dist >= 363; b += dist >= 470; b += dist >= 609; b += dist >= 790;
    return b;
}
__device__ __forceinline__ float wave_sum(float v) {
#pragma unroll
    for (int o = 1; o < 64; o <<= 1) v += __shfl_xor(v, o);
    return v;
}
__device__ __forceinline__ float wave_max(float v) {
#pragma unroll
    for (int o = 1; o < 64; o <<= 1) v = fmaxf(v, __shfl_xor(v, o));
    return v;
}

__global__ void __launch_bounds__(256) k_rmsnorm_in(const float* __restrict__ x, const float* __restrict__ g, h16* __restrict__ xn) {
    const int lane = threadIdx.x & 63, w = (blockIdx.x * blockDim.x + threadIdx.x) >> 6, nw = (gridDim.x * blockDim.x) >> 6;
    for (int m = w; m < M; m += nw) {
        const float4* xr = (const float4*)(x + (size_t)m * D);
        float4 v[8]; float s = 0.f;
#pragma unroll
        for (int j = 0; j < 8; ++j) { v[j] = xr[lane + 64 * j]; s += v[j].x * v[j].x + v[j].y * v[j].y + v[j].z * v[j].z + v[j].w * v[j].w; }
        const float r = rsqrtf(wave_sum(s) * (1.f / D) + RMS_EPS);
#pragma unroll
        for (int j = 0; j < 8; ++j) {
            const float4 gg = ((const float4*)g)[lane + 64 * j];
            h16* o = xn + (size_t)m * D + 4 * (lane + 64 * j);
            o[0] = (h16)(v[j].x * r * gg.x); o[1] = (h16)(v[j].y * r * gg.y); o[2] = (h16)(v[j].z * r * gg.z); o[3] = (h16)(v[j].w * r * gg.w);
        }
    }
}
__global__ void __launch_bounds__(256) k_transpose_w(const float* __restrict__ W, h16* __restrict__ WT, int K, int ldw, int N_out, int remap) {
    __shared__ float t[32][33];
    const int k0 = blockIdx.x * 32, n0 = blockIdx.y * 32, tx = threadIdx.x & 31, ty = threadIdx.x >> 5;
    for (int i = ty; i < 32; i += 8) { const int n = n0 + tx; const int sc = remap ? src_col(n) : n; t[i][tx] = (sc >= 0) ? W[(size_t)(k0 + i) * ldw + sc] : 0.f; }
    __syncthreads();
    for (int i = ty; i < 32; i += 8) WT[(size_t)(n0 + i) * K + k0 + tx] = (h16)t[tx][i];
}

template <int MODE>
__global__ void __launch_bounds__(256) k_gemm_naive(const h16* __restrict__ A, const h16* __restrict__ Bt, void* __restrict__ Cv, const float* __restrict__ resid, int K, int ldc) {
    __shared__ float As[32][68], Bs[32][68];
    const int tx = threadIdx.x & 15, ty = threadIdx.x >> 4, m0 = blockIdx.y * 64, n0 = blockIdx.x * 64;
    float acc[4][4] = {};
    for (int k0 = 0; k0 < K; k0 += 32) {
        for (int i = threadIdx.x; i < 64 * 32; i += 256) { const int r = i >> 5, c = i & 31; As[c][r] = (float)A[(size_t)(m0 + r) * K + k0 + c]; Bs[c][r] = (float)Bt[(size_t)(n0 + r) * K + k0 + c]; }
        __syncthreads();
#pragma unroll 8
        for (int kk = 0; kk < 32; ++kk) {
            const float4 a = *(const float4*)&As[kk][ty * 4], b = *(const float4*)&Bs[kk][tx * 4];
            const float av[4] = {a.x, a.y, a.z, a.w}, bv[4] = {b.x, b.y, b.z, b.w};
#pragma unroll
            for (int i = 0; i < 4; ++i)
#pragma unroll
                for (int j = 0; j < 4; ++j) acc[i][j] += av[i] * bv[j];
        }
        __syncthreads();
    }
#pragma unroll
    for (int i = 0; i < 4; ++i)
#pragma unroll
        for (int j = 0; j < 4; ++j) {
            const size_t o = (size_t)(m0 + ty * 4 + i) * ldc + n0 + tx * 4 + j;
            if (MODE == 0) ((h16*)Cv)[o] = (h16)acc[i][j]; else ((float*)Cv)[o] = resid[o] + acc[i][j];
        }
}

__global__ void __launch_bounds__(256) k_compress(const h16* __restrict__ proj, const float* __restrict__ posk, const float* __restrict__ w1k, const float* __restrict__ w2k,
                                                  const float* __restrict__ posv, const float* __restrict__ w1v, const float* __restrict__ w2v, h16* __restrict__ kcc, h16* __restrict__ vcc) {
    __shared__ float in[32 * 128]; __shared__ float hid[256];
    const int n = blockIdx.x, g = blockIdx.y & 1, kv = blockIdx.y >> 1, b = blockIdx.z, e = threadIdx.x;
    const float* pos = kv ? posv : posk; const float* w1 = kv ? w1v : w1k; const float* w2 = kv ? w2v : w2k; h16* out = kv ? vcc : kcc;
    const int col0 = (kv ? C_VC : C_KC) + g * HD;
    for (int i = e; i < 32 * 128; i += 256) { const int l = i >> 7, d = i & 127; in[i] = (float)proj[(size_t)(b * S + 16 * n + l) * LDP + col0 + d] + pos[i]; }
    __syncthreads();
    float acc = 0.f;
    for (int i = 0; i < 32 * 128; ++i) acc += in[i] * w1[(size_t)i * 256 + e];
    const float u = 0.7978845608028654f * (acc + 0.044715f * acc * acc * acc);
    hid[e] = 0.5f * acc * (1.f + tanhf(u));
    __syncthreads();
    if (e < 128) { float o = 0.f; for (int i = 0; i < 256; ++i) o += hid[i] * w2[i * 128 + e]; out[((size_t)(b * NG + g) * NCBP + n) * HD + e] = (h16)o; }
}

__global__ void __launch_bounds__(64) k_nsa_cmp(const h16* __restrict__ proj, const h16* __restrict__ kcc, const h16* __restrict__ vcc, const float* __restrict__ rel_bias,
                                                float* __restrict__ oc, u64* __restrict__ sel) {
    __shared__ float q[128]; __shared__ float P[4][256];
    const int t = blockIdx.x, g = blockIdx.y, b = blockIdx.z, lane = threadIdx.x; const size_t m = (size_t)b * S + t;
    const int nvalid = t < 31 ? 0 : min((t - 31) / 16 + 1, NCB);
    const h16* kc = kcc + (size_t)(b * NG + g) * NCBP * HD; const h16* vc = vcc + (size_t)(b * NG + g) * NCBP * HD;
    for (int r = 0; r < 4; ++r) {
        const int hh = g * 4 + r;
        __syncthreads();
        q[lane] = (float)proj[m * LDP + C_NQ + hh * HD + lane]; q[lane + 64] = (float)proj[m * LDP + C_NQ + hh * HD + lane + 64];
        __syncthreads();
        float sc[4]; float mx = -1e30f;
#pragma unroll
        for (int i = 0; i < 4; ++i) { const int n = lane + 64 * i; sc[i] = -1e30f;
            if (n < nvalid) { float s = 0.f; for (int d = 0; d < 128; ++d) s += q[d] * (float)kc[(size_t)n * HD + d];
                sc[i] = s * QMUL + rel_bias[rel_bucket(t - (16 * n + 31)) * NHEAD + hh]; }
            mx = fmaxf(mx, sc[i]); }
        mx = wave_max(mx); float l = 0.f;
#pragma unroll
        for (int i = 0; i < 4; ++i) { const int n = lane + 64 * i; sc[i] = (n < nvalid) ? __expf(sc[i] - mx) : 0.f; l += sc[i]; }
        l = wave_sum(l); const float inv = nvalid > 0 ? 1.f / l : 0.f;
#pragma unroll
        for (int i = 0; i < 4; ++i) P[r][lane + 64 * i] = sc[i] * inv;
        __syncthreads();
        float o0 = 0.f, o1 = 0.f;
        for (int n = 0; n < nvalid; ++n) { const float p = P[r][n]; o0 += p * (float)vc[(size_t)n * HD + lane]; o1 += p * (float)vc[(size_t)n * HD + lane + 64]; }
        oc[m * 1024 + hh * HD + lane] = o0; oc[m * 1024 + hh * HD + lane + 64] = o1;
    }
    __syncthreads();
    const int j = lane; float imp = 0.f;
    for (int r = 0; r < 4; ++r) for (int n = 4 * j - 1; n <= 4 * j + 3; ++n) if (n >= 0 && n < NCB) imp += P[r][n];
    const int cur = t >> 6; const bool valid = j * 64 <= t, forced = (j == 0) || (j == cur) || (j == cur - 1);
    const float score = valid ? (forced ? 1e9f : imp) : -1e9f;
    int rank = 0;
    for (int i = 0; i < 64; ++i) { const float si = __shfl(score, i); rank += (si > score) || (si == score && i < j); }
    const u64 mask = __ballot(rank < 16);
    if (lane == 0) sel[m * NG + g] = mask;
}

__global__ void __launch_bounds__(128) k_nsa_selwin(const h16* __restrict__ proj, const float* __restrict__ rel_bias, const u64* __restrict__ sel, const float* __restrict__ oc, float* __restrict__ onsa) {
    __shared__ h16 Kt[64 * 128]; __shared__ h16 Vt[64 * 128]; __shared__ float bt[1024];
    const int cur = blockIdx.x, hh = blockIdx.y, b = blockIdx.z, g = hh >> 2, tid = threadIdx.x, t = cur * 64 + (tid >> 1), d0 = (tid & 1) * 64; const size_t m = (size_t)b * S + t;
    for (int i = tid; i < 1024; i += 128) bt[i] = rel_bias[rel_bucket(i) * NHEAD + hh];
    __syncthreads();
    float q[64];
#pragma unroll
    for (int d = 0; d < 64; ++d) q[d] = (float)proj[m * LDP + C_NQ + hh * HD + d0 + d] * QMUL;
    const u64 mysel = sel[m * NG + g];
    const float g0 = 1.f / (1.f + __expf(-(float)proj[m * LDP + C_GATE + hh * 3 + 0])), g1 = 1.f / (1.f + __expf(-(float)proj[m * LDP + C_GATE + hh * 3 + 1])), g2 = 1.f / (1.f + __expf(-(float)proj[m * LDP + C_GATE + hh * 3 + 2]));
    for (int br = 0; br < 2; ++br) {
        float o[64];
#pragma unroll
        for (int d = 0; d < 64; ++d) o[d] = 0.f;
        float mx = -1e30f, l = 0.f;
        const int kcol = (br ? C_KW : C_KS) + g * HD, vcol = (br ? C_VW : C_VS) + g * HD;
        const int j0 = br ? max(0, cur - 8) : 0;
        for (int j = j0; j <= cur; ++j) {
            const bool act = br ? true : ((mysel >> j) & 1ull) != 0ull;
            if (!__syncthreads_or(act ? 1 : 0)) continue;
            for (int i = tid; i < 64 * 128 / 8; i += 128) { const int r = i >> 4, c = (i & 15) * 8; const size_t row = (size_t)(b * S + j * 64 + r) * LDP;
                *(uint4*)&Kt[r * 128 + c] = *(const uint4*)&proj[row + kcol + c]; *(uint4*)&Vt[r * 128 + c] = *(const uint4*)&proj[row + vcol + c]; }
            __syncthreads();
            for (int c0 = 0; c0 < 64; c0 += 16) {
                float sc[16]; float cm = -1e30f;
#pragma unroll
                for (int kk = 0; kk < 16; ++kk) { const int pos = j * 64 + c0 + kk, dist = t - pos; const bool ok = act && dist >= 0 && (br == 0 || dist < 512);
                    float s = 0.f;
#pragma unroll
                    for (int d = 0; d < 64; ++d) s += q[d] * (float)Kt[(c0 + kk) * 128 + d0 + d];
                    s += __shfl_xor(s, 1);
                    s += bt[min(max(dist, 0), 1023)];
                    sc[kk] = ok ? s : -1e30f; cm = fmaxf(cm, sc[kk]); }
                if (cm > -1e29f) {
                    const float mn = fmaxf(mx, cm), al = __expf(mx - mn); mx = mn; l *= al;
#pragma unroll
                    for (int d = 0; d < 64; ++d) o[d] *= al;
#pragma unroll
                    for (int kk = 0; kk < 16; ++kk) { const float p = sc[kk] > -1e29f ? __expf(sc[kk] - mn) : 0.f; l += p;
#pragma unroll
                        for (int d = 0; d < 64; ++d) o[d] += p * (float)Vt[(c0 + kk) * 128 + d0 + d]; }
                }
            }
        }
        const float inv = 1.f / l;
        float* dst = onsa + m * 1024 + hh * HD + d0; const float* ocr = oc + m * 1024 + hh * HD + d0;
        if (br == 0) {
#pragma unroll
            for (int d = 0; d < 64; ++d) dst[d] = g0 * ocr[d] + g1 * o[d] * inv;
        } else {
#pragma unroll
            for (int d = 0; d < 64; ++d) dst[d] += g2 * o[d] * inv;
        }
    }
}

__global__ void __launch_bounds__(128) k_sb_naive(const h16* __restrict__ proj, float* __restrict__ osb) {
    __shared__ h16 Kt[64 * 128]; __shared__ h16 Vt[64 * 128];
    const int cur = blockIdx.x, h = blockIdx.y, b = blockIdx.z, tid = threadIdx.x, t = cur * 64 + (tid >> 1), d0 = (tid & 1) * 64; const size_t m = (size_t)b * S + t;
    float q[64], o[64];
#pragma unroll
    for (int d = 0; d < 64; ++d) { q[d] = (float)proj[m * LDP + C_SBQ + h * HD + d0 + d] * QMUL; o[d] = 0.f; }
    float cum = 0.f;
    for (int j = cur; j >= 0; --j) {
        __syncthreads();
        for (int i = tid; i < 64 * 128 / 8; i += 128) { const int r = i >> 4, c = (i & 15) * 8; const size_t row = (size_t)(b * S + j * 64 + r) * LDP;
            *(uint4*)&Kt[r * 128 + c] = *(const uint4*)&proj[row + C_SBK + h * HD + c]; *(uint4*)&Vt[r * 128 + c] = *(const uint4*)&proj[row + C_SBV + h * HD + c]; }
        __syncthreads();
        for (int kk = 63; kk >= 0; --kk) {
            const int pos = j * 64 + kk;
            float z = 0.f;
#pragma unroll
            for (int d = 0; d < 64; ++d) z += q[d] * (float)Kt[kk * 128 + d0 + d];
            z += __shfl_xor(z, 1);
            const float sp = fmaxf(z, 0.f) + log1pf(__expf(-fabsf(z)));
            const float log_rest = -sp, log_beta = z - sp;
            const float a = (pos < t) ? __expf(log_beta + cum) : 0.f;
            if (pos < t) cum += log_rest;
#pragma unroll
            for (int d = 0; d < 64; ++d) o[d] += a * (float)Vt[kk * 128 + d0 + d];
        }
    }
#pragma unroll
    for (int d = 0; d < 64; ++d) osb[m * 1024 + h * HD + d0 + d] = o[d];
}

__global__ void __launch_bounds__(256) k_make_y(const float* __restrict__ osb, const float* __restrict__ onsa, const h16* __restrict__ proj, const float* __restrict__ gsb, const float* __restrict__ gnsa, h16* __restrict__ y) {
    const int lane = threadIdx.x & 63, w = (blockIdx.x * blockDim.x + threadIdx.x) >> 6, nw = (gridDim.x * blockDim.x) >> 6;
    for (int i = w; i < 2 * M; i += nw) {
        const int m = i >> 1, part = i & 1;
        const float* src = (part ? onsa : osb) + (size_t)m * 1024; const float* gg = part ? gnsa : gsb; const h16* zz = proj + (size_t)m * LDP + (part ? C_NZ : C_SBZ);
        float v[16]; float s = 0.f;
#pragma unroll
        for (int j = 0; j < 16; ++j) { v[j] = src[lane + 64 * j]; s += v[j] * v[j]; }
        const float r = rsqrtf(wave_sum(s) * (1.f / 1024.f) + RMS_EPS);
#pragma unroll
        for (int j = 0; j < 16; ++j) { const int c = lane + 64 * j; const float z = (float)zz[c]; y[(size_t)m * D + part * 1024 + c] = (h16)(v[j] * r * gg[c] * (z / (1.f + __expf(-z)))); }
    }
}
__global__ void __launch_bounds__(256) k_make_y2(const h16* __restrict__ og, const float* __restrict__ ssq16, const float* __restrict__ onsa, const h16* __restrict__ proj, const float* __restrict__ gnsa, h16* __restrict__ y) {
    const int lane = threadIdx.x & 63, w = (blockIdx.x * blockDim.x + threadIdx.x) >> 6, nw = (gridDim.x * blockDim.x) >> 6;
    for (int i = w; i < 2 * M; i += nw) {
        const int m = i >> 1, part = i & 1;
        if (part == 0) {
            float s = 0.f;
            for (int k = 0; k < 8; ++k) s += ssq16[(size_t)m * 16 + k];
            const float r = rsqrtf(s * (1.f / 1024.f) + RMS_EPS);
            for (int j = 0; j < 16; ++j) { const int c = lane + 64 * j; y[(size_t)m * D + c] = (h16)((float)og[(size_t)m * 2048 + c] * r); }
        } else {
            const float* src = onsa + (size_t)m * 1024; const h16* zz = proj + (size_t)m * LDP + C_NZ;
            float v[16]; float s = 0.f;
#pragma unroll
            for (int j = 0; j < 16; ++j) { v[j] = src[lane + 64 * j]; s += v[j] * v[j]; }
            const float r = rsqrtf(wave_sum(s) * (1.f / 1024.f) + RMS_EPS);
#pragma unroll
            for (int j = 0; j < 16; ++j) { const int c = lane + 64 * j; const float z = (float)zz[c]; y[(size_t)m * D + 1024 + c] = (h16)(v[j] * r * gnsa[c] * (z / (1.f + __expf(-z)))); }
        }
    }
}
__global__ void __launch_bounds__(256) k_final_norm(float* __restrict__ out, const float* __restrict__ g) {
    const int lane = threadIdx.x & 63, w = (blockIdx.x * blockDim.x + threadIdx.x) >> 6, nw = (gridDim.x * blockDim.x) >> 6;
    for (int m = w; m < M; m += nw) {
        float4* xr = (float4*)(out + (size_t)m * D);
        float4 v[8]; float s = 0.f;
#pragma unroll
        for (int j = 0; j < 8; ++j) { v[j] = xr[lane + 64 * j]; s += v[j].x * v[j].x + v[j].y * v[j].y + v[j].z * v[j].z + v[j].w * v[j].w; }
        const float r = rsqrtf(wave_sum(s) * (1.f / D) + RMS_EPS);
#pragma unroll
        for (int j = 0; j < 8; ++j) { const float4 gg = ((const float4*)g)[lane + 64 * j]; xr[lane + 64 * j] = make_float4(v[j].x * r * gg.x, v[j].y * r * gg.y, v[j].z * r * gg.z, v[j].w * r * gg.w); }
    }
}

namespace pg8 {
#define PG8_LAS __attribute__((address_space(3)))
typedef unsigned short bf16_t;
typedef _Float16 bf16x8 __attribute__((ext_vector_type(8)));
typedef float f32x4 __attribute__((ext_vector_type(4)));
typedef unsigned u32x4 __attribute__((ext_vector_type(4)));
constexpr int BM = 256, BK = 64, HALF = 128, HTB = HALF * BK * 2  , STAGE_BYTES = 8 * HTB, NXCD = 8, WGM = 8;

__host__ __device__ __forceinline__ int lds_byte(int r, int c) { const int st = (r >> 4) * 2 + (c >> 5), rr = r & 15, cc = c & 31, ob = rr * 64 + cc * 2; return st * 1024 + (ob ^ (((ob >> 9) & 1) << 5)); }
__host__ __device__ __forceinline__ void stage_rc(int b, int& R, int& C) { const int st = b / 1024, sb = b % 1024, swz = sb ^ (((sb >> 9) & 1) << 5); R = (st >> 1) * 16 + swz / 64; C = (st & 1) * 32 + (swz % 64) / 2; }
__host__ __device__ __forceinline__ int perm32(int rho) { const int n = rho >> 4, i = rho & 15; return 8 * (i >> 2) + 4 * n + (i & 3); }

struct Unit { int pm, pn; };
struct Gemm { const bf16_t* A; const bf16_t* Bt; int M, N, K; };

struct StaticOrder {
    int nM, nN, nwg, G, c;
    __host__ __device__ void init(int M, int N, int G_, int c_) { nM = M / BM; nN = N / BM; nwg = nM * nN; G = G_; c = c_; }
    __host__ __device__ bool next(int i, Unit& u) const {
        const long L = (long)i * G + c; if (L >= nwg) return false;
        int wgid = (int)L; { const int q = nwg / NXCD, r = nwg % NXCD, xcd = wgid % NXCD, off = wgid / NXCD; wgid = (xcd < r ? xcd * (q + 1) : r * (q + 1) + (xcd - r) * q) + off; }
        const int nig = WGM * nN, gid = wgid / nig, fm = gid * WGM, gsz = (nM - fm) < WGM ? (nM - fm) : WGM;
        u.pm = fm + ((wgid % nig) % gsz); u.pn = (wgid % nig) / gsz; return true;
    }
    __device__ __forceinline__ void a_ready(const Unit&) const {}
    __device__ __forceinline__ void done(const Unit&) const {}
};

struct EpiF16 {
    static constexpr bool PERM = true, AFTER_DRAIN = false;
    _Float16* O; int ldc; float qscale;
    __device__ __forceinline__ void operator()(const f32x4 (&acc)[2][2][4][2], const Unit& u, int wr, int wc, int fr, int fq) const {
        const int row0 = u.pm * BM + wr * 64 + fr, col0 = u.pn * BM + wc * 32 + 8 * fq;
        const float s = (u.pn < 4 || (u.pn >= 16 && u.pn < 20)) ? qscale : 1.0f;
#pragma unroll
        for (int ai = 0; ai < 2; ++ai)
#pragma unroll
            for (int m = 0; m < 4; ++m) { _Float16* rowp = O + (size_t)(row0 + ai * HALF + m * 16) * ldc + col0;
#pragma unroll
                for (int bj = 0; bj < 2; ++bj) { const f32x4 v0 = acc[ai][bj][m][0] * s, v1 = acc[ai][bj][m][1] * s;
                    bf16x8 w; w[0] = (_Float16)v0[0]; w[1] = (_Float16)v0[1]; w[2] = (_Float16)v0[2]; w[3] = (_Float16)v0[3]; w[4] = (_Float16)v1[0]; w[5] = (_Float16)v1[1]; w[6] = (_Float16)v1[2]; w[7] = (_Float16)v1[3];
                    *(bf16x8*)(rowp + bj * HALF) = w; } }
    }
};
struct EpiResF32 {
    static constexpr bool PERM = false, AFTER_DRAIN = false;
    const float* resid; float* C; int ldc; float* ssq;
    __device__ __forceinline__ void operator()(const f32x4 (&acc)[2][2][4][2], const Unit& u, int wr, int wc, int fr, int fq) const {
        const int row0 = u.pm * BM + wr * 64 + fr, col0 = u.pn * BM + wc * 32 + 4 * fq;
#pragma unroll
        for (int ai = 0; ai < 2; ++ai)
#pragma unroll
            for (int m = 0; m < 4; ++m) { const int row = row0 + ai * HALF + m * 16; const size_t off = (size_t)row * ldc + col0; float q = 0.f;
#pragma unroll
                for (int bj = 0; bj < 2; ++bj)
#pragma unroll
                    for (int n = 0; n < 2; ++n) { const f32x4 h = *(const f32x4*)(resid + off + bj * HALF + n * 16) + acc[ai][bj][m][n]; *(f32x4*)(C + off + bj * HALF + n * 16) = h;
                        q += (h[0] * h[0] + h[1] * h[1]) + (h[2] * h[2] + h[3] * h[3]); }
                q += __shfl_xor(q, 16); q += __shfl_xor(q, 32);
                if (fq == 0) ssq[(size_t)row * 32 + 4 * u.pn + wc] = q; }
    }
};
template <class Epi, class Sched, bool ALIGN_EPI = false, bool SP2 = false>
__device__ __forceinline__ void gemm_phase(PG8_LAS unsigned char* lds, const Gemm g, const Sched& S, const Epi& E) {
    const int tid = threadIdx.x, wid = __builtin_amdgcn_readfirstlane(tid >> 6), lane = tid & 63, wr = wid >> 2, wc = wid & 3, fr = lane & 15, fq = lane >> 4;
    const int K = g.K, nt = K / BK;
    unsigned voffA[2], voffB[2];
#pragma unroll
    for (int i = 0; i < 2; ++i) { int R, C; stage_rc(tid * 16 + i * 8192, R, C); const int Rb = Epi::PERM ? ((R & ~31) + perm32(R & 31)) : R;
        voffA[i] = (unsigned)(R * K + C) * 2u; voffB[i] = (unsigned)(Rb * K + C) * 2u; }
    const size_t kstep = (size_t)(BK * 2);
    const size_t hstep = (size_t)HALF * K * 2;
    const size_t tstep = 2 * hstep;
    const unsigned ldsw = (unsigned)wid * 1024u;
    const int aoff = lds_byte(wr * 64 + fr, fq * 8), boff = lds_byte(wc * 32 + fr, fq * 8);
#define PG8_SA(b, h) (((b) * 2 + (h)) * HTB)
#define PG8_SB(b, h) ((4 + (b) * 2 + (h)) * HTB)
#define PG8_STAGE(bufoff, gbase, voff) do { _Pragma("unroll") for (int _i = 0; _i < 2; ++_i) \
        __builtin_amdgcn_global_load_lds((const unsigned*)((const char*)(gbase) + (voff)[_i]), (PG8_LAS unsigned*)(lds + (bufoff) + ldsw + _i * 8192), 16, 0, 0); } while (0)
#define PG8_LDA(dst, b, h) do { _Pragma("unroll") for (int m = 0; m < 4; ++m) _Pragma("unroll") for (int k = 0; k < 2; ++k) dst[m][k] = *(const PG8_LAS bf16x8*)(lds + PG8_SA(b, h) + aoff + m * 2048 + k * 1024); } while (0)
#define PG8_LDB(dst, b, h) do { _Pragma("unroll") for (int n = 0; n < 2; ++n) _Pragma("unroll") for (int k = 0; k < 2; ++k) dst[n][k] = *(const PG8_LAS bf16x8*)(lds + PG8_SB(b, h) + boff + n * 2048 + k * 1024); } while (0)
#define PG8_MMA(ai, bj, At, Bt) do { __builtin_amdgcn_s_setprio(1); _Pragma("unroll") for (int m = 0; m < 4; ++m) _Pragma("unroll") for (int n = 0; n < 2; ++n) _Pragma("unroll") for (int k = 0; k < 2; ++k) \
        acc[ai][bj][m][n] = __builtin_amdgcn_mfma_f32_16x16x32_f16(Bt[n][k], At[m][k], acc[ai][bj][m][n], 0, 0, 0); __builtin_amdgcn_s_setprio(0); } while (0)
#define PG8_WAIT_V(n) asm volatile("s_waitcnt vmcnt(" #n ")" ::: "memory")
#define PG8_WAIT_L(n) asm volatile("s_waitcnt lgkmcnt(" #n ")" ::: "memory")
#define PG8_BAR __builtin_amdgcn_s_barrier()
#define PG8_SCHED __builtin_amdgcn_sched_barrier(0)
    Unit cur, nxt; int ui = 0;
    if (!S.next(0, cur)) return;
    f32x4 acc[2][2][4][2];
#pragma unroll
    for (int a = 0; a < 2; ++a)
#pragma unroll
        for (int b = 0; b < 2; ++b)
#pragma unroll
            for (int m = 0; m < 4; ++m)
#pragma unroll
                for (int n = 0; n < 2; ++n) acc[a][b][m][n] = (f32x4){0.f, 0.f, 0.f, 0.f};
    bf16x8 At[4][2], B0[2][2], B1[2][2];
    const char* cA = (const char*)g.A + (size_t)cur.pm * tstep; const char* cB = (const char*)g.Bt + (size_t)cur.pn * tstep;
    S.a_ready(cur);
    if constexpr (SP2) {
        PG8_STAGE(PG8_SB(0, 0), cB, voffB); PG8_STAGE(PG8_SB(0, 1), cB + hstep, voffB); PG8_STAGE(PG8_SA(0, 0), cA, voffA); PG8_STAGE(PG8_SA(0, 1), cA + hstep, voffA);
        if (wr == 1) PG8_BAR;
        PG8_WAIT_V(2); PG8_BAR;
        PG8_STAGE(PG8_SB(1, 0), cB + kstep, voffB); PG8_STAGE(PG8_SA(1, 0), cA + kstep, voffA); PG8_STAGE(PG8_SB(1, 1), cB + hstep + kstep, voffB);
        PG8_WAIT_V(6); PG8_BAR;
    } else {
        PG8_STAGE(PG8_SB(0, 0), cB, voffB); PG8_STAGE(PG8_SA(0, 0), cA, voffA); PG8_STAGE(PG8_SB(0, 1), cB + hstep, voffB); PG8_STAGE(PG8_SA(0, 1), cA + hstep, voffA);
        if (wr == 1) PG8_BAR;
        PG8_WAIT_V(4); PG8_BAR;
        PG8_STAGE(PG8_SB(1, 0), cB + kstep, voffB); PG8_STAGE(PG8_SA(1, 0), cA + kstep, voffA); PG8_STAGE(PG8_SB(1, 1), cB + hstep + kstep, voffB);
        PG8_WAIT_V(6); PG8_BAR;
    }
    for (;;) {
        const bool has_next = S.next(ui + 1, nxt);
        const char* nA = has_next ? (const char*)g.A + (size_t)nxt.pm * tstep : cA; const char* nB = has_next ? (const char*)g.Bt + (size_t)nxt.pn * tstep : cB;
        for (int t = 0; t < nt; t += 2) {
            const bool last = (t == nt - 2);
            const char* a1 = cA + (size_t)(t + 1) * kstep;
            const char* a2 = last ? nA : cA + (size_t)(t + 2) * kstep; const char* b2 = last ? nB : cB + (size_t)(t + 2) * kstep;
            const char* a3 = a2 + kstep; const char* b3 = b2 + kstep;
            if (last && has_next) S.a_ready(nxt);
            if constexpr (SP2) {
            PG8_LDB(B0, 0, 0); PG8_LDB(B1, 0, 1); PG8_SCHED; PG8_LDA(At, 0, 0); PG8_STAGE(PG8_SA(1, 1), a1 + hstep, voffA);
            PG8_WAIT_V(8); PG8_WAIT_L(0); PG8_BAR; PG8_MMA(0, 0, At, B0); PG8_MMA(0, 1, At, B1); PG8_BAR; PG8_SCHED;
            PG8_LDA(At, 0, 1); PG8_STAGE(PG8_SB(0, 0), b2, voffB); PG8_STAGE(PG8_SB(0, 1), b2 + hstep, voffB); PG8_STAGE(PG8_SA(0, 0), a2, voffA);
            PG8_WAIT_V(8); PG8_WAIT_L(0); PG8_BAR; PG8_MMA(1, 0, At, B0); PG8_MMA(1, 1, At, B1); PG8_BAR; PG8_SCHED;
            PG8_LDB(B0, 1, 0); PG8_LDB(B1, 1, 1); PG8_SCHED; PG8_LDA(At, 1, 0); PG8_STAGE(PG8_SA(0, 1), a2 + hstep, voffA);
            PG8_WAIT_V(8); PG8_WAIT_L(0); PG8_BAR; PG8_MMA(0, 0, At, B0); PG8_MMA(0, 1, At, B1); PG8_BAR; PG8_SCHED;
            PG8_LDA(At, 1, 1); PG8_STAGE(PG8_SB(1, 0), b3, voffB); PG8_STAGE(PG8_SB(1, 1), b3 + hstep, voffB); PG8_STAGE(PG8_SA(1, 0), a3, voffA);
            PG8_WAIT_V(8); PG8_WAIT_L(0); PG8_BAR; PG8_MMA(1, 0, At, B0); PG8_MMA(1, 1, At, B1); PG8_BAR; PG8_SCHED;
            } else {
            PG8_LDB(B0, 0, 0); PG8_SCHED; PG8_LDA(At, 0, 0); PG8_STAGE(PG8_SA(1, 1), a1 + hstep, voffA);
            PG8_WAIT_L(8); PG8_BAR; PG8_WAIT_L(0); PG8_MMA(0, 0, At, B0); PG8_BAR; PG8_SCHED;
            PG8_LDB(B1, 0, 1); PG8_STAGE(PG8_SB(0, 0), b2, voffB);
            PG8_BAR; PG8_WAIT_L(0); PG8_MMA(0, 1, At, B1); PG8_BAR;
            PG8_LDA(At, 0, 1); PG8_STAGE(PG8_SA(0, 0), a2, voffA);
            PG8_BAR; PG8_WAIT_L(0); PG8_MMA(1, 0, At, B0); PG8_BAR; PG8_SCHED;
            PG8_STAGE(PG8_SB(0, 1), b2 + hstep, voffB);
            PG8_WAIT_V(6); PG8_BAR; PG8_MMA(1, 1, At, B1); PG8_BAR;
            PG8_LDB(B0, 1, 0); PG8_SCHED; PG8_LDA(At, 1, 0); PG8_STAGE(PG8_SA(0, 1), a2 + hstep, voffA);
            PG8_WAIT_L(8); PG8_BAR; PG8_WAIT_L(0); PG8_MMA(0, 0, At, B0); PG8_BAR; PG8_SCHED;
            PG8_LDB(B1, 1, 1); PG8_STAGE(PG8_SB(1, 0), b3, voffB);
            PG8_BAR; PG8_WAIT_L(0); PG8_MMA(0, 1, At, B1); PG8_BAR;
            PG8_LDA(At, 1, 1); PG8_STAGE(PG8_SA(1, 0), a3, voffA);
            PG8_BAR; PG8_WAIT_L(0); PG8_MMA(1, 0, At, B0); PG8_BAR; PG8_SCHED;
            PG8_STAGE(PG8_SB(1, 1), b3 + hstep, voffB);
            PG8_WAIT_V(6); PG8_BAR; PG8_MMA(1, 1, At, B1); PG8_BAR;
            }
        }
        if constexpr (ALIGN_EPI) { if (wr == 0) PG8_BAR; }
        if constexpr (!Epi::AFTER_DRAIN) { E(acc, cur, wr, wc, fr, fq); S.done(cur); }
        if (!has_next) break;
#pragma unroll
        for (int a = 0; a < 2; ++a)
#pragma unroll
            for (int b = 0; b < 2; ++b)
#pragma unroll
                for (int m = 0; m < 4; ++m)
#pragma unroll
                    for (int n = 0; n < 2; ++n) acc[a][b][m][n] = (f32x4){0.f, 0.f, 0.f, 0.f};
        cur = nxt; cA = nA; cB = nB; ++ui;
        if constexpr (ALIGN_EPI) { if (wr == 1) PG8_BAR; }
    }
    PG8_WAIT_V(0);
    if constexpr (!ALIGN_EPI) { if (wr == 0) PG8_BAR; }
    PG8_BAR;
    if constexpr (Epi::AFTER_DRAIN) { E.fused(acc, cur, wr, wc, fr, fq, lds, wid, lane); S.done(cur); }
#undef PG8_SA
#undef PG8_SB
#undef PG8_STAGE
#undef PG8_LDA
#undef PG8_LDB
#undef PG8_MMA
#undef PG8_WAIT_V
#undef PG8_WAIT_L
#undef PG8_BAR
#undef PG8_SCHED
}
}

#define GAS __attribute__((address_space(1)))
#define LAS __attribute__((address_space(3)))
typedef unsigned v4u __attribute__((ext_vector_type(4)));
#define LDS_WAIT() asm volatile("s_waitcnt lgkmcnt(0)" ::: "memory")
#define VM_WAIT() asm volatile("s_waitcnt vmcnt(0)" ::: "memory")
constexpr int NWAVES = 8, NTHR = NWAVES * 64;
constexpr int RING_OFF = 0, RING_BYTES = 131072;
constexpr int LDSCTL_OFF = RING_BYTES, MISC_OFF = LDSCTL_OFF + 320;
constexpr int LDS_BYTES = 147456;
constexpr int CW_BAR = 4096;
constexpr size_t CTL_ZERO_BYTES = 65536;

#define XB_TMO      128
#define XB_XCNT(j)  (256  + 64 * (j))
#define XB_XSUB(j)  (1280 + 64 * (j))
#define XB_XGEN(j)  (2304 + 64 * (j))
#define XB_TOP      3328
#define XB_TOPGEN   3392
#define XCD_BAR_WORDS 3456
#define XB_SPIN_CAP (1u << 18)

__device__ __forceinline__ unsigned xb_ld(unsigned* p)              { return __hip_atomic_load(p, __ATOMIC_RELAXED, __HIP_MEMORY_SCOPE_AGENT); }
__device__ __forceinline__ unsigned xb_add(unsigned* p, unsigned v) { return __hip_atomic_fetch_add(p, v, __ATOMIC_RELAXED, __HIP_MEMORY_SCOPE_AGENT); }
__device__ __forceinline__ unsigned xb_xcc_id() { return (unsigned)__builtin_amdgcn_s_getreg((3 << 11) | 20) & 0xFu; }
#define XB_SPIN(cond, bar) do { unsigned _sp = 0; while (cond) { __builtin_amdgcn_s_sleep(1); \
    if ((++_sp & 255u) == 0u) { if (xb_ld(&(bar)[XB_TMO])) break; if (_sp > XB_SPIN_CAP) { atomicAdd(&(bar)[XB_TMO], 1u); break; } } } } while (0)

struct XcdBarrier {
    unsigned* bar; unsigned x;
    volatile LAS unsigned* st;
};

__device__ __forceinline__ XcdBarrier xcd_barrier_post(unsigned* bar, volatile LAS unsigned* st) {
    XcdBarrier b; b.bar = bar; b.x = xb_xcc_id(); b.st = st;
    if (threadIdx.x == 0) (void)xb_add(&bar[XB_XCNT(b.x)], 1u);
    return b;
}
__device__ __forceinline__ void xcd_barrier_complete(unsigned* bar, unsigned x, unsigned& nloc, unsigned& nx) {
    const unsigned G = gridDim.x * gridDim.y * gridDim.z;
    unsigned sum, cnt, mine, sp = 0u;
    for (;;) {
        sum = 0u; cnt = 0u; mine = 0u;
#pragma unroll
        for (unsigned j = 0; j < 16; ++j) { const unsigned c = xb_ld(&bar[XB_XCNT(j)]); sum += c; cnt += (c > 0u) ? 1u : 0u; mine = (j == x) ? c : mine; }
        if (sum == G) break;
        __builtin_amdgcn_s_sleep(1);
        if ((++sp & 255u) == 0u) { if (xb_ld(&bar[XB_TMO])) break; if (sp > XB_SPIN_CAP) { atomicAdd(&bar[XB_TMO], 1u); break; } }
    }
    nloc = mine > 0u ? mine : 1u; nx = cnt > 0u ? cnt : 1u;
}

__device__ __forceinline__ void xcd_barrier(const XcdBarrier& b) {
    asm volatile("s_waitcnt vmcnt(0)" ::: "memory");
    __syncthreads();
    if (threadIdx.x == 0) {
        unsigned* bar = b.bar;
        __builtin_amdgcn_s_waitcnt(0);
        unsigned nloc = b.st[0], nx = b.st[1];
        if (nloc == 0u) { xcd_barrier_complete(bar, b.x, nloc, nx); b.st[0] = nloc; b.st[1] = nx; }
        const unsigned old = xb_add(&bar[XB_XSUB(b.x)], 1u);
        const unsigned gen = old / nloc;
        if (old + 1u == (gen + 1u) * nloc) {
            __builtin_amdgcn_fence(__ATOMIC_RELEASE, "agent");
            asm volatile("s_waitcnt vmcnt(0)" ::: "memory");
            const unsigned og = xb_add(&bar[XB_TOP], 1u);
            const unsigned tg = og / nx;
            if (og + 1u == (tg + 1u) * nx) xb_add(&bar[XB_TOPGEN], 1u);
            else XB_SPIN(xb_ld(&bar[XB_TOPGEN]) == tg, bar);
            __builtin_amdgcn_fence(__ATOMIC_ACQUIRE, "agent");
            xb_add(&bar[XB_XGEN(b.x)], 1u);
            asm volatile("s_waitcnt vmcnt(0)" ::: "memory");
        } else {
            XB_SPIN(xb_ld(&bar[XB_XGEN(b.x)]) == gen, bar);
            __builtin_amdgcn_fence(__ATOMIC_ACQUIRE, "agent");
            asm volatile("s_waitcnt vmcnt(0)" ::: "memory");
        }
    }
    __syncthreads();
}

static_assert((CW_BAR + XCD_BAR_WORDS) * 4 <= (int)CTL_ZERO_BYTES, "barrier words inside the memset region");

__device__ __forceinline__ unsigned pk2h(float lo, float hi) { typedef _Float16 h2 __attribute__((ext_vector_type(2))); h2 v; v[0] = (_Float16)lo; v[1] = (_Float16)hi; return __builtin_bit_cast(unsigned, v); }

__device__ __forceinline__ void p0_transpose_item(const float* W, int K, int ldw, bool remap, h16* WT, LAS float* scr, int item, int nblk, int lane) {
    const int kb = item / nblk, nb = item % nblk, k0 = 64 * kb, n0 = 32 * nb;
    const int n = n0 + (lane & 31), sc = remap ? src_col(n) : n;
#pragma unroll 8
    for (int i = 0; i < 32; ++i) { const int kk = 2 * i + (lane >> 5); scr[kk * 33 + (lane & 31)] = sc >= 0 ? W[(size_t)(k0 + kk) * ldw + sc] : 0.f; }
    LDS_WAIT(); asm volatile("" ::: "memory");
    const int c = lane & 7;
#pragma unroll
    for (int j = 0; j < 4; ++j) { const int nn = (lane >> 3) + 8 * j; const LAS float* s = scr + (8 * c) * 33 + nn;
        v4u o; o.x = pk2h(s[0 * 33], s[1 * 33]); o.y = pk2h(s[2 * 33], s[3 * 33]); o.z = pk2h(s[4 * 33], s[5 * 33]); o.w = pk2h(s[6 * 33], s[7 * 33]);
        *(GAS v4u*)(WT + (size_t)(n0 + nn) * K + k0 + 8 * c) = o; }
    LDS_WAIT(); asm volatile("" ::: "memory");
}
typedef float f32x4v __attribute__((ext_vector_type(4)));
typedef unsigned u32x2v __attribute__((ext_vector_type(2)));
__device__ __forceinline__ void p0_rms_row(const float* xrow, const float* g, h16* orow, int lane) {
    const f32x4v* xr = (const f32x4v*)xrow + lane; const f32x4v* gr = (const f32x4v*)g + lane;
    f32x4v v[8]; float s = 0.f;
#pragma unroll
    for (int j = 0; j < 8; ++j) { v[j] = xr[64 * j]; s += (v[j][0] * v[j][0] + v[j][1] * v[j][1]) + (v[j][2] * v[j][2] + v[j][3] * v[j][3]); }
    const float r = rsqrtf(wave_sum(s) * (1.f / D) + RMS_EPS);
    u32x2v* o8 = (u32x2v*)orow + lane;
#pragma unroll
    for (int j = 0; j < 8; ++j) { const f32x4v gg = gr[64 * j]; u32x2v w; w[0] = pk2h(v[j][0] * r * gg[0], v[j][1] * r * gg[1]); w[1] = pk2h(v[j][2] * r * gg[2], v[j][3] * r * gg[3]); o8[64 * j] = w; }
}


typedef _Float16 h16x4 __attribute__((ext_vector_type(4)));
typedef _Float16 h16x8 __attribute__((ext_vector_type(8)));
typedef short s16x4 __attribute__((ext_vector_type(4)));
typedef float f32x16 __attribute__((ext_vector_type(16)));
constexpr int AT_BUF = 32768, AT_V = 16384;
__device__ __forceinline__ unsigned offb(unsigned row, unsigned ch) { return 256u * row + 16u * (ch ^ (((row & 3u) << 2) | ((row >> 2) & 3u))); }
__device__ __forceinline__ h16x4 tr_read(LAS unsigned char* p) { return __builtin_bit_cast(h16x4, __builtin_amdgcn_ds_read_tr16_b64_v4i16((LAS s16x4*)p)); }
__device__ __forceinline__ int crow(int i, int h) { return (i & 3) + 8 * (i >> 2) + 4 * h; }
__device__ __forceinline__ void tile_gload(const h16* gK, const h16* gV, size_t pitch, v4u (&kr)[2], v4u (&vr)[2], int tid) {
#pragma unroll
    for (int i = 0; i < 2; ++i) { const int cidx = tid + 512 * i, row = cidx >> 4, ch = cidx & 15; kr[i] = *(const v4u*)(gK + (size_t)row * pitch + ch * 8); vr[i] = *(const v4u*)(gV + (size_t)row * pitch + ch * 8); }
}
__device__ __forceinline__ void tile_lstore(LAS unsigned char* buf, const v4u (&kr)[2], const v4u (&vr)[2], int tid) {
#pragma unroll
    for (int i = 0; i < 2; ++i) { const int cidx = tid + 512 * i, row = cidx >> 4, ch = cidx & 15; const unsigned o = offb(row, ch); *(LAS v4u*)(buf + o) = kr[i]; *(LAS v4u*)(buf + AT_V + o) = vr[i]; }
}
__device__ __forceinline__ f32x16 qk_block(LAS unsigned char* KT, int kb, const h16x8 (&qf)[8], int lane) {
    f32x16 sacc;
#pragma unroll
    for (int i = 0; i < 16; ++i) sacc[i] = 0.f;
    const unsigned r = 32u * kb + (lane & 31), h = lane >> 5;
#pragma unroll
    for (int s = 0; s < 8; ++s) { const h16x8 kf = *(const LAS h16x8*)(KT + offb(r, 2 * s + h)); sacc = __builtin_amdgcn_mfma_f32_32x32x16_f16(kf, qf[s], sacc, 0, 0, 0); }
    return sacc;
}
__device__ __forceinline__ void pv_block(LAS unsigned char* VT, int kb, const h16x8 (&pf)[2], f32x16 (&oacc)[4], int lane) {
    const unsigned h = lane >> 5, blk = (lane >> 4) & 1, q = (lane & 15) >> 2, p = lane & 3;
#pragma unroll
    for (int c = 0; c < 4; ++c)
#pragma unroll
        for (int s = 0; s < 2; ++s) {
            const unsigned r0 = 32u * kb + 16u * s + 4u * h + q, ch = 4u * c + 2u * blk + (p >> 1);
            const h16x4 lo = tr_read(VT + offb(r0, ch) + 8u * (p & 1)), hi = tr_read(VT + offb(r0 + 8u, ch) + 8u * (p & 1));
            const h16x8 vf = __builtin_shufflevector(lo, hi, 0, 1, 2, 3, 4, 5, 6, 7);
            oacc[c] = __builtin_amdgcn_mfma_f32_32x32x16_f16(vf, pf[s], oacc[c], 0, 0, 0);
        }
}
__device__ __forceinline__ float lane_partner(float x) {
    const auto r = __builtin_amdgcn_permlane32_swap(__builtin_bit_cast(unsigned, x), __builtin_bit_cast(unsigned, x), false, false);
    return __builtin_bit_cast(float, (threadIdx.x & 32) ? r[0] : r[1]);
}
template <bool DIAG>
__device__ __forceinline__ void sb_weights(const f32x16& sacc, h16x8 (&pf)[2], float& C, int lane, int pos0, int t) {
    const int h = lane >> 5;
    float E[16], T[4], m1[4], m2[4], f0[4];
#pragma unroll
    for (int i = 0; i < 16; ++i) { float e = __builtin_amdgcn_exp2f(fminf(sacc[i], 24.f)); if (DIAG) e = (pos0 + crow(i, h) < t) ? e : 0.f; E[i] = e; }
#pragma unroll
    for (int g = 0; g < 4; ++g) { f0[g] = 1.f + E[4 * g]; m1[g] = f0[g] * (1.f + E[4 * g + 1]); m2[g] = m1[g] * (1.f + E[4 * g + 2]); T[g] = m2[g] * (1.f + E[4 * g + 3]); }
    float U[4], TPs[4];
#pragma unroll
    for (int g = 0; g < 4; ++g) { const float tp = lane_partner(T[g]); U[g] = T[g] * tp; TPs[g] = h ? 1.f : tp; }
    float V[4]; V[3] = C; V[2] = V[3] * U[3]; V[1] = V[2] * U[2]; V[0] = V[1] * U[1]; C = V[0] * U[0];
    float a[16];
#pragma unroll
    for (int g = 0; g < 4; ++g) { const float r = __builtin_amdgcn_rcpf(T[g] * (V[g] * TPs[g]));
        a[4 * g] = E[4 * g] * r; a[4 * g + 1] = E[4 * g + 1] * (r * f0[g]); a[4 * g + 2] = E[4 * g + 2] * (r * m1[g]); a[4 * g + 3] = E[4 * g + 3] * (r * m2[g]); }
#pragma unroll
    for (int s = 0; s < 2; ++s)
#pragma unroll
        for (int j = 0; j < 8; ++j) pf[s][j] = (_Float16)a[8 * s + j];
}
__device__ __forceinline__ void sb_attn_unit(LAS unsigned char* lds, const h16* PROJ, const float* gsb, h16* OG, float* SSQ16, int b, int head, int qt, int tid, int lane, int wave) {
    const int h = lane >> 5, n = lane & 31, q0 = 256 * qt + 32 * wave, t = q0 + n;
    const size_t mrow = (size_t)b * S + t;
    h16x8 qf[8];
#pragma unroll
    for (int s = 0; s < 8; ++s) qf[s] = *(const h16x8*)(PROJ + mrow * LDP + C_SBQ + head * HD + 16 * s + 8 * h);
    f32x16 oacc[4];
#pragma unroll
    for (int c = 0; c < 4; ++c)
#pragma unroll
        for (int i = 0; i < 16; ++i) oacc[c][i] = 0.f;
    float C = 1.f;
    const int jmax = 4 * qt + 3;
    const h16* gK = PROJ + (size_t)b * S * LDP + C_SBK + head * HD; const h16* gV = PROJ + (size_t)b * S * LDP + C_SBV + head * HD;
    v4u kr[2], vr[2];
    __syncthreads();
    tile_gload(gK + (size_t)(64 * jmax) * LDP, gV + (size_t)(64 * jmax) * LDP, LDP, kr, vr, tid);
    tile_lstore(lds, kr, vr, tid);
    __syncthreads();
    for (int j = jmax; j >= 0; --j) {
        LAS unsigned char* buf = lds + ((jmax - j) & 1) * AT_BUF;
        if (j > 0) tile_gload(gK + (size_t)(64 * (j - 1)) * LDP, gV + (size_t)(64 * (j - 1)) * LDP, LDP, kr, vr, tid);
#pragma unroll
        for (int kb = 1; kb >= 0; --kb) {
            const int pos0 = 64 * j + 32 * kb;
            if (pos0 < q0 + 31) {
                const f32x16 sacc = qk_block(buf, kb, qf, lane);
                h16x8 pf[2];
                if (pos0 + 31 >= q0) sb_weights<true>(sacc, pf, C, lane, pos0, t); else sb_weights<false>(sacc, pf, C, lane, pos0, t);
                pv_block(buf + AT_V, kb, pf, oacc, lane);
            }
        }
        if (j > 0) tile_lstore(lds + (((jmax - j) & 1) ^ 1) * AT_BUF, kr, vr, tid);
        __syncthreads();
    }
    float ss = 0.f;
#pragma unroll
    for (int c = 0; c < 4; ++c)
#pragma unroll
        for (int i = 0; i < 16; ++i) ss += oacc[c][i] * oacc[c][i];
    ss += lane_partner(ss);
    if (h == 0) SSQ16[mrow * 16 + head] = ss;
#pragma unroll
    for (int c = 0; c < 4; ++c)
#pragma unroll
        for (int g = 0; g < 4; ++g) {
            const int d0 = 32 * c + 8 * g + 4 * h;
            const h16x4 z4 = *(const h16x4*)(PROJ + mrow * LDP + C_SBZ + head * HD + d0); const f32x4v g4 = *(const f32x4v*)(gsb + head * HD + d0);
            h16x4 o4;
#pragma unroll
            for (int e = 0; e < 4; ++e) { const float z = (float)z4[e]; o4[e] = (_Float16)(oacc[c][4 * g + e] * g4[e] * (z / (1.f + __expf(-z)))); }
            *(h16x4*)(OG + mrow * 2048 + head * HD + d0) = o4;
        }
}

struct Args { const float* in[14]; float* out; unsigned char* ws; int ph_lo, ph_hi; };

__global__ void __launch_bounds__(NTHR, 2) fwd(Args args) {
    extern __shared__ __attribute__((aligned(16))) unsigned char lds_raw[];
    LAS unsigned char* lds = (LAS unsigned char*)lds_raw;
    volatile LAS unsigned* MISC = (volatile LAS unsigned*)(lds + MISC_OFF);
    const int tid = threadIdx.x, lane = tid & 63, wave = __builtin_amdgcn_readfirstlane(tid >> 6);
    const int G = gridDim.x; const int bx = blockIdx.x; const int vcu = (G % 8 == 0) ? (bx % 8) * (G / 8) + bx / 8 : bx;
    unsigned char* ws = args.ws;
    unsigned* ctl = (unsigned*)(ws + WS_CTL);
    for (int u = tid; u < (LDS_BYTES - LDSCTL_OFF) / 4; u += NTHR) ((LAS unsigned*)(lds + LDSCTL_OFF))[u] = 0u;
    __syncthreads();
    XcdBarrier bar = xcd_barrier_post(ctl + CW_BAR, MISC + 8);
    const int lo = args.ph_lo, hi = args.ph_hi;
#define IN(k) (lo <= (k) && (k) < hi)
#define BOTH(k) (IN(k) && IN((k) + 1))
    h16* XN = (h16*)(ws + WS_XN); h16* WINT = (h16*)(ws + WS_WINT); h16* WOUTT = (h16*)(ws + WS_WOUTT); h16* PROJ = (h16*)(ws + WS_PROJ);

    if (IN(0)) {
        LAS float* scr = (LAS float*)(lds + RING_OFF + wave * 16384);
        const int gw = vcu * NWAVES + wave, NGW = G * NWAVES;
        constexpr int I_IN = (D / 64) * (LDP / 32), I_OUT = (D / 64) * (D / 32);
        for (int it = gw; it < I_IN + I_OUT; it += NGW) {
            if (it < I_IN) p0_transpose_item(args.in[2], D, NPROJ, true, WINT, scr, it, LDP / 32, lane);
            else p0_transpose_item(args.in[12], D, D, false, WOUTT, scr, it - I_IN, D / 32, lane);
        }
        for (int m = gw; m < M; m += NGW) p0_rms_row(args.in[0] + (size_t)m * D, args.in[1], XN + (size_t)m * D, lane);
        if (BOTH(0)) xcd_barrier(bar);
    }
    if (IN(1)) {
        pg8::Gemm g{(const pg8::bf16_t*)XN, (const pg8::bf16_t*)WINT, M, LDP, D}; pg8::StaticOrder SO; SO.init(M, LDP, G, bx);
        pg8::EpiF16 E{PROJ, LDP, QSCALE};
        pg8::gemm_phase<pg8::EpiF16, pg8::StaticOrder, true, true>(lds + RING_OFF, g, SO, E);
        if (BOTH(1)) xcd_barrier(bar);
    }
    if (IN(2)) {
        h16* OG = (h16*)(ws + WS_OG); float* SSQ16 = (float*)(ws + WS_SSQ16);
        for (int idx = vcu; idx < 1024; idx += G) {
            const int r = idx >> 8, v = idx & 255, c = v >> 6, bh = v & 63;
            const int qt = (r == 0) ? 15 - c : (r == 1) ? 8 + c : (r == 2) ? 7 - c : c;
            sb_attn_unit(lds + RING_OFF, PROJ, args.in[10], OG, SSQ16, bh >> 3, bh & 7, qt, tid, lane, wave);
        }
        if (BOTH(2)) xcd_barrier(bar);
    }
#undef IN
#undef BOTH
}

extern "C" void kernel_launch(void* const* d_in, const int* in_sizes, int n_in, void* d_out, int out_size, void* d_ws, size_t ws_size, hipStream_t stream) {
    static int grid = 0;
    if (grid == 0) {
        if (n_in != 14 || in_sizes[0] != M * D || out_size != M * D || ws_size < WS_END) { fprintf(stderr, "kernel_launch: unexpected shapes (n_in %d in0 %d out %d ws %zu need %zu)\n", n_in, n_in > 0 ? in_sizes[0] : -1, out_size, ws_size, (size_t)WS_END); grid = -1; return; }
        int dev = 0, cus = 0, per_cu = 0;
        if (hipGetDevice(&dev) != hipSuccess || hipDeviceGetAttribute(&cus, hipDeviceAttributeMultiprocessorCount, dev) != hipSuccess) { grid = -1; return; }
        if (hipFuncSetAttribute((const void*)fwd, hipFuncAttributeMaxDynamicSharedMemorySize, LDS_BYTES) != hipSuccess) { fprintf(stderr, "kernel_launch: hipFuncSetAttribute failed\n"); grid = -1; return; }
        if (hipOccupancyMaxActiveBlocksPerMultiprocessor(&per_cu, (const void*)fwd, NTHR, LDS_BYTES) != hipSuccess || per_cu < 1) { fprintf(stderr, "kernel_launch: occupancy query says %d blocks per CU\n", per_cu); grid = -1; return; }
        (void)hipGetLastError();
        grid = cus;
    }
    if (grid < 0) return;
    const float* x = (const float*)d_in[0];
    const float* kpos = (const float*)d_in[3]; const float* kw1 = (const float*)d_in[4]; const float* kw2 = (const float*)d_in[5];
    const float* vpos = (const float*)d_in[6]; const float* vw1 = (const float*)d_in[7]; const float* vw2 = (const float*)d_in[8];
    const float* rel_bias = (const float*)d_in[9]; const float* norm_sb = (const float*)d_in[10]; const float* norm_nsa = (const float*)d_in[11];
    const float* norm_final = (const float*)d_in[13];
    unsigned char* ws = (unsigned char*)d_ws; float* out = (float*)d_out;
    h16* XN = (h16*)(ws + WS_XN); h16* WOUTT = (h16*)(ws + WS_WOUTT); h16* PROJ = (h16*)(ws + WS_PROJ);
    h16* KCC = (h16*)(ws + WS_KCC); h16* VCC = (h16*)(ws + WS_VCC); u64* SEL = (u64*)(ws + WS_SEL); float* OC = (float*)(ws + WS_OC);
    float* ONSA = out + (size_t)M * 1024;

    (void)hipMemsetAsync(ws + WS_CTL, 0, CTL_ZERO_BYTES, stream);
    Args a{};
    for (int i = 0; i < 14; ++i) a.in[i] = (const float*)d_in[i];
    a.out = out; a.ws = ws; a.ph_lo = 0; a.ph_hi = 3;
    hipLaunchKernelGGL(fwd, dim3(grid), dim3(NTHR), LDS_BYTES, stream, a);
    k_compress<<<dim3(NCB, 4, NB), 256, 0, stream>>>(PROJ, kpos, kw1, kw2, vpos, vw1, vw2, KCC, VCC);
    k_nsa_cmp<<<dim3(S, NG, NB), 64, 0, stream>>>(PROJ, KCC, VCC, rel_bias, OC, SEL);
    k_nsa_selwin<<<dim3(S / 64, NHEAD, NB), 128, 0, stream>>>(PROJ, rel_bias, SEL, OC, ONSA);
    k_make_y2<<<2048, 256, 0, stream>>>((const h16*)(ws + WS_OG), (const float*)(ws + WS_SSQ16), ONSA, PROJ, norm_nsa, XN  );
    k_gemm_naive<1><<<dim3(D / 64, M / 64), 256, 0, stream>>>(XN, WOUTT, out, x, D, D);
    k_final_norm<<<2048, 256, 0, stream>>>(out, norm_final);
}
```

```cpp
#include <hip/hip_runtime.h>
#include <cstdio>
#include <cstdint>

typedef _Float16 h16;
typedef unsigned long long u64;

constexpr int NB = 8, S = 4096, D = 2048, M = NB * S;
constexpr int HD = 128, NHEAD = 8, NG = 2, NR = 4;
constexpr int NPROJ = 7704, LDP = 7936;
constexpr int C_SBQ = 0, C_SBK = 1024, C_SBV = 2048, C_SBZ = 3072, C_NQ = 4096, C_KC = 5120, C_VC = 5376, C_KS = 5632, C_VS = 5888,
              C_KW = 6144, C_VW = 6400, C_NZ = 6656, C_GATE = 7680;
constexpr int NCB = 255, NCBP = 256;
constexpr float RMS_EPS = 1e-6f;
constexpr float QSCALE = 0.08838834764831845f * 1.4426950408889634f;
constexpr float QMUL = 0.6931471805599453f;

constexpr size_t MiB = 1u << 20;
constexpr size_t WS_CTL = 0;
constexpr size_t WS_XN = 1 * MiB;
constexpr size_t WS_WINT = WS_XN + (size_t)M * D * 2;
constexpr size_t WS_WOUTT = WS_WINT + (size_t)LDP * D * 2;
constexpr size_t WS_PROJ = WS_WOUTT + (size_t)D * D * 2;
constexpr size_t WS_KCC = WS_PROJ + (size_t)M * LDP * 2;
constexpr size_t WS_VCC = WS_KCC + (size_t)NB * NG * NCBP * HD * 2;
constexpr size_t WS_SEL = WS_VCC + (size_t)NB * NG * NCBP * HD * 2;
constexpr size_t WS_OC = WS_SEL + (size_t)M * NG * 8;
constexpr size_t WS_SSQ = WS_OC + (size_t)M * 1024 * 4;
constexpr size_t WS_OG = WS_SSQ + (size_t)M * 32 * 4;
constexpr size_t WS_SSQ16 = WS_OG + (size_t)M * 2048 * 2;
constexpr size_t WS_END = WS_SSQ16 + (size_t)M * 16 * 4;

__device__ __forceinline__ int src_col(int c) { return c < 6656 ? c : (c < 7680 ? c + 24 : (c < NPROJ ? c - 1024 : -1)); }

__device__ __forceinline__ int rel_bucket(int dist) {
    if (dist < 16) return dist < 0 ? 0 : dist;
    int b = 16;
    b += dist >= 21; b += dist >= 27; b += dist >= 35; b += dist >= 46; b += dist >= 59; b += dist >= 77; b += dist >= 99; b += dist >= 128;
    b += dist >= 166; b += dist >= 216; b += dist >= 280; b += dist >= 363; b += dist >= 470; b += dist >= 609; b += dist >= 790;
    return b;
}
__device__ __forceinline__ float wave_sum(float v) {
#pragma unroll
    for (int o = 1; o < 64; o <<= 1) v += __shfl_xor(v, o);
    return v;
}
__device__ __forceinline__ float wave_max(float v) {
#pragma unroll
    for (int o = 1; o < 64; o <<= 1) v = fmaxf(v, __shfl_xor(v, o));
    return v;
}

__global__ void __launch_bounds__(256) k_rmsnorm_in(const float* __restrict__ x, const float* __restrict__ g, h16* __restrict__ xn) {
    const int lane = threadIdx.x & 63, w = (blockIdx.x * blockDim.x + threadIdx.x) >> 6, nw = (gridDim.x * blockDim.x) >> 6;
    for (int m = w; m < M; m += nw) {
        const float4* xr = (const float4*)(x + (size_t)m * D);
        float4 v[8]; float s = 0.f;
#pragma unroll
        for (int j = 0; j < 8; ++j) { v[j] = xr[lane + 64 * j]; s += v[j].x * v[j].x + v[j].y * v[j].y + v[j].z * v[j].z + v[j].w * v[j].w; }
        const float r = rsqrtf(wave_sum(s) * (1.f / D) + RMS_EPS);
#pragma unroll
        for (int j = 0; j < 8; ++j) {
            const float4 gg = ((const float4*)g)[lane + 64 * j];
            h16* o = xn + (size_t)m * D + 4 * (lane + 64 * j);
            o[0] = (h16)(v[j].x * r * gg.x); o[1] = (h16)(v[j].y * r * gg.y); o[2] = (h16)(v[j].z * r * gg.z); o[3] = (h16)(v[j].w * r * gg.w);
        }
    }
}
__global__ void __launch_bounds__(256) k_transpose_w(const float* __restrict__ W, h16* __restrict__ WT, int K, int ldw, int N_out, int remap) {
    __shared__ float t[32][33];
    const int k0 = blockIdx.x * 32, n0 = blockIdx.y * 32, tx = threadIdx.x & 31, ty = threadIdx.x >> 5;
    for (int i = ty; i < 32; i += 8) { const int n = n0 + tx; const int sc = remap ? src_col(n) : n; t[i][tx] = (sc >= 0) ? W[(size_t)(k0 + i) * ldw + sc] : 0.f; }
    __syncthreads();
    for (int i = ty; i < 32; i += 8) WT[(size_t)(n0 + i) * K + k0 + tx] = (h16)t[tx][i];
}

template <int MODE>
__global__ void __launch_bounds__(256) k_gemm_naive(const h16* __restrict__ A, const h16* __restrict__ Bt, void* __restrict__ Cv, const float* __restrict__ resid, int K, int ldc) {
    __shared__ float As[32][68], Bs[32][68];
    const int tx = threadIdx.x & 15, ty = threadIdx.x >> 4, m0 = blockIdx.y * 64, n0 = blockIdx.x * 64;
    float acc[4][4] = {};
    for (int k0 = 0; k0 < K; k0 += 32) {
        for (int i = threadIdx.x; i < 64 * 32; i += 256) { const int r = i >> 5, c = i & 31; As[c][r] = (float)A[(size_t)(m0 + r) * K + k0 + c]; Bs[c][r] = (float)Bt[(size_t)(n0 + r) * K + k0 + c]; }
        __syncthreads();
#pragma unroll 8
        for (int kk = 0; kk < 32; ++kk) {
            const float4 a = *(const float4*)&As[kk][ty * 4], b = *(const float4*)&Bs[kk][tx * 4];
            const float av[4] = {a.x, a.y, a.z, a.w}, bv[4] = {b.x, b.y, b.z, b.w};
#pragma unroll
            for (int i = 0; i < 4; ++i)
#pragma unroll
                for (int j = 0; j < 4; ++j) acc[i][j] += av[i] * bv[j];
        }
        __syncthreads();
    }
#pragma unroll
    for (int i = 0; i < 4; ++i)
#pragma unroll
        for (int j = 0; j < 4; ++j) {
            const size_t o = (size_t)(m0 + ty * 4 + i) * ldc + n0 + tx * 4 + j;
            if (MODE == 0) ((h16*)Cv)[o] = (h16)acc[i][j]; else ((float*)Cv)[o] = resid[o] + acc[i][j];
        }
}

__global__ void __launch_bounds__(256) k_compress(const h16* __restrict__ proj, const float* __restrict__ posk, const float* __restrict__ w1k, const float* __restrict__ w2k,
                                                  const float* __restrict__ posv, const float* __restrict__ w1v, const float* __restrict__ w2v, h16* __restrict__ kcc, h16* __restrict__ vcc) {
    __shared__ float in[32 * 128]; __shared__ float hid[256];
    const int n = blockIdx.x, g = blockIdx.y & 1, kv = blockIdx.y >> 1, b = blockIdx.z, e = threadIdx.x;
    const float* pos = kv ? posv : posk; const float* w1 = kv ? w1v : w1k; const float* w2 = kv ? w2v : w2k; h16* out = kv ? vcc : kcc;
    const int col0 = (kv ? C_VC : C_KC) + g * HD;
    if (n == NCB) { if (e < 128) out[((size_t)(b * NG + g) * NCBP + n) * HD + e] = (h16)0.f; return; }
    for (int i = e; i < 32 * 128; i += 256) { const int l = i >> 7, d = i & 127; in[i] = (float)proj[(size_t)(b * S + 16 * n + l) * LDP + col0 + d] + pos[i]; }
    __syncthreads();
    float acc = 0.f;
    for (int i = 0; i < 32 * 128; ++i) acc += in[i] * w1[(size_t)i * 256 + e];
    const float u = 0.7978845608028654f * (acc + 0.044715f * acc * acc * acc);
    hid[e] = 0.5f * acc * (1.f + tanhf(u));
    __syncthreads();
    if (e < 128) { float o = 0.f; for (int i = 0; i < 256; ++i) o += hid[i] * w2[i * 128 + e]; out[((size_t)(b * NG + g) * NCBP + n) * HD + e] = (h16)o; }
}

__global__ void __launch_bounds__(64) k_nsa_cmp(const h16* __restrict__ proj, const h16* __restrict__ kcc, const h16* __restrict__ vcc, const float* __restrict__ rel_bias,
                                                float* __restrict__ oc, u64* __restrict__ sel) {
    __shared__ float q[128]; __shared__ float P[4][256];
    const int t = blockIdx.x, g = blockIdx.y, b = blockIdx.z, lane = threadIdx.x; const size_t m = (size_t)b * S + t;
    const int nvalid = t < 31 ? 0 : min((t - 31) / 16 + 1, NCB);
    const h16* kc = kcc + (size_t)(b * NG + g) * NCBP * HD; const h16* vc = vcc + (size_t)(b * NG + g) * NCBP * HD;
    for (int r = 0; r < 4; ++r) {
        const int hh = g * 4 + r;
        __syncthreads();
        q[lane] = (float)proj[m * LDP + C_NQ + hh * HD + lane]; q[lane + 64] = (float)proj[m * LDP + C_NQ + hh * HD + lane + 64];
        __syncthreads();
        float sc[4]; float mx = -1e30f;
#pragma unroll
        for (int i = 0; i < 4; ++i) { const int n = lane + 64 * i; sc[i] = -1e30f;
            if (n < nvalid) { float s = 0.f; for (int d = 0; d < 128; ++d) s += q[d] * (float)kc[(size_t)n * HD + d];
                sc[i] = s * QMUL + rel_bias[rel_bucket(t - (16 * n + 31)) * NHEAD + hh]; }
            mx = fmaxf(mx, sc[i]); }
        mx = wave_max(mx); float l = 0.f;
#pragma unroll
        for (int i = 0; i < 4; ++i) { const int n = lane + 64 * i; sc[i] = (n < nvalid) ? __expf(sc[i] - mx) : 0.f; l += sc[i]; }
        l = wave_sum(l); const float inv = nvalid > 0 ? 1.f / l : 0.f;
#pragma unroll
        for (int i = 0; i < 4; ++i) P[r][lane + 64 * i] = sc[i] * inv;
        __syncthreads();
        float o0 = 0.f, o1 = 0.f;
        for (int n = 0; n < nvalid; ++n) { const float p = P[r][n]; o0 += p * (float)vc[(size_t)n * HD + lane]; o1 += p * (float)vc[(size_t)n * HD + lane + 64]; }
        oc[m * 1024 + hh * HD + lane] = o0; oc[m * 1024 + hh * HD + lane + 64] = o1;
    }
    __syncthreads();
    const int j = lane; float imp = 0.f;
    for (int r = 0; r < 4; ++r) for (int n = 4 * j - 1; n <= 4 * j + 3; ++n) if (n >= 0 && n < NCB) imp += P[r][n];
    const int cur = t >> 6; const bool valid = j * 64 <= t, forced = (j == 0) || (j == cur) || (j == cur - 1);
    const float score = valid ? (forced ? 1e9f : imp) : -1e9f;
    int rank = 0;
    for (int i = 0; i < 64; ++i) { const float si = __shfl(score, i); rank += (si > score) || (si == score && i < j); }
    const u64 mask = __ballot(rank < 16);
    if (lane == 0) sel[m * NG + g] = mask;
}

__global__ void __launch_bounds__(128) k_nsa_selwin(const h16* __restrict__ proj, const float* __restrict__ rel_bias, const u64* __restrict__ sel, const float* __restrict__ oc, float* __restrict__ onsa) {
    __shared__ h16 Kt[64 * 128]; __shared__ h16 Vt[64 * 128]; __shared__ float bt[1024];
    const int cur = blockIdx.x, hh = blockIdx.y, b = blockIdx.z, g = hh >> 2, tid = threadIdx.x, t = cur * 64 + (tid >> 1), d0 = (tid & 1) * 64; const size_t m = (size_t)b * S + t;
    for (int i = tid; i < 1024; i += 128) bt[i] = rel_bias[rel_bucket(i) * NHEAD + hh];
    __syncthreads();
    float q[64];
#pragma unroll
    for (int d = 0; d < 64; ++d) q[d] = (float)proj[m * LDP + C_NQ + hh * HD + d0 + d] * QMUL;
    const u64 mysel = sel[m * NG + g];
    const float g0 = 1.f / (1.f + __expf(-(float)proj[m * LDP + C_GATE + hh * 3 + 0])), g1 = 1.f / (1.f + __expf(-(float)proj[m * LDP + C_GATE + hh * 3 + 1])), g2 = 1.f / (1.f + __expf(-(float)proj[m * LDP + C_GATE + hh * 3 + 2]));
    for (int br = 0; br < 2; ++br) {
        float o[64];
#pragma unroll
        for (int d = 0; d < 64; ++d) o[d] = 0.f;
        float mx = -1e30f, l = 0.f;
        const int kcol = (br ? C_KW : C_KS) + g * HD, vcol = (br ? C_VW : C_VS) + g * HD;
        const int j0 = br ? max(0, cur - 8) : 0;
        for (int j = j0; j <= cur; ++j) {
            const bool act = br ? true : ((mysel >> j) & 1ull) != 0ull;
            if (!__syncthreads_or(act ? 1 : 0)) continue;
            for (int i = tid; i < 64 * 128 / 8; i += 128) { const int r = i >> 4, c = (i & 15) * 8; const size_t row = (size_t)(b * S + j * 64 + r) * LDP;
                *(uint4*)&Kt[r * 128 + c] = *(const uint4*)&proj[row + kcol + c]; *(uint4*)&Vt[r * 128 + c] = *(const uint4*)&proj[row + vcol + c]; }
            __syncthreads();
            for (int c0 = 0; c0 < 64; c0 += 16) {
                float sc[16]; float cm = -1e30f;
#pragma unroll
                for (int kk = 0; kk < 16; ++kk) { const int pos = j * 64 + c0 + kk, dist = t - pos; const bool ok = act && dist >= 0 && (br == 0 || dist < 512);
                    float s = 0.f;
#pragma unroll
                    for (int d = 0; d < 64; ++d) s += q[d] * (float)Kt[(c0 + kk) * 128 + d0 + d];
                    s += __shfl_xor(s, 1);
                    s += bt[min(max(dist, 0), 1023)];
                    sc[kk] = ok ? s : -1e30f; cm = fmaxf(cm, sc[kk]); }
                if (cm > -1e29f) {
                    const float mn = fmaxf(mx, cm), al = __expf(mx - mn); mx = mn; l *= al;
#pragma unroll
                    for (int d = 0; d < 64; ++d) o[d] *= al;
#pragma unroll
                    for (int kk = 0; kk < 16; ++kk) { const float p = sc[kk] > -1e29f ? __expf(sc[kk] - mn) : 0.f; l += p;
#pragma unroll
                        for (int d = 0; d < 64; ++d) o[d] += p * (float)Vt[(c0 + kk) * 128 + d0 + d]; }
                }
            }
        }
        const float inv = 1.f / l;
        float* dst = onsa + m * 1024 + hh * HD + d0; const float* ocr = oc + m * 1024 + hh * HD + d0;
        if (br == 0) {
#pragma unroll
            for (int d = 0; d < 64; ++d) dst[d] = g0 * ocr[d] + g1 * o[d] * inv;
        } else {
#pragma unroll
            for (int d = 0; d < 64; ++d) dst[d] += g2 * o[d] * inv;
        }
    }
}

__global__ void __launch_bounds__(128) k_sb_naive(const h16* __restrict__ proj, float* __restrict__ osb) {
    __shared__ h16 Kt[64 * 128]; __shared__ h16 Vt[64 * 128];
    const int cur = blockIdx.x, h = blockIdx.y, b = blockIdx.z, tid = threadIdx.x, t = cur * 64 + (tid >> 1), d0 = (tid & 1) * 64; const size_t m = (size_t)b * S + t;
    float q[64], o[64];
#pragma unroll
    for (int d = 0; d < 64; ++d) { q[d] = (float)proj[m * LDP + C_SBQ + h * HD + d0 + d] * QMUL; o[d] = 0.f; }
    float cum = 0.f;
    for (int j = cur; j >= 0; --j) {
        __syncthreads();
        for (int i = tid; i < 64 * 128 / 8; i += 128) { const int r = i >> 4, c = (i & 15) * 8; const size_t row = (size_t)(b * S + j * 64 + r) * LDP;
            *(uint4*)&Kt[r * 128 + c] = *(const uint4*)&proj[row + C_SBK + h * HD + c]; *(uint4*)&Vt[r * 128 + c] = *(const uint4*)&proj[row + C_SBV + h * HD + c]; }
        __syncthreads();
        for (int kk = 63; kk >= 0; --kk) {
            const int pos = j * 64 + kk;
            float z = 0.f;
#pragma unroll
            for (int d = 0; d < 64; ++d) z += q[d] * (float)Kt[kk * 128 + d0 + d];
            z += __shfl_xor(z, 1);
            const float sp = fmaxf(z, 0.f) + log1pf(__expf(-fabsf(z)));
            const float log_rest = -sp, log_beta = z - sp;
            const float a = (pos < t) ? __expf(log_beta + cum) : 0.f;
            if (pos < t) cum += log_rest;
#pragma unroll
            for (int d = 0; d < 64; ++d) o[d] += a * (float)Vt[kk * 128 + d0 + d];
        }
    }
#pragma unroll
    for (int d = 0; d < 64; ++d) osb[m * 1024 + h * HD + d0 + d] = o[d];
}

__global__ void __launch_bounds__(256) k_make_y(const float* __restrict__ osb, const float* __restrict__ onsa, const h16* __restrict__ proj, const float* __restrict__ gsb, const float* __restrict__ gnsa, h16* __restrict__ y) {
    const int lane = threadIdx.x & 63, w = (blockIdx.x * blockDim.x + threadIdx.x) >> 6, nw = (gridDim.x * blockDim.x) >> 6;
    for (int i = w; i < 2 * M; i += nw) {
        const int m = i >> 1, part = i & 1;
        const float* src = (part ? onsa : osb) + (size_t)m * 1024; const float* gg = part ? gnsa : gsb; const h16* zz = proj + (size_t)m * LDP + (part ? C_NZ : C_SBZ);
        float v[16]; float s = 0.f;
#pragma unroll
        for (int j = 0; j < 16; ++j) { v[j] = src[lane + 64 * j]; s += v[j] * v[j]; }
        const float r = rsqrtf(wave_sum(s) * (1.f / 1024.f) + RMS_EPS);
#pragma unroll
        for (int j = 0; j < 16; ++j) { const int c = lane + 64 * j; const float z = (float)zz[c]; y[(size_t)m * D + part * 1024 + c] = (h16)(v[j] * r * gg[c] * (z / (1.f + __expf(-z)))); }
    }
}
__global__ void __launch_bounds__(256) k_make_y2(const h16* __restrict__ og, const float* __restrict__ ssq16, const float* __restrict__ onsa, const h16* __restrict__ proj, const float* __restrict__ gnsa, h16* __restrict__ y) {
    const int lane = threadIdx.x & 63, w = (blockIdx.x * blockDim.x + threadIdx.x) >> 6, nw = (gridDim.x * blockDim.x) >> 6;
    for (int i = w; i < 2 * M; i += nw) {
        const int m = i >> 1, part = i & 1;
        if (part == 0) {
            float s = 0.f;
            for (int k = 0; k < 8; ++k) s += ssq16[(size_t)m * 16 + k];
            const float r = rsqrtf(s * (1.f / 1024.f) + RMS_EPS);
            for (int j = 0; j < 16; ++j) { const int c = lane + 64 * j; y[(size_t)m * D + c] = (h16)((float)og[(size_t)m * 2048 + c] * r); }
        } else {
            const float* src = onsa + (size_t)m * 1024; const h16* zz = proj + (size_t)m * LDP + C_NZ;
            float v[16]; float s = 0.f;
#pragma unroll
            for (int j = 0; j < 16; ++j) { v[j] = src[lane + 64 * j]; s += v[j] * v[j]; }
            const float r = rsqrtf(wave_sum(s) * (1.f / 1024.f) + RMS_EPS);
#pragma unroll
            for (int j = 0; j < 16; ++j) { const int c = lane + 64 * j; const float z = (float)zz[c]; y[(size_t)m * D + 1024 + c] = (h16)(v[j] * r * gnsa[c] * (z / (1.f + __expf(-z)))); }
        }
    }
}
__global__ void __launch_bounds__(256) k_make_y3(const h16* __restrict__ og, const float* __restrict__ ssq16, h16* __restrict__ y) {
    const int lane = threadIdx.x & 63, w = (blockIdx.x * blockDim.x + threadIdx.x) >> 6, nw = (gridDim.x * blockDim.x) >> 6;
    for (int i = w; i < 2 * M; i += nw) {
        const int m = i >> 1, part = i & 1;
        float s = 0.f;
        for (int k = 0; k < 8; ++k) s += ssq16[(size_t)m * 16 + 8 * part + k];
        const float r = rsqrtf(s * (1.f / 1024.f) + RMS_EPS);
        for (int j = 0; j < 16; ++j) { const int c = part * 1024 + lane + 64 * j; y[(size_t)m * D + c] = (h16)((float)og[(size_t)m * 2048 + c] * r); }
    }
}
__global__ void __launch_bounds__(256) k_final_norm(float* __restrict__ out, const float* __restrict__ g) {
    const int lane = threadIdx.x & 63, w = (blockIdx.x * blockDim.x + threadIdx.x) >> 6, nw = (gridDim.x * blockDim.x) >> 6;
    for (int m = w; m < M; m += nw) {
        float4* xr = (float4*)(out + (size_t)m * D);
        float4 v[8]; float s = 0.f;
#pragma unroll
        for (int j = 0; j < 8; ++j) { v[j] = xr[lane + 64 * j]; s += v[j].x * v[j].x + v[j].y * v[j].y + v[j].z * v[j].z + v[j].w * v[j].w; }
        const float r = rsqrtf(wave_sum(s) * (1.f / D) + RMS_EPS);
#pragma unroll
        for (int j = 0; j < 8; ++j) { const float4 gg = ((const float4*)g)[lane + 64 * j]; xr[lane + 64 * j] = make_float4(v[j].x * r * gg.x, v[j].y * r * gg.y, v[j].z * r * gg.z, v[j].w * r * gg.w); }
    }
}

namespace pg8 {
#define PG8_LAS __attribute__((address_space(3)))
typedef unsigned short bf16_t;
typedef _Float16 bf16x8 __attribute__((ext_vector_type(8)));
typedef float f32x4 __attribute__((ext_vector_type(4)));
typedef unsigned u32x4 __attribute__((ext_vector_type(4)));
constexpr int BM = 256, BK = 64, HALF = 128, HTB = HALF * BK * 2  , STAGE_BYTES = 8 * HTB, NXCD = 8, WGM = 8;

__host__ __device__ __forceinline__ int lds_byte(int r, int c) { const int st = (r >> 4) * 2 + (c >> 5), rr = r & 15, cc = c & 31, ob = rr * 64 + cc * 2; return st * 1024 + (ob ^ (((ob >> 9) & 1) << 5)); }
__host__ __device__ __forceinline__ void stage_rc(int b, int& R, int& C) { const int st = b / 1024, sb = b % 1024, swz = sb ^ (((sb >> 9) & 1) << 5); R = (st >> 1) * 16 + swz / 64; C = (st & 1) * 32 + (swz % 64) / 2; }
__host__ __device__ __forceinline__ int perm32(int rho) { const int n = rho >> 4, i = rho & 15; return 8 * (i >> 2) + 4 * n + (i & 3); }

struct Unit { int pm, pn; };
struct Gemm { const bf16_t* A; const bf16_t* Bt; int M, N, K; };

struct StaticOrder {
    int nM, nN, nwg, G, c;
    __host__ __device__ void init(int M, int N, int G_, int c_) { nM = M / BM; nN = N / BM; nwg = nM * nN; G = G_; c = c_; }
    __host__ __device__ bool next(int i, Unit& u) const {
        const long L = (long)i * G + c; if (L >= nwg) return false;
        int wgid = (int)L; { const int q = nwg / NXCD, r = nwg % NXCD, xcd = wgid % NXCD, off = wgid / NXCD; wgid = (xcd < r ? xcd * (q + 1) : r * (q + 1) + (xcd - r) * q) + off; }
        const int nig = WGM * nN, gid = wgid / nig, fm = gid * WGM, gsz = (nM - fm) < WGM ? (nM - fm) : WGM;
        u.pm = fm + ((wgid % nig) % gsz); u.pn = (wgid % nig) / gsz; return true;
    }
    __device__ __forceinline__ void a_ready(const Unit&) const {}
    __device__ __forceinline__ void done(const Unit&) const {}
};

struct EpiF16 {
    static constexpr bool PERM = true, AFTER_DRAIN = false;
    _Float16* O; int ldc; float qscale;
    __device__ __forceinline__ void operator()(const f32x4 (&acc)[2][2][4][2], const Unit& u, int wr, int wc, int fr, int fq) const {
        const int row0 = u.pm * BM + wr * 64 + fr, col0 = u.pn * BM + wc * 32 + 8 * fq;
        const float s = (u.pn < 4 || (u.pn >= 16 && u.pn < 20)) ? qscale : 1.0f;
#pragma unroll
        for (int ai = 0; ai < 2; ++ai)
#pragma unroll
            for (int m = 0; m < 4; ++m) { _Float16* rowp = O + (size_t)(row0 + ai * HALF + m * 16) * ldc + col0;
#pragma unroll
                for (int bj = 0; bj < 2; ++bj) { const f32x4 v0 = acc[ai][bj][m][0] * s, v1 = acc[ai][bj][m][1] * s;
                    bf16x8 w; w[0] = (_Float16)v0[0]; w[1] = (_Float16)v0[1]; w[2] = (_Float16)v0[2]; w[3] = (_Float16)v0[3]; w[4] = (_Float16)v1[0]; w[5] = (_Float16)v1[1]; w[6] = (_Float16)v1[2]; w[7] = (_Float16)v1[3];
                    *(bf16x8*)(rowp + bj * HALF) = w; } }
    }
};
struct EpiResF32 {
    static constexpr bool PERM = false, AFTER_DRAIN = false;
    const float* resid; float* C; int ldc; float* ssq;
    __device__ __forceinline__ void operator()(const f32x4 (&acc)[2][2][4][2], const Unit& u, int wr, int wc, int fr, int fq) const {
        const int row0 = u.pm * BM + wr * 64 + fr, col0 = u.pn * BM + wc * 32 + 4 * fq;
#pragma unroll
        for (int ai = 0; ai < 2; ++ai)
#pragma unroll
            for (int m = 0; m < 4; ++m) { const int row = row0 + ai * HALF + m * 16; const size_t off = (size_t)row * ldc + col0; float q = 0.f;
#pragma unroll
                for (int bj = 0; bj < 2; ++bj)
#pragma unroll
                    for (int n = 0; n < 2; ++n) { const f32x4 h = *(const f32x4*)(resid + off + bj * HALF + n * 16) + acc[ai][bj][m][n]; *(f32x4*)(C + off + bj * HALF + n * 16) = h;
                        q += (h[0] * h[0] + h[1] * h[1]) + (h[2] * h[2] + h[3] * h[3]); }
                q += __shfl_xor(q, 16); q += __shfl_xor(q, 32);
                if (fq == 0) ssq[(size_t)row * 32 + 4 * u.pn + wc] = q; }
    }
};
template <class Epi, class Sched, bool ALIGN_EPI = false, bool SP2 = false>
__device__ __forceinline__ void gemm_phase(PG8_LAS unsigned char* lds, const Gemm g, const Sched& S, const Epi& E) {
    const int tid = threadIdx.x, wid = __builtin_amdgcn_readfirstlane(tid >> 6), lane = tid & 63, wr = wid >> 2, wc = wid & 3, fr = lane & 15, fq = lane >> 4;
    const int K = g.K, nt = K / BK;
    unsigned voffA[2], voffB[2];
#pragma unroll
    for (int i = 0; i < 2; ++i) { int R, C; stage_rc(tid * 16 + i * 8192, R, C); const int Rb = Epi::PERM ? ((R & ~31) + perm32(R & 31)) : R;
        voffA[i] = (unsigned)(R * K + C) * 2u; voffB[i] = (unsigned)(Rb * K + C) * 2u; }
    const size_t kstep = (size_t)(BK * 2);
    const size_t hstep = (size_t)HALF * K * 2;
    const size_t tstep = 2 * hstep;
    const unsigned ldsw = (unsigned)wid * 1024u;
    const int aoff = lds_byte(wr * 64 + fr, fq * 8), boff = lds_byte(wc * 32 + fr, fq * 8);
#define PG8_SA(b, h) (((b) * 2 + (h)) * HTB)
#define PG8_SB(b, h) ((4 + (b) * 2 + (h)) * HTB)
#define PG8_STAGE(bufoff, gbase, voff) do { _Pragma("unroll") for (int _i = 0; _i < 2; ++_i) \
        __builtin_amdgcn_global_load_lds((const unsigned*)((const char*)(gbase) + (voff)[_i]), (PG8_LAS unsigned*)(lds + (bufoff) + ldsw + _i * 8192), 16, 0, 0); } while (0)
#define PG8_LDA(dst, b, h) do { _Pragma("unroll") for (int m = 0; m < 4; ++m) _Pragma("unroll") for (int k = 0; k < 2; ++k) dst[m][k] = *(const PG8_LAS bf16x8*)(lds + PG8_SA(b, h) + aoff + m * 2048 + k * 1024); } while (0)
#define PG8_LDB(dst, b, h) do { _Pragma("unroll") for (int n = 0; n < 2; ++n) _Pragma("unroll") for (int k = 0; k < 2; ++k) dst[n][k] = *(const PG8_LAS bf16x8*)(lds + PG8_SB(b, h) + boff + n * 2048 + k * 1024); } while (0)
#define PG8_MMA(ai, bj, At, Bt) do { __builtin_amdgcn_s_setprio(1); _Pragma("unroll") for (int m = 0; m < 4; ++m) _Pragma("unroll") for (int n = 0; n < 2; ++n) _Pragma("unroll") for (int k = 0; k < 2; ++k) \
        acc[ai][bj][m][n] = __builtin_amdgcn_mfma_f32_16x16x32_f16(Bt[n][k], At[m][k], acc[ai][bj][m][n], 0, 0, 0); __builtin_amdgcn_s_setprio(0); } while (0)
#define PG8_WAIT_V(n) asm volatile("s_waitcnt vmcnt(" #n ")" ::: "memory")
#define PG8_WAIT_L(n) asm volatile("s_waitcnt lgkmcnt(" #n ")" ::: "memory")
#define PG8_BAR __builtin_amdgcn_s_barrier()
#define PG8_SCHED __builtin_amdgcn_sched_barrier(0)
    Unit cur, nxt; int ui = 0;
    if (!S.next(0, cur)) return;
    f32x4 acc[2][2][4][2];
#pragma unroll
    for (int a = 0; a < 2; ++a)
#pragma unroll
        for (int b = 0; b < 2; ++b)
#pragma unroll
            for (int m = 0; m < 4; ++m)
#pragma unroll
                for (int n = 0; n < 2; ++n) acc[a][b][m][n] = (f32x4){0.f, 0.f, 0.f, 0.f};
    bf16x8 At[4][2], B0[2][2], B1[2][2];
    const char* cA = (const char*)g.A + (size_t)cur.pm * tstep; const char* cB = (const char*)g.Bt + (size_t)cur.pn * tstep;
    S.a_ready(cur);
    if constexpr (SP2) {
        PG8_STAGE(PG8_SB(0, 0), cB, voffB); PG8_STAGE(PG8_SB(0, 1), cB + hstep, voffB); PG8_STAGE(PG8_SA(0, 0), cA, voffA); PG8_STAGE(PG8_SA(0, 1), cA + hstep, voffA);
        if (wr == 1) PG8_BAR;
        PG8_WAIT_V(2); PG8_BAR;
        PG8_STAGE(PG8_SB(1, 0), cB + kstep, voffB); PG8_STAGE(PG8_SA(1, 0), cA + kstep, voffA); PG8_STAGE(PG8_SB(1, 1), cB + hstep + kstep, voffB);
        PG8_WAIT_V(6); PG8_BAR;
    } else {
        PG8_STAGE(PG8_SB(0, 0), cB, voffB); PG8_STAGE(PG8_SA(0, 0), cA, voffA); PG8_STAGE(PG8_SB(0, 1), cB + hstep, voffB); PG8_STAGE(PG8_SA(0, 1), cA + hstep, voffA);
        if (wr == 1) PG8_BAR;
        PG8_WAIT_V(4); PG8_BAR;
        PG8_STAGE(PG8_SB(1, 0), cB + kstep, voffB); PG8_STAGE(PG8_SA(1, 0), cA + kstep, voffA); PG8_STAGE(PG8_SB(1, 1), cB + hstep + kstep, voffB);
        PG8_WAIT_V(6); PG8_BAR;
    }
    for (;;) {
        const bool has_next = S.next(ui + 1, nxt);
        const char* nA = has_next ? (const char*)g.A + (size_t)nxt.pm * tstep : cA; const char* nB = has_next ? (const char*)g.Bt + (size_t)nxt.pn * tstep : cB;
        for (int t = 0; t < nt; t += 2) {
            const bool last = (t == nt - 2);
            const char* a1 = cA + (size_t)(t + 1) * kstep;
            const char* a2 = last ? nA : cA + (size_t)(t + 2) * kstep; const char* b2 = last ? nB : cB + (size_t)(t + 2) * kstep;
            const char* a3 = a2 + kstep; const char* b3 = b2 + kstep;
            if (last && has_next) S.a_ready(nxt);
            if constexpr (SP2) {
            PG8_LDB(B0, 0, 0); PG8_LDB(B1, 0, 1); PG8_SCHED; PG8_LDA(At, 0, 0); PG8_STAGE(PG8_SA(1, 1), a1 + hstep, voffA);
            PG8_WAIT_V(8); PG8_WAIT_L(0); PG8_BAR; PG8_MMA(0, 0, At, B0); PG8_MMA(0, 1, At, B1); PG8_BAR; PG8_SCHED;
            PG8_LDA(At, 0, 1); PG8_STAGE(PG8_SB(0, 0), b2, voffB); PG8_STAGE(PG8_SB(0, 1), b2 + hstep, voffB); PG8_STAGE(PG8_SA(0, 0), a2, voffA);
            PG8_WAIT_V(8); PG8_WAIT_L(0); PG8_BAR; PG8_MMA(1, 0, At, B0); PG8_MMA(1, 1, At, B1); PG8_BAR; PG8_SCHED;
            PG8_LDB(B0, 1, 0); PG8_LDB(B1, 1, 1); PG8_SCHED; PG8_LDA(At, 1, 0); PG8_STAGE(PG8_SA(0, 1), a2 + hstep, voffA);
            PG8_WAIT_V(8); PG8_WAIT_L(0); PG8_BAR; PG8_MMA(0, 0, At, B0); PG8_MMA(0, 1, At, B1); PG8_BAR; PG8_SCHED;
            PG8_LDA(At, 1, 1); PG8_STAGE(PG8_SB(1, 0), b3, voffB); PG8_STAGE(PG8_SB(1, 1), b3 + hstep, voffB); PG8_STAGE(PG8_SA(1, 0), a3, voffA);
            PG8_WAIT_V(8); PG8_WAIT_L(0); PG8_BAR; PG8_MMA(1, 0, At, B0); PG8_MMA(1, 1, At, B1); PG8_BAR; PG8_SCHED;
            } else {
            PG8_LDB(B0, 0, 0); PG8_SCHED; PG8_LDA(At, 0, 0); PG8_STAGE(PG8_SA(1, 1), a1 + hstep, voffA);
            PG8_WAIT_L(8); PG8_BAR; PG8_WAIT_L(0); PG8_MMA(0, 0, At, B0); PG8_BAR; PG8_SCHED;
            PG8_LDB(B1, 0, 1); PG8_STAGE(PG8_SB(0, 0), b2, voffB);
            PG8_BAR; PG8_WAIT_L(0); PG8_MMA(0, 1, At, B1); PG8_BAR;
            PG8_LDA(At, 0, 1); PG8_STAGE(PG8_SA(0, 0), a2, voffA);
            PG8_BAR; PG8_WAIT_L(0); PG8_MMA(1, 0, At, B0); PG8_BAR; PG8_SCHED;
            PG8_STAGE(PG8_SB(0, 1), b2 + hstep, voffB);
            PG8_WAIT_V(6); PG8_BAR; PG8_MMA(1, 1, At, B1); PG8_BAR;
            PG8_LDB(B0, 1, 0); PG8_SCHED; PG8_LDA(At, 1, 0); PG8_STAGE(PG8_SA(0, 1), a2 + hstep, voffA);
            PG8_WAIT_L(8); PG8_BAR; PG8_WAIT_L(0); PG8_MMA(0, 0, At, B0); PG8_BAR; PG8_SCHED;
            PG8_LDB(B1, 1, 1); PG8_STAGE(PG8_SB(1, 0), b3, voffB);
            PG8_BAR; PG8_WAIT_L(0); PG8_MMA(0, 1, At, B1); PG8_BAR;
            PG8_LDA(At, 1, 1); PG8_STAGE(PG8_SA(1, 0), a3, voffA);
            PG8_BAR; PG8_WAIT_L(0); PG8_MMA(1, 0, At, B0); PG8_BAR; PG8_SCHED;
            PG8_STAGE(PG8_SB(1, 1), b3 + hstep, voffB);
            PG8_WAIT_V(6); PG8_BAR; PG8_MMA(1, 1, At, B1); PG8_BAR;
            }
        }
        if constexpr (ALIGN_EPI) { if (wr == 0) PG8_BAR; }
        if constexpr (!Epi::AFTER_DRAIN) { E(acc, cur, wr, wc, fr, fq); S.done(cur); }
        if (!has_next) break;
#pragma unroll
        for (int a = 0; a < 2; ++a)
#pragma unroll
            for (int b = 0; b < 2; ++b)
#pragma unroll
                for (int m = 0; m < 4; ++m)
#pragma unroll
                    for (int n = 0; n < 2; ++n) acc[a][b][m][n] = (f32x4){0.f, 0.f, 0.f, 0.f};
        cur = nxt; cA = nA; cB = nB; ++ui;
        if constexpr (ALIGN_EPI) { if (wr == 1) PG8_BAR; }
    }
    PG8_WAIT_V(0);
    if constexpr (!ALIGN_EPI) { if (wr == 0) PG8_BAR; }
    PG8_BAR;
    if constexpr (Epi::AFTER_DRAIN) { E.fused(acc, cur, wr, wc, fr, fq, lds, wid, lane); S.done(cur); }
#undef PG8_SA
#undef PG8_SB
#undef PG8_STAGE
#undef PG8_LDA
#undef PG8_LDB
#undef PG8_MMA
#undef PG8_WAIT_V
#undef PG8_WAIT_L
#undef PG8_BAR
#undef PG8_SCHED
}
}

#define GAS __attribute__((address_space(1)))
#define LAS __attribute__((address_space(3)))
typedef unsigned v4u __attribute__((ext_vector_type(4)));
#define LDS_WAIT() asm volatile("s_waitcnt lgkmcnt(0)" ::: "memory")
#define VM_WAIT() asm volatile("s_waitcnt vmcnt(0)" ::: "memory")
constexpr int NWAVES = 8, NTHR = NWAVES * 64;
constexpr int RING_OFF = 0, RING_BYTES = 157696;
constexpr int LDSCTL_OFF = RING_BYTES, MISC_OFF = LDSCTL_OFF + 320;
constexpr int LDS_BYTES = 158720;
constexpr int CW_BAR = 4096;
constexpr size_t CTL_ZERO_BYTES = 65536;

#define XB_TMO      128
#define XB_XCNT(j)  (256  + 64 * (j))
#define XB_XSUB(j)  (1280 + 64 * (j))
#define XB_XGEN(j)  (2304 + 64 * (j))
#define XB_TOP      3328
#define XB_TOPGEN   3392
#define XCD_BAR_WORDS 3456
#define XB_SPIN_CAP (1u << 18)

__device__ __forceinline__ unsigned xb_ld(unsigned* p)              { return __hip_atomic_load(p, __ATOMIC_RELAXED, __HIP_MEMORY_SCOPE_AGENT); }
__device__ __forceinline__ unsigned xb_add(unsigned* p, unsigned v) { return __hip_atomic_fetch_add(p, v, __ATOMIC_RELAXED, __HIP_MEMORY_SCOPE_AGENT); }
__device__ __forceinline__ unsigned xb_xcc_id() { return (unsigned)__builtin_amdgcn_s_getreg((3 << 11) | 20) & 0xFu; }
#define XB_SPIN(cond, bar) do { unsigned _sp = 0; while (cond) { __builtin_amdgcn_s_sleep(1); \
    if ((++_sp & 255u) == 0u) { if (xb_ld(&(bar)[XB_TMO])) break; if (_sp > XB_SPIN_CAP) { atomicAdd(&(bar)[XB_TMO], 1u); break; } } } } while (0)

struct XcdBarrier {
    unsigned* bar; unsigned x;
    volatile LAS unsigned* st;
};

__device__ __forceinline__ XcdBarrier xcd_barrier_post(unsigned* bar, volatile LAS unsigned* st) {
    XcdBarrier b; b.bar = bar; b.x = xb_xcc_id(); b.st = st;
    if (threadIdx.x == 0) (void)xb_add(&bar[XB_XCNT(b.x)], 1u);
    return b;
}
__device__ __forceinline__ void xcd_barrier_complete(unsigned* bar, unsigned x, unsigned& nloc, unsigned& nx) {
    const unsigned G = gridDim.x * gridDim.y * gridDim.z;
    unsigned sum, cnt, mine, sp = 0u;
    for (;;) {
        sum = 0u; cnt = 0u; mine = 0u;
#pragma unroll
        for (unsigned j = 0; j < 16; ++j) { const unsigned c = xb_ld(&bar[XB_XCNT(j)]); sum += c; cnt += (c > 0u) ? 1u : 0u; mine = (j == x) ? c : mine; }
        if (sum == G) break;
        __builtin_amdgcn_s_sleep(1);
        if ((++sp & 255u) == 0u) { if (xb_ld(&bar[XB_TMO])) break; if (sp > XB_SPIN_CAP) { atomicAdd(&bar[XB_TMO], 1u); break; } }
    }
    nloc = mine > 0u ? mine : 1u; nx = cnt > 0u ? cnt : 1u;
}

__device__ __forceinline__ void xcd_barrier(const XcdBarrier& b) {
    asm volatile("s_waitcnt vmcnt(0)" ::: "memory");
    __syncthreads();
    if (threadIdx.x == 0) {
        unsigned* bar = b.bar;
        __builtin_amdgcn_s_waitcnt(0);
        unsigned nloc = b.st[0], nx = b.st[1];
        if (nloc == 0u) { xcd_barrier_complete(bar, b.x, nloc, nx); b.st[0] = nloc; b.st[1] = nx; }
        const unsigned old = xb_add(&bar[XB_XSUB(b.x)], 1u);
        const unsigned gen = old / nloc;
        if (old + 1u == (gen + 1u) * nloc) {
            __builtin_amdgcn_fence(__ATOMIC_RELEASE, "agent");
            asm volatile("s_waitcnt vmcnt(0)" ::: "memory");
            const unsigned og = xb_add(&bar[XB_TOP], 1u);
            const unsigned tg = og / nx;
            if (og + 1u == (tg + 1u) * nx) xb_add(&bar[XB_TOPGEN], 1u);
            else XB_SPIN(xb_ld(&bar[XB_TOPGEN]) == tg, bar);
            __builtin_amdgcn_fence(__ATOMIC_ACQUIRE, "agent");
            xb_add(&bar[XB_XGEN(b.x)], 1u);
            asm volatile("s_waitcnt vmcnt(0)" ::: "memory");
        } else {
            XB_SPIN(xb_ld(&bar[XB_XGEN(b.x)]) == gen, bar);
            __builtin_amdgcn_fence(__ATOMIC_ACQUIRE, "agent");
            asm volatile("s_waitcnt vmcnt(0)" ::: "memory");
        }
    }
    __syncthreads();
}

static_assert((CW_BAR + XCD_BAR_WORDS) * 4 <= (int)CTL_ZERO_BYTES, "barrier words inside the memset region");

__device__ __forceinline__ unsigned pk2h(float lo, float hi) { typedef _Float16 h2 __attribute__((ext_vector_type(2))); h2 v; v[0] = (_Float16)lo; v[1] = (_Float16)hi; return __builtin_bit_cast(unsigned, v); }

__device__ __forceinline__ void p0_transpose_item(const float* W, int K, int ldw, bool remap, h16* WT, LAS float* scr, int item, int nblk, int lane) {
    const int kb = item / nblk, nb = item % nblk, k0 = 64 * kb, n0 = 32 * nb;
    const int n = n0 + (lane & 31), sc = remap ? src_col(n) : n;
#pragma unroll 8
    for (int i = 0; i < 32; ++i) { const int kk = 2 * i + (lane >> 5); scr[kk * 33 + (lane & 31)] = sc >= 0 ? W[(size_t)(k0 + kk) * ldw + sc] : 0.f; }
    LDS_WAIT(); asm volatile("" ::: "memory");
    const int c = lane & 7;
#pragma unroll
    for (int j = 0; j < 4; ++j) { const int nn = (lane >> 3) + 8 * j; const LAS float* s = scr + (8 * c) * 33 + nn;
        v4u o; o.x = pk2h(s[0 * 33], s[1 * 33]); o.y = pk2h(s[2 * 33], s[3 * 33]); o.z = pk2h(s[4 * 33], s[5 * 33]); o.w = pk2h(s[6 * 33], s[7 * 33]);
        *(GAS v4u*)(WT + (size_t)(n0 + nn) * K + k0 + 8 * c) = o; }
    LDS_WAIT(); asm volatile("" ::: "memory");
}
typedef float f32x4v __attribute__((ext_vector_type(4)));
typedef unsigned u32x2v __attribute__((ext_vector_type(2)));
__device__ __forceinline__ void p0_rms_row(const float* xrow, const float* g, h16* orow, int lane) {
    const f32x4v* xr = (const f32x4v*)xrow + lane; const f32x4v* gr = (const f32x4v*)g + lane;
    f32x4v v[8]; float s = 0.f;
#pragma unroll
    for (int j = 0; j < 8; ++j) { v[j] = xr[64 * j]; s += (v[j][0] * v[j][0] + v[j][1] * v[j][1]) + (v[j][2] * v[j][2] + v[j][3] * v[j][3]); }
    const float r = rsqrtf(wave_sum(s) * (1.f / D) + RMS_EPS);
    u32x2v* o8 = (u32x2v*)orow + lane;
#pragma unroll
    for (int j = 0; j < 8; ++j) { const f32x4v gg = gr[64 * j]; u32x2v w; w[0] = pk2h(v[j][0] * r * gg[0], v[j][1] * r * gg[1]); w[1] = pk2h(v[j][2] * r * gg[2], v[j][3] * r * gg[3]); o8[64 * j] = w; }
}


typedef _Float16 h16x2 __attribute__((ext_vector_type(2)));
typedef _Float16 h16x4 __attribute__((ext_vector_type(4)));
typedef _Float16 h16x8 __attribute__((ext_vector_type(8)));
typedef short s16x4 __attribute__((ext_vector_type(4)));
typedef float f32x16 __attribute__((ext_vector_type(16)));
constexpr int KPITCH = 272, VPITCH = 320;
constexpr int AT_V = 64 * KPITCH, AT_BUF = AT_V + 64 * VPITCH;
__device__ __forceinline__ h16x4 tr_read(LAS unsigned char* p) { return __builtin_bit_cast(h16x4, __builtin_amdgcn_ds_read_tr16_b64_v4i16((LAS s16x4*)p)); }
__device__ __forceinline__ int crow(int i, int h) { return (i & 3) + 8 * (i >> 2) + 4 * h; }
__device__ __forceinline__ void tile_gload(const h16* gK, const h16* gV, unsigned pitch, v4u (&kr)[2], v4u (&vr)[2], int tid) {
    asm volatile("" : "+v"(tid));
#pragma unroll
    for (int i = 0; i < 2; ++i) { const unsigned cidx = tid + 512 * i, boff = ((cidx >> 4) * pitch + (cidx & 15) * 8) * 2u;
        kr[i] = *(const v4u*)((const char*)gK + boff); vr[i] = *(const v4u*)((const char*)gV + boff); }
}
__device__ __forceinline__ void tile_lstore(LAS unsigned char* buf, const v4u (&kr)[2], const v4u (&vr)[2], int tid) {
    asm volatile("" : "+v"(tid));
#pragma unroll
    for (int i = 0; i < 2; ++i) { const int cidx = tid + 512 * i, row = cidx >> 4, ch = cidx & 15; *(LAS v4u*)(buf + row * KPITCH + ch * 16) = kr[i]; *(LAS v4u*)(buf + AT_V + row * VPITCH + ch * 16) = vr[i]; }
}
__device__ __forceinline__ f32x16 qk_block(LAS unsigned char* KT, int kb, const h16x8 (&qf)[8], int lane) {
    f32x16 sacc;
#pragma unroll
    for (int i = 0; i < 16; ++i) sacc[i] = 0.f;
    LAS unsigned char* base = KT + (lane & 31) * KPITCH + (lane >> 5) * 16;
#pragma unroll
    for (int s = 0; s < 8; ++s) { const h16x8 kf = *(const LAS h16x8*)(base + kb * 32 * KPITCH + 32 * s); sacc = __builtin_amdgcn_mfma_f32_32x32x16_f16(kf, qf[s], sacc, 0, 0, 0); }
    return sacc;
}
__device__ __forceinline__ void pv_block(LAS unsigned char* VT, int kb, const h16x8 (&pf)[2], f32x16 (&oacc)[4], int lane) {
    const int h = lane >> 5, blk = (lane >> 4) & 1, q = (lane & 15) >> 2, p = lane & 3;
    LAS unsigned char* base = VT + (4 * h + q) * VPITCH + 32 * blk + 8 * p;
#pragma unroll
    for (int c = 0; c < 4; ++c)
#pragma unroll
        for (int s = 0; s < 2; ++s) {
            const h16x4 lo = tr_read(base + (kb * 32 + 16 * s) * VPITCH + 64 * c), hi = tr_read(base + (kb * 32 + 16 * s + 8) * VPITCH + 64 * c);
            const h16x8 vf = __builtin_shufflevector(lo, hi, 0, 1, 2, 3, 4, 5, 6, 7);
            oacc[c] = __builtin_amdgcn_mfma_f32_32x32x16_f16(vf, pf[s], oacc[c], 0, 0, 0);
            if (c == 1 && s == 1) asm volatile("" ::: "memory");
        }
}
__device__ __forceinline__ float lane_partner(float x) {
    const auto r = __builtin_amdgcn_permlane32_swap(__builtin_bit_cast(unsigned, x), __builtin_bit_cast(unsigned, x), false, false);
    return __builtin_bit_cast(float, (threadIdx.x & 32) ? r[0] : r[1]);
}
template <bool DIAG>
__device__ __forceinline__ void sb_weights(const f32x16& sacc, h16x8 (&pf)[2], float& C, int lane, int pos0, int t) {
    const int h = lane >> 5;
    float E[16], T[4], m1[4], m2[4], f0[4];
#pragma unroll
    for (int i = 0; i < 16; ++i) { float e = __builtin_amdgcn_exp2f(fminf(sacc[i], 24.f)); if (DIAG) e = (pos0 + crow(i, h) < t) ? e : 0.f; E[i] = e; }
#pragma unroll
    for (int g = 0; g < 4; ++g) { f0[g] = 1.f + E[4 * g]; m1[g] = f0[g] * (1.f + E[4 * g + 1]); m2[g] = m1[g] * (1.f + E[4 * g + 2]); T[g] = m2[g] * (1.f + E[4 * g + 3]); }
    float U[4], TPs[4];
#pragma unroll
    for (int g = 0; g < 4; ++g) { const float tp = lane_partner(T[g]); U[g] = T[g] * tp; TPs[g] = h ? 1.f : tp; }
    float V[4]; V[3] = C; V[2] = V[3] * U[3]; V[1] = V[2] * U[2]; V[0] = V[1] * U[1]; C = V[0] * U[0];
    float a[16];
#pragma unroll
    for (int g = 0; g < 4; ++g) { const float r = __builtin_amdgcn_rcpf(T[g] * (V[g] * TPs[g]));
        a[4 * g] = E[4 * g] * r; a[4 * g + 1] = E[4 * g + 1] * (r * f0[g]); a[4 * g + 2] = E[4 * g + 2] * (r * m1[g]); a[4 * g + 3] = E[4 * g + 3] * (r * m2[g]); }
#pragma unroll
    for (int s = 0; s < 2; ++s)
#pragma unroll
        for (int j = 0; j < 8; ++j) pf[s][j] = (_Float16)a[8 * s + j];
}
__device__ __forceinline__ void sb_attn_unit(LAS unsigned char* lds, const h16* PROJ, const float* gsb, h16* OG, float* SSQ16, int b, int head, int qt, int tid, int lane, int wave) {
    const int h = lane >> 5, n = lane & 31, q0 = 256 * qt + 32 * wave, t = q0 + n;
    const unsigned mrow = (unsigned)b * S + t;
    const unsigned prow = mrow * (unsigned)(LDP * 2);
    h16x8 qf[8];
#pragma unroll
    for (int s = 0; s < 8; ++s) qf[s] = *(const h16x8*)((const char*)PROJ + prow + (C_SBQ + head * HD + 16 * s + 8 * h) * 2);
    f32x16 oacc[4];
#pragma unroll
    for (int c = 0; c < 4; ++c)
#pragma unroll
        for (int i = 0; i < 16; ++i) oacc[c][i] = 0.f;
    float C = 1.f;
    const int jmax = 4 * qt + 3;
    const h16* gK = PROJ + (size_t)b * S * LDP + C_SBK + head * HD; const h16* gV = PROJ + (size_t)b * S * LDP + C_SBV + head * HD;
    v4u kr[2], vr[2];
    __syncthreads();
    tile_gload(gK + (size_t)(64 * jmax) * LDP, gV + (size_t)(64 * jmax) * LDP, (unsigned)LDP, kr, vr, tid);
    tile_lstore(lds, kr, vr, tid);
    __syncthreads();
    for (int j = jmax; j >= 0; --j) {
        LAS unsigned char* buf = lds + ((jmax - j) & 1) * AT_BUF;
        if (j > 0) tile_gload(gK + (size_t)(64 * (j - 1)) * LDP, gV + (size_t)(64 * (j - 1)) * LDP, (unsigned)LDP, kr, vr, tid);
#pragma unroll
        for (int kb = 1; kb >= 0; --kb) {
            const int pos0 = 64 * j + 32 * kb;
            if (pos0 < q0 + 31) {
                const f32x16 sacc = qk_block(buf, kb, qf, lane);
                h16x8 pf[2];
                if (pos0 + 31 >= q0) sb_weights<true>(sacc, pf, C, lane, pos0, t); else sb_weights<false>(sacc, pf, C, lane, pos0, t);
                pv_block(buf + AT_V, kb, pf, oacc, lane);
            }
        }
        if (j > 0) tile_lstore(lds + (((jmax - j) & 1) ^ 1) * AT_BUF, kr, vr, tid);
        __syncthreads();
    }
    float ss = 0.f;
#pragma unroll
    for (int c = 0; c < 4; ++c)
#pragma unroll
        for (int i = 0; i < 16; ++i) ss += oacc[c][i] * oacc[c][i];
    ss += lane_partner(ss);
    if (h == 0) *(float*)((char*)SSQ16 + (mrow * 16u + head) * 4u) = ss;
#pragma unroll
    for (int c = 0; c < 4; ++c)
#pragma unroll
        for (int g = 0; g < 4; ++g) {
            const int d0 = 32 * c + 8 * g + 4 * h;
            const h16x4 z4 = *(const h16x4*)((const char*)PROJ + prow + (C_SBZ + head * HD + d0) * 2); const f32x4v g4 = *(const f32x4v*)(gsb + head * HD + d0);
            h16x4 o4;
#pragma unroll
            for (int e = 0; e < 4; ++e) { const float z = (float)z4[e]; o4[e] = (_Float16)(oacc[c][4 * g + e] * g4[e] * (z / (1.f + __expf(-z)))); }
            *(h16x4*)((char*)OG + mrow * 4096u + (head * HD + d0) * 2) = o4;
        }
}


constexpr float LOG2E = 1.4426950408889634f;
constexpr int NS_BT = 2 * AT_BUF, NS_IMPG = NS_BT + 16384, NS_IMPL = NS_IMPG + 16384, NS_OFIN = NS_IMPG;
static_assert(NS_OFIN + 65536 <= 157696, "NSA LDS map");
constexpr int BT_SHIFT = 96;
template <int CTRL> __device__ __forceinline__ float dpp_f(float x) { return __builtin_bit_cast(float, __builtin_amdgcn_update_dpp(0, __builtin_bit_cast(int, x), CTRL, 0xf, 0xf, true)); }
__device__ __forceinline__ float quad_sum(float x) { x += dpp_f<0xB1>(x); x += dpp_f<0x4E>(x); return x; }
template <int MODE>
__device__ __forceinline__ unsigned nsa_scores(const f32x16& sacc, float (&sv)[16], const LAS float* BTr, float b31, int d0, int h, bool selbit, bool far) {
    unsigned vm = 0u;
    const LAS float* bp = BTr + 4 * (d0 + BT_SHIFT - 4 * h - 27);
#pragma unroll
    for (int i = 0; i < 16; ++i) {
        const int dist = d0 - (MODE == 0 ? 16 : 1) * crow(i, h);
        bool ok = dist >= 0; if (MODE == 2) ok = ok && selbit; if (MODE == 3) ok = ok && dist < 512;
        float bias;
        if (MODE == 0) bias = far ? b31 : BTr[4 * (min(max(dist, 0), 1023 - BT_SHIFT) + BT_SHIFT)];
        else bias = far ? b31 : bp[4 * (27 - (i & 3) - 8 * (i >> 2))];
        sv[i] = ok ? sacc[i] + bias : -1e30f; vm |= ok ? (1u << i) : 0u;
    }
    return vm;
}
__device__ __forceinline__ float max16(const float (&sv)[16]) {
    float a = fmaxf(fmaxf(sv[0], sv[1]), fmaxf(sv[2], sv[3])), b = fmaxf(fmaxf(sv[4], sv[5]), fmaxf(sv[6], sv[7])), c = fmaxf(fmaxf(sv[8], sv[9]), fmaxf(sv[10], sv[11])), d = fmaxf(fmaxf(sv[12], sv[13]), fmaxf(sv[14], sv[15]));
    return fmaxf(fmaxf(a, b), fmaxf(c, d));
}
__device__ __forceinline__ void online_step(const float (&sv)[16], unsigned vm, float& m, float& l, float (&pv)[16], f32x16 (&oacc)[4]) {
    float bm = max16(sv); bm = fmaxf(bm, lane_partner(bm));
    const float mn = fmaxf(m, bm), alpha = __builtin_amdgcn_exp2f(m - mn);
    float ps = 0.f;
#pragma unroll
    for (int i = 0; i < 16; ++i) { pv[i] = ((vm >> i) & 1u) ? __builtin_amdgcn_exp2f(sv[i] - mn) : 0.f; ps += pv[i]; }
    ps += lane_partner(ps);
    l = l * alpha + ps; m = mn;
#pragma unroll
    for (int c = 0; c < 4; ++c)
#pragma unroll
        for (int i = 0; i < 16; ++i) oacc[c][i] *= alpha;
}
__device__ __forceinline__ void pack_p(const float (&pv)[16], float scale, h16x8 (&pf)[2]) {
#pragma unroll
    for (int s = 0; s < 2; ++s)
#pragma unroll
        for (int j = 0; j < 8; ++j) pf[s][j] = (_Float16)(pv[8 * s + j] * scale);
}
#define NSA_LOOP_BEGIN(GK, GV, PITCH, J0, J1) { \
    const h16* _gk = (GK); const h16* _gv = (GV); const int _j0 = (J0), _j1 = (J1); const unsigned _pitch = (PITCH); v4u _kr[2], _vr[2]; \
    __syncthreads(); \
    tile_gload(_gk + (size_t)(64 * _j0) * _pitch, _gv + (size_t)(64 * _j0) * _pitch, _pitch, _kr, _vr, tid); tile_lstore(lds, _kr, _vr, tid); \
    __syncthreads(); \
    for (int j = _j0; j <= _j1; ++j) { LAS unsigned char* buf = lds + ((j - _j0) & 1) * AT_BUF; \
        if (j < _j1) tile_gload(_gk + (size_t)(64 * (j + 1)) * _pitch, _gv + (size_t)(64 * (j + 1)) * _pitch, _pitch, _kr, _vr, tid);
#define NSA_LOOP_END() \
        if (j < _j1) tile_lstore(lds + (((j - _j0) & 1) ^ 1) * AT_BUF, _kr, _vr, tid); \
        __syncthreads(); } }

__device__ __forceinline__ void nsa_unit(LAS unsigned char* lds, const h16* PROJ, const h16* KCC, const h16* VCC, const float* rel_bias, const float* gnsa, h16* OG, float* SSQ16,
                                         int b, int g, int cur, int tid, int lane, int wave) {
    const int h = lane >> 5, n = lane & 31, tl = n >> 2, r = n & 3, hh = 4 * g + r, tw0 = 64 * cur + 8 * wave, t = tw0 + tl;
    const unsigned mrow = (unsigned)b * S + t;
    const unsigned prow = mrow * (unsigned)(LDP * 2);
    LAS float* BT = (LAS float*)(lds + NS_BT); LAS float* IMPG = (LAS float*)(lds + NS_IMPG); LAS float* IMPL = (LAS float*)(lds + NS_IMPL);
    __syncthreads();
    for (int i = tid; i < 4096; i += NTHR) BT[i] = rel_bias[rel_bucket(max((i >> 2) - BT_SHIFT, 0)) * NHEAD + 4 * g + (i & 3)] * LOG2E;
    for (int i = tid; i < 8192; i += NTHR) IMPG[i] = 0.f;
    h16x8 qf[8];
#pragma unroll
    for (int s = 0; s < 8; ++s) qf[s] = *(const h16x8*)((const char*)PROJ + prow + (C_NQ + hh * HD + 16 * s + 8 * h) * 2);
#define NSA_GATE(k) (1.f / (1.f + __expf(-(float)*(const h16*)((const char*)PROJ + prow + (C_GATE + hh * 3 + (k)) * 2))))
    f32x16 oacc[4];
    LAS unsigned char* OFIN = lds + NS_OFIN + wave * 8192 + lane * 16;
#pragma unroll
    for (int c = 0; c < 4; ++c)
#pragma unroll
        for (int i = 0; i < 16; ++i) oacc[c][i] = 0.f;
    __syncthreads();
    const LAS float* BTr = BT + r; const float b31 = BT[4 * 1023 + r];

    const h16* gKC = KCC + (size_t)(b * NG + g) * NCBP * HD; const h16* gVC = VCC + (size_t)(b * NG + g) * NCBP * HD;
    const int jc1 = (4 * cur + 2) >> 6;
    float mc = -1e30f, lc = 0.f;
    NSA_LOOP_BEGIN(gKC, gVC, HD, 0, jc1)
#pragma unroll
        for (int kb = 0; kb < 2; ++kb) {
            const int nb = 64 * j + 32 * kb;
            if (16 * nb + 31 <= tw0 + 7) {
                const f32x16 sacc = qk_block(buf, kb, qf, lane); float sv[16];
                const bool far = (tw0 - 31 - 16 * (nb + 31)) >= 790;
                const unsigned vm = nsa_scores<0>(sacc, sv, BTr, b31, t - 31 - 16 * nb, h, true, far);
                float bm = max16(sv); bm = fmaxf(bm, lane_partner(bm));
                const float mn = fmaxf(mc, bm), alpha = __builtin_amdgcn_exp2f(mc - mn); float ps = 0.f;
#pragma unroll
                for (int i = 0; i < 16; ++i) ps += ((vm >> i) & 1u) ? __builtin_amdgcn_exp2f(sv[i] - mn) : 0.f;
                ps += lane_partner(ps); lc = lc * alpha + ps; mc = mn;
            }
        }
    NSA_LOOP_END()
    const float invlc = lc > 0.f ? 1.f / lc : 0.f, g0 = NSA_GATE(0);
    NSA_LOOP_BEGIN(gKC, gVC, HD, 0, jc1)
#pragma unroll
        for (int kb = 0; kb < 2; ++kb) {
            const int nb = 64 * j + 32 * kb;
            if (16 * nb + 31 <= tw0 + 7) {
                const f32x16 sacc = qk_block(buf, kb, qf, lane); float sv[16], pv[16];
                const bool far = (tw0 - 31 - 16 * (nb + 31)) >= 790;
                const unsigned vm = nsa_scores<0>(sacc, sv, BTr, b31, t - 31 - 16 * nb, h, true, far);
#pragma unroll
                for (int i = 0; i < 16; ++i) pv[i] = ((vm >> i) & 1u) ? __builtin_amdgcn_exp2f(sv[i] - mc) * invlc : 0.f;
#pragma unroll
                for (int gq = 0; gq < 4; ++gq) {
                    const float gs = quad_sum((pv[4 * gq] + pv[4 * gq + 1]) + (pv[4 * gq + 2] + pv[4 * gq + 3])), ls = quad_sum(pv[4 * gq + 3]);
                    const int jsel = (nb >> 2) + 2 * gq + h;
                    if (r == 0) { IMPG[(8 * wave + tl) * 64 + jsel] = gs; if (jsel + 1 < 64) IMPL[(8 * wave + tl) * 64 + jsel + 1] = ls; }
                }
                h16x8 pf[2]; pack_p(pv, g0, pf);
                pv_block(buf + AT_V, kb, pf, oacc, lane);
            }
        }
    NSA_LOOP_END()
    unsigned sel_lo = 0u, sel_hi = 0u;
#pragma unroll 1
    for (int tk = 0; tk < 8; ++tk) {
        const int jb = lane; const float imp = IMPG[(8 * wave + tk) * 64 + jb] + IMPL[(8 * wave + tk) * 64 + jb];
        const bool valid = jb <= cur, forced = (jb == 0) || (jb == cur) || (jb == cur - 1);
        const unsigned key = (valid ? ((forced ? 0x4e6e6b28u   : __builtin_bit_cast(unsigned, imp)) & ~63u) : 0u) | (unsigned)(63 - jb);
        int rank = 0;
#pragma unroll
        for (int i = 0; i < 64; ++i) rank += ((unsigned)__builtin_amdgcn_readlane((int)key, i) > key) ? 1 : 0;
        const u64 mask = __ballot(rank < 16);
        if (tl == tk) { sel_lo = (unsigned)mask; sel_hi = (unsigned)(mask >> 32); }
    }
    __syncthreads();
#pragma unroll
    for (int c = 0; c < 4; ++c)
#pragma unroll
        for (int k = 0; k < 2; ++k) { h16x8 w;
#pragma unroll
            for (int e = 0; e < 8; ++e) w[e] = (_Float16)oacc[c][8 * k + e];
            *(LAS h16x8*)(OFIN + (2 * c + k) * 1024) = w; }
    {
#pragma unroll
        for (int c = 0; c < 4; ++c)
#pragma unroll
            for (int i = 0; i < 16; ++i) oacc[c][i] = 0.f;
        float m = -1e30f, l = 0.f;
        const h16* gK = PROJ + (size_t)b * S * LDP + C_KS + g * HD; const h16* gV = PROJ + (size_t)b * S * LDP + C_VS + g * HD;
        NSA_LOOP_BEGIN(gK, gV, LDP, 0, cur)
            const bool selbit = (((j < 32) ? (sel_lo >> j) : (sel_hi >> (j - 32))) & 1u) != 0u;
            if (__any(selbit)) {
#pragma unroll
                for (int kb = 0; kb < 2; ++kb) {
                    const int pos0 = 64 * j + 32 * kb;
                    if (pos0 <= tw0 + 7) {
                        const f32x16 sacc = qk_block(buf, kb, qf, lane); float sv[16], pv[16];
                        const bool far = (tw0 - (pos0 + 31)) >= 790;
                        const unsigned vm = nsa_scores<2>(sacc, sv, BTr, b31, t - pos0, h, selbit, far);
                        online_step(sv, vm, m, l, pv, oacc);
                        h16x8 pf[2]; pack_p(pv, 1.f, pf);
                        pv_block(buf + AT_V, kb, pf, oacc, lane);
                    }
                }
            }
    NSA_LOOP_END()
        const float cs = NSA_GATE(1) / l;
#pragma unroll
        for (int c = 0; c < 4; ++c)
#pragma unroll
            for (int k = 0; k < 2; ++k) { h16x8 w = *(const LAS h16x8*)(OFIN + (2 * c + k) * 1024);
#pragma unroll
                for (int e = 0; e < 8; ++e) w[e] = (_Float16)((float)w[e] + cs * oacc[c][8 * k + e]);
                *(LAS h16x8*)(OFIN + (2 * c + k) * 1024) = w; }
    }
    {
#pragma unroll
        for (int c = 0; c < 4; ++c)
#pragma unroll
            for (int i = 0; i < 16; ++i) oacc[c][i] = 0.f;
        float m = -1e30f, l = 0.f;
        const h16* gK = PROJ + (size_t)b * S * LDP + C_KW + g * HD; const h16* gV = PROJ + (size_t)b * S * LDP + C_VW + g * HD;
        NSA_LOOP_BEGIN(gK, gV, LDP, max(0, cur - 8), cur)
#pragma unroll
            for (int kb = 0; kb < 2; ++kb) {
                const int pos0 = 64 * j + 32 * kb;
                if (pos0 <= tw0 + 7 && (tw0 - (pos0 + 31)) < 512) {
                    const f32x16 sacc = qk_block(buf, kb, qf, lane); float sv[16], pv[16];
                    const unsigned vm = nsa_scores<3>(sacc, sv, BTr, b31, t - pos0, h, true, false);
                    online_step(sv, vm, m, l, pv, oacc);
                    h16x8 pf[2]; pack_p(pv, 1.f, pf);
                    pv_block(buf + AT_V, kb, pf, oacc, lane);
                }
            }
    NSA_LOOP_END()
        const float cs = NSA_GATE(2) / l;
#pragma unroll
        for (int c = 0; c < 4; ++c)
#pragma unroll
            for (int k = 0; k < 2; ++k) { const h16x8 w = *(const LAS h16x8*)(OFIN + (2 * c + k) * 1024);
#pragma unroll
                for (int e = 0; e < 8; ++e) oacc[c][8 * k + e] = (float)w[e] + cs * oacc[c][8 * k + e]; }
    }
    float ss = 0.f;
#pragma unroll
    for (int c = 0; c < 4; ++c)
#pragma unroll
        for (int i = 0; i < 16; ++i) ss += oacc[c][i] * oacc[c][i];
    ss += lane_partner(ss);
    if (h == 0) *(float*)((char*)SSQ16 + (mrow * 16u + 8 + hh) * 4u) = ss;
#pragma unroll
    for (int c = 0; c < 4; ++c)
#pragma unroll
        for (int gq = 0; gq < 4; ++gq) {
            const int d0 = 32 * c + 8 * gq + 4 * h;
            const h16x4 z4 = *(const h16x4*)((const char*)PROJ + prow + (C_NZ + hh * HD + d0) * 2); const f32x4v g4 = *(const f32x4v*)(gnsa + hh * HD + d0);
            h16x4 o4;
#pragma unroll
            for (int e = 0; e < 4; ++e) { const float z = (float)z4[e]; o4[e] = (_Float16)(oacc[c][4 * gq + e] * g4[e] * (z / (1.f + __expf(-z)))); }
            *(h16x4*)((char*)OG + mrow * 4096u + (1024 + hh * HD + d0) * 2) = o4;
        }
}

struct Args { const float* in[14]; float* out; unsigned char* ws; int ph_lo, ph_hi; };

__global__ void __launch_bounds__(NTHR, 2) fwd(Args args) {
    extern __shared__ __attribute__((aligned(16))) unsigned char lds_raw[];
    LAS unsigned char* lds = (LAS unsigned char*)lds_raw;
    volatile LAS unsigned* MISC = (volatile LAS unsigned*)(lds + MISC_OFF);
    const int tid = threadIdx.x, lane = tid & 63, wave = __builtin_amdgcn_readfirstlane(tid >> 6);
    const int G = gridDim.x; const int bx = blockIdx.x; const int vcu = (G % 8 == 0) ? (bx % 8) * (G / 8) + bx / 8 : bx;
    unsigned char* ws = args.ws;
    unsigned* ctl = (unsigned*)(ws + WS_CTL);
    for (int u = tid; u < (LDS_BYTES - LDSCTL_OFF) / 4; u += NTHR) ((LAS unsigned*)(lds + LDSCTL_OFF))[u] = 0u;
    __syncthreads();
    XcdBarrier bar = xcd_barrier_post(ctl + CW_BAR, MISC + 8);
    const int lo = args.ph_lo, hi = args.ph_hi;
#define IN(k) (lo <= (k) && (k) < hi)
#define BOTH(k) (IN(k) && IN((k) + 1))
    h16* XN = (h16*)(ws + WS_XN); h16* WINT = (h16*)(ws + WS_WINT); h16* WOUTT = (h16*)(ws + WS_WOUTT); h16* PROJ = (h16*)(ws + WS_PROJ);

    if (IN(0)) {
        LAS float* scr = (LAS float*)(lds + RING_OFF + wave * 16384);
        const int gw = vcu * NWAVES + wave, NGW = G * NWAVES;
        constexpr int I_IN = (D / 64) * (LDP / 32), I_OUT = (D / 64) * (D / 32);
        for (int it = gw; it < I_IN + I_OUT; it += NGW) {
            if (it < I_IN) p0_transpose_item(args.in[2], D, NPROJ, true, WINT, scr, it, LDP / 32, lane);
            else p0_transpose_item(args.in[12], D, D, false, WOUTT, scr, it - I_IN, D / 32, lane);
        }
        for (int m = gw; m < M; m += NGW) p0_rms_row(args.in[0] + (size_t)m * D, args.in[1], XN + (size_t)m * D, lane);
        if (BOTH(0)) xcd_barrier(bar);
    }
    if (IN(1)) {
        pg8::Gemm g{(const pg8::bf16_t*)XN, (const pg8::bf16_t*)WINT, M, LDP, D}; pg8::StaticOrder SO; SO.init(M, LDP, G, bx);
        pg8::EpiF16 E{PROJ, LDP, QSCALE};
        pg8::gemm_phase<pg8::EpiF16, pg8::StaticOrder, true, true>(lds + RING_OFF, g, SO, E);
        if (BOTH(1)) xcd_barrier(bar);
    }
    if (IN(2)) {
        h16* OG = (h16*)(ws + WS_OG); float* SSQ16 = (float*)(ws + WS_SSQ16);
        for (int idx = vcu; idx < 1024; idx += G) {
            const int r = idx >> 8, v = idx & 255, c = v >> 6, bh = v & 63;
            const int qt = (r == 0) ? 15 - c : (r == 1) ? 8 + c : (r == 2) ? 7 - c : c;
            sb_attn_unit(lds + RING_OFF, PROJ, args.in[10], OG, SSQ16, bh >> 3, bh & 7, qt, tid, lane, wave);
        }
        if (BOTH(2)) xcd_barrier(bar);
    }
    if (IN(3)) {
        h16* OG = (h16*)(ws + WS_OG); float* SSQ16 = (float*)(ws + WS_SSQ16); const h16* KCC = (const h16*)(ws + WS_KCC); const h16* VCC = (const h16*)(ws + WS_VCC);
        for (int idx = vcu; idx < 1024; idx += G) {
            const int rr = idx >> 8, v = idx & 255, c = v >> 4, bg = v & 15;
            const int cur = (rr == 0) ? 63 - c : (rr == 1) ? 32 + c : (rr == 2) ? 31 - c : c;
            nsa_unit(lds + RING_OFF, PROJ, KCC, VCC, args.in[9], args.in[11], OG, SSQ16, bg >> 1, bg & 1, cur, tid, lane, wave);
        }
        if (BOTH(3)) xcd_barrier(bar);
    }
#undef IN
#undef BOTH
}

extern "C" void kernel_launch(void* const* d_in, const int* in_sizes, int n_in, void* d_out, int out_size, void* d_ws, size_t ws_size, hipStream_t stream) {
    static int grid = 0;
    if (grid == 0) {
        if (n_in != 14 || in_sizes[0] != M * D || out_size != M * D || ws_size < WS_END) { fprintf(stderr, "kernel_launch: unexpected shapes (n_in %d in0 %d out %d ws %zu need %zu)\n", n_in, n_in > 0 ? in_sizes[0] : -1, out_size, ws_size, (size_t)WS_END); grid = -1; return; }
        int dev = 0, cus = 0, per_cu = 0;
        if (hipGetDevice(&dev) != hipSuccess || hipDeviceGetAttribute(&cus, hipDeviceAttributeMultiprocessorCount, dev) != hipSuccess) { grid = -1; return; }
        if (hipFuncSetAttribute((const void*)fwd, hipFuncAttributeMaxDynamicSharedMemorySize, LDS_BYTES) != hipSuccess) { fprintf(stderr, "kernel_launch: hipFuncSetAttribute failed\n"); grid = -1; return; }
        if (hipOccupancyMaxActiveBlocksPerMultiprocessor(&per_cu, (const void*)fwd, NTHR, LDS_BYTES) != hipSuccess || per_cu < 1) { fprintf(stderr, "kernel_launch: occupancy query says %d blocks per CU\n", per_cu); grid = -1; return; }
        (void)hipGetLastError();
        grid = cus;
    }
    if (grid < 0) return;
    const float* x = (const float*)d_in[0];
    const float* kpos = (const float*)d_in[3]; const float* kw1 = (const float*)d_in[4]; const float* kw2 = (const float*)d_in[5];
    const float* vpos = (const float*)d_in[6]; const float* vw1 = (const float*)d_in[7]; const float* vw2 = (const float*)d_in[8];
    const float* rel_bias = (const float*)d_in[9]; const float* norm_sb = (const float*)d_in[10]; const float* norm_nsa = (const float*)d_in[11];
    const float* norm_final = (const float*)d_in[13];
    unsigned char* ws = (unsigned char*)d_ws; float* out = (float*)d_out;
    h16* XN = (h16*)(ws + WS_XN); h16* WOUTT = (h16*)(ws + WS_WOUTT); h16* PROJ = (h16*)(ws + WS_PROJ);
    h16* KCC = (h16*)(ws + WS_KCC); h16* VCC = (h16*)(ws + WS_VCC); u64* SEL = (u64*)(ws + WS_SEL); float* OC = (float*)(ws + WS_OC);
    float* ONSA = out + (size_t)M * 1024;

    (void)hipMemsetAsync(ws + WS_CTL, 0, CTL_ZERO_BYTES, stream);
    Args a{};
    for (int i = 0; i < 14; ++i) a.in[i] = (const float*)d_in[i];
    a.out = out; a.ws = ws; a.ph_lo = 0; a.ph_hi = 3;
    hipLaunchKernelGGL(fwd, dim3(grid), dim3(NTHR), LDS_BYTES, stream, a);
    k_compress<<<dim3(NCBP, 4, NB), 256, 0, stream>>>(PROJ, kpos, kw1, kw2, vpos, vw1, vw2, KCC, VCC);
    (void)hipMemsetAsync(ws + WS_CTL, 0, CTL_ZERO_BYTES, stream);
    a.ph_lo = 3; a.ph_hi = 4;
    hipLaunchKernelGGL(fwd, dim3(grid), dim3(NTHR), LDS_BYTES, stream, a);
    k_make_y3<<<2048, 256, 0, stream>>>((const h16*)(ws + WS_OG), (const float*)(ws + WS_SSQ16), XN  );
    k_gemm_naive<1><<<dim3(D / 64, M / 64), 256, 0, stream>>>(XN, WOUTT, out, x, D, D);
    k_final_norm<<<2048, 256, 0, stream>>>(out, norm_final);
}
```

```cpp
#include <hip/hip_runtime.h>
#include <cstdio>
#include <cstdint>

typedef _Float16 h16;
typedef unsigned long long u64;

constexpr int NB = 8, S = 4096, D = 2048, M = NB * S;
constexpr int HD = 128, NHEAD = 8, NG = 2, NR = 4;
constexpr int NPROJ = 7704, LDP = 7936;
constexpr int C_SBQ = 0, C_SBK = 1024, C_SBV = 2048, C_SBZ = 3072, C_NQ = 4096, C_KC = 5120, C_VC = 5376, C_KS = 5632, C_VS = 5888,
              C_KW = 6144, C_VW = 6400, C_NZ = 6656, C_GATE = 7680;
constexpr int NCB = 255, NCBP = 256;
constexpr float RMS_EPS = 1e-6f;
constexpr float QSCALE = 0.08838834764831845f * 1.4426950408889634f;
constexpr float QMUL = 0.6931471805599453f;

constexpr size_t MiB = 1u << 20;
constexpr size_t WS_CTL = 0;
constexpr size_t WS_XN = 1 * MiB;
constexpr size_t WS_WINT = WS_XN + (size_t)M * D * 2;
constexpr size_t WS_WOUTT = WS_WINT + (size_t)LDP * D * 2;
constexpr size_t WS_PROJ = WS_WOUTT + (size_t)D * D * 2;
constexpr size_t WS_KCC = WS_PROJ + (size_t)M * LDP * 2;
constexpr size_t WS_VCC = WS_KCC + (size_t)NB * NG * NCBP * HD * 2;
constexpr size_t WS_SEL = WS_VCC + (size_t)NB * NG * NCBP * HD * 2;
constexpr size_t WS_OC = WS_SEL + (size_t)M * NG * 8;
constexpr size_t WS_SSQ = WS_OC + (size_t)M * 1024 * 4;
constexpr size_t WS_OG = WS_SSQ + (size_t)M * 32 * 4;
constexpr size_t WS_SSQ16 = WS_OG + (size_t)M * 2048 * 2;
constexpr size_t WS_END = WS_SSQ16 + (size_t)M * 16 * 4;

__device__ __forceinline__ int src_col(int c) { return c < 6656 ? c : (c < 7680 ? c + 24 : (c < NPROJ ? c - 1024 : -1)); }

__device__ __forceinline__ int rel_bucket(int dist) {
    if (dist < 16) return dist < 0 ? 0 : dist;
    int b = 16;
    b += dist >= 21; b += dist >= 27; b += dist >= 35; b += dist >= 46; b += dist >= 59; b += dist >= 77; b += dist >= 99; b += dist >= 128;
    b += dist >= 166; b += dist >= 216; b += dist >= 280; b += dist >= 363; b += dist >= 470; b += dist >= 609; b += dist >= 790;
    return b;
}
__device__ __forceinline__ float wave_sum(float v) {
#pragma unroll
    for (int o = 1; o < 64; o <<= 1) v += __shfl_xor(v, o);
    return v;
}
__device__ __forceinline__ float wave_max(float v) {
#pragma unroll
    for (int o = 1; o < 64; o <<= 1) v = fmaxf(v, __shfl_xor(v, o));
    return v;
}

__global__ void __launch_bounds__(256) k_rmsnorm_in(const float* __restrict__ x, const float* __restrict__ g, h16* __restrict__ xn) {
    const int lane = threadIdx.x & 63, w = (blockIdx.x * blockDim.x + threadIdx.x) >> 6, nw = (gridDim.x * blockDim.x) >> 6;
    for (int m = w; m < M; m += nw) {
        const float4* xr = (const float4*)(x + (size_t)m * D);
        float4 v[8]; float s = 0.f;
#pragma unroll
        for (int j = 0; j < 8; ++j) { v[j] = xr[lane + 64 * j]; s += v[j].x * v[j].x + v[j].y * v[j].y + v[j].z * v[j].z + v[j].w * v[j].w; }
        const float r = rsqrtf(wave_sum(s) * (1.f / D) + RMS_EPS);
#pragma unroll
        for (int j = 0; j < 8; ++j) {
            const float4 gg = ((const float4*)g)[lane + 64 * j];
            h16* o = xn + (size_t)m * D + 4 * (lane + 64 * j);
            o[0] = (h16)(v[j].x * r * gg.x); o[1] = (h16)(v[j].y * r * gg.y); o[2] = (h16)(v[j].z * r * gg.z); o[3] = (h16)(v[j].w * r * gg.w);
        }
    }
}
__global__ void __launch_bounds__(256) k_transpose_w(const float* __restrict__ W, h16* __restrict__ WT, int K, int ldw, int N_out, int remap) {
    __shared__ float t[32][33];
    const int k0 = blockIdx.x * 32, n0 = blockIdx.y * 32, tx = threadIdx.x & 31, ty = threadIdx.x >> 5;
    for (int i = ty; i < 32; i += 8) { const int n = n0 + tx; const int sc = remap ? src_col(n) : n; t[i][tx] = (sc >= 0) ? W[(size_t)(k0 + i) * ldw + sc] : 0.f; }
    __syncthreads();
    for (int i = ty; i < 32; i += 8) WT[(size_t)(n0 + i) * K + k0 + tx] = (h16)t[tx][i];
}

template <int MODE>
__global__ void __launch_bounds__(256) k_gemm_naive(const h16* __restrict__ A, const h16* __restrict__ Bt, void* __restrict__ Cv, const float* __restrict__ resid, int K, int ldc) {
    __shared__ float As[32][68], Bs[32][68];
    const int tx = threadIdx.x & 15, ty = threadIdx.x >> 4, m0 = blockIdx.y * 64, n0 = blockIdx.x * 64;
    float acc[4][4] = {};
    for (int k0 = 0; k0 < K; k0 += 32) {
        for (int i = threadIdx.x; i < 64 * 32; i += 256) { const int r = i >> 5, c = i & 31; As[c][r] = (float)A[(size_t)(m0 + r) * K + k0 + c]; Bs[c][r] = (float)Bt[(size_t)(n0 + r) * K + k0 + c]; }
        __syncthreads();
#pragma unroll 8
        for (int kk = 0; kk < 32; ++kk) {
            const float4 a = *(const float4*)&As[kk][ty * 4], b = *(const float4*)&Bs[kk][tx * 4];
            const float av[4] = {a.x, a.y, a.z, a.w}, bv[4] = {b.x, b.y, b.z, b.w};
#pragma unroll
            for (int i = 0; i < 4; ++i)
#pragma unroll
                for (int j = 0; j < 4; ++j) acc[i][j] += av[i] * bv[j];
        }
        __syncthreads();
    }
#pragma unroll
    for (int i = 0; i < 4; ++i)
#pragma unroll
        for (int j = 0; j < 4; ++j) {
            const size_t o = (size_t)(m0 + ty * 4 + i) * ldc + n0 + tx * 4 + j;
            if (MODE == 0) ((h16*)Cv)[o] = (h16)acc[i][j]; else ((float*)Cv)[o] = resid[o] + acc[i][j];
        }
}

__global__ void __launch_bounds__(256) k_compress(const h16* __restrict__ proj, const float* __restrict__ posk, const float* __restrict__ w1k, const float* __restrict__ w2k,
                                                  const float* __restrict__ posv, const float* __restrict__ w1v, const float* __restrict__ w2v, h16* __restrict__ kcc, h16* __restrict__ vcc) {
    __shared__ float in[32 * 128]; __shared__ float hid[256];
    const int n = blockIdx.x, g = blockIdx.y & 1, kv = blockIdx.y >> 1, b = blockIdx.z, e = threadIdx.x;
    const float* pos = kv ? posv : posk; const float* w1 = kv ? w1v : w1k; const float* w2 = kv ? w2v : w2k; h16* out = kv ? vcc : kcc;
    const int col0 = (kv ? C_VC : C_KC) + g * HD;
    if (n == NCB) { if (e < 128) out[((size_t)(b * NG + g) * NCBP + n) * HD + e] = (h16)0.f; return; }
    for (int i = e; i < 32 * 128; i += 256) { const int l = i >> 7, d = i & 127; in[i] = (float)proj[(size_t)(b * S + 16 * n + l) * LDP + col0 + d] + pos[i]; }
    __syncthreads();
    float acc = 0.f;
    for (int i = 0; i < 32 * 128; ++i) acc += in[i] * w1[(size_t)i * 256 + e];
    const float u = 0.7978845608028654f * (acc + 0.044715f * acc * acc * acc);
    hid[e] = 0.5f * acc * (1.f + tanhf(u));
    __syncthreads();
    if (e < 128) { float o = 0.f; for (int i = 0; i < 256; ++i) o += hid[i] * w2[i * 128 + e]; out[((size_t)(b * NG + g) * NCBP + n) * HD + e] = (h16)o; }
}

__global__ void __launch_bounds__(64) k_nsa_cmp(const h16* __restrict__ proj, const h16* __restrict__ kcc, const h16* __restrict__ vcc, const float* __restrict__ rel_bias,
                                                float* __restrict__ oc, u64* __restrict__ sel) {
    __shared__ float q[128]; __shared__ float P[4][256];
    const int t = blockIdx.x, g = blockIdx.y, b = blockIdx.z, lane = threadIdx.x; const size_t m = (size_t)b * S + t;
    const int nvalid = t < 31 ? 0 : min((t - 31) / 16 + 1, NCB);
    const h16* kc = kcc + (size_t)(b * NG + g) * NCBP * HD; const h16* vc = vcc + (size_t)(b * NG + g) * NCBP * HD;
    for (int r = 0; r < 4; ++r) {
        const int hh = g * 4 + r;
        __syncthreads();
        q[lane] = (float)proj[m * LDP + C_NQ + hh * HD + lane]; q[lane + 64] = (float)proj[m * LDP + C_NQ + hh * HD + lane + 64];
        __syncthreads();
        float sc[4]; float mx = -1e30f;
#pragma unroll
        for (int i = 0; i < 4; ++i) { const int n = lane + 64 * i; sc[i] = -1e30f;
            if (n < nvalid) { float s = 0.f; for (int d = 0; d < 128; ++d) s += q[d] * (float)kc[(size_t)n * HD + d];
                sc[i] = s * QMUL + rel_bias[rel_bucket(t - (16 * n + 31)) * NHEAD + hh]; }
            mx = fmaxf(mx, sc[i]); }
        mx = wave_max(mx); float l = 0.f;
#pragma unroll
        for (int i = 0; i < 4; ++i) { const int n = lane + 64 * i; sc[i] = (n < nvalid) ? __expf(sc[i] - mx) : 0.f; l += sc[i]; }
        l = wave_sum(l); const float inv = nvalid > 0 ? 1.f / l : 0.f;
#pragma unroll
        for (int i = 0; i < 4; ++i) P[r][lane + 64 * i] = sc[i] * inv;
        __syncthreads();
        float o0 = 0.f, o1 = 0.f;
        for (int n = 0; n < nvalid; ++n) { const float p = P[r][n]; o0 += p * (float)vc[(size_t)n * HD + lane]; o1 += p * (float)vc[(size_t)n * HD + lane + 64]; }
        oc[m * 1024 + hh * HD + lane] = o0; oc[m * 1024 + hh * HD + lane + 64] = o1;
    }
    __syncthreads();
    const int j = lane; float imp = 0.f;
    for (int r = 0; r < 4; ++r) for (int n = 4 * j - 1; n <= 4 * j + 3; ++n) if (n >= 0 && n < NCB) imp += P[r][n];
    const int cur = t >> 6; const bool valid = j * 64 <= t, forced = (j == 0) || (j == cur) || (j == cur - 1);
    const float score = valid ? (forced ? 1e9f : imp) : -1e9f;
    int rank = 0;
    for (int i = 0; i < 64; ++i) { const float si = __shfl(score, i); rank += (si > score) || (si == score && i < j); }
    const u64 mask = __ballot(rank < 16);
    if (lane == 0) sel[m * NG + g] = mask;
}

__global__ void __launch_bounds__(128) k_nsa_selwin(const h16* __restrict__ proj, const float* __restrict__ rel_bias, const u64* __restrict__ sel, const float* __restrict__ oc, float* __restrict__ onsa) {
    __shared__ h16 Kt[64 * 128]; __shared__ h16 Vt[64 * 128]; __shared__ float bt[1024];
    const int cur = blockIdx.x, hh = blockIdx.y, b = blockIdx.z, g = hh >> 2, tid = threadIdx.x, t = cur * 64 + (tid >> 1), d0 = (tid & 1) * 64; const size_t m = (size_t)b * S + t;
    for (int i = tid; i < 1024; i += 128) bt[i] = rel_bias[rel_bucket(i) * NHEAD + hh];
    __syncthreads();
    float q[64];
#pragma unroll
    for (int d = 0; d < 64; ++d) q[d] = (float)proj[m * LDP + C_NQ + hh * HD + d0 + d] * QMUL;
    const u64 mysel = sel[m * NG + g];
    const float g0 = 1.f / (1.f + __expf(-(float)proj[m * LDP + C_GATE + hh * 3 + 0])), g1 = 1.f / (1.f + __expf(-(float)proj[m * LDP + C_GATE + hh * 3 + 1])), g2 = 1.f / (1.f + __expf(-(float)proj[m * LDP + C_GATE + hh * 3 + 2]));
    for (int br = 0; br < 2; ++br) {
        float o[64];
#pragma unroll
        for (int d = 0; d < 64; ++d) o[d] = 0.f;
        float mx = -1e30f, l = 0.f;
        const int kcol = (br ? C_KW : C_KS) + g * HD, vcol = (br ? C_VW : C_VS) + g * HD;
        const int j0 = br ? max(0, cur - 8) : 0;
        for (int j = j0; j <= cur; ++j) {
            const bool act = br ? true : ((mysel >> j) & 1ull) != 0ull;
            if (!__syncthreads_or(act ? 1 : 0)) continue;
            for (int i = tid; i < 64 * 128 / 8; i += 128) { const int r = i >> 4, c = (i & 15) * 8; const size_t row = (size_t)(b * S + j * 64 + r) * LDP;
                *(uint4*)&Kt[r * 128 + c] = *(const uint4*)&proj[row + kcol + c]; *(uint4*)&Vt[r * 128 + c] = *(const uint4*)&proj[row + vcol + c]; }
            __syncthreads();
            for (int c0 = 0; c0 < 64; c0 += 16) {
                float sc[16]; float cm = -1e30f;
#pragma unroll
                for (int kk = 0; kk < 16; ++kk) { const int pos = j * 64 + c0 + kk, dist = t - pos; const bool ok = act && dist >= 0 && (br == 0 || dist < 512);
                    float s = 0.f;
#pragma unroll
                    for (int d = 0; d < 64; ++d) s += q[d] * (float)Kt[(c0 + kk) * 128 + d0 + d];
                    s += __shfl_xor(s, 1);
                    s += bt[min(max(dist, 0), 1023)];
                    sc[kk] = ok ? s : -1e30f; cm = fmaxf(cm, sc[kk]); }
                if (cm > -1e29f) {
                    const float mn = fmaxf(mx, cm), al = __expf(mx - mn); mx = mn; l *= al;
#pragma unroll
                    for (int d = 0; d < 64; ++d) o[d] *= al;
#pragma unroll
                    for (int kk = 0; kk < 16; ++kk) { const float p = sc[kk] > -1e29f ? __expf(sc[kk] - mn) : 0.f; l += p;
#pragma unroll
                        for (int d = 0; d < 64; ++d) o[d] += p * (float)Vt[(c0 + kk) * 128 + d0 + d]; }
                }
            }
        }
        const float inv = 1.f / l;
        float* dst = onsa + m * 1024 + hh * HD + d0; const float* ocr = oc + m * 1024 + hh * HD + d0;
        if (br == 0) {
#pragma unroll
            for (int d = 0; d < 64; ++d) dst[d] = g0 * ocr[d] + g1 * o[d] * inv;
        } else {
#pragma unroll
            for (int d = 0; d < 64; ++d) dst[d] += g2 * o[d] * inv;
        }
    }
}

__global__ void __launch_bounds__(128) k_sb_naive(const h16* __restrict__ proj, float* __restrict__ osb) {
    __shared__ h16 Kt[64 * 128]; __shared__ h16 Vt[64 * 128];
    const int cur = blockIdx.x, h = blockIdx.y, b = blockIdx.z, tid = threadIdx.x, t = cur * 64 + (tid >> 1), d0 = (tid & 1) * 64; const size_t m = (size_t)b * S + t;
    float q[64], o[64];
#pragma unroll
    for (int d = 0; d < 64; ++d) { q[d] = (float)proj[m * LDP + C_SBQ + h * HD + d0 + d] * QMUL; o[d] = 0.f; }
    float cum = 0.f;
    for (int j = cur; j >= 0; --j) {
        __syncthreads();
        for (int i = tid; i < 64 * 128 / 8; i += 128) { const int r = i >> 4, c = (i & 15) * 8; const size_t row = (size_t)(b * S + j * 64 + r) * LDP;
            *(uint4*)&Kt[r * 128 + c] = *(const uint4*)&proj[row + C_SBK + h * HD + c]; *(uint4*)&Vt[r * 128 + c] = *(const uint4*)&proj[row + C_SBV + h * HD + c]; }
        __syncthreads();
        for (int kk = 63; kk >= 0; --kk) {
            const int pos = j * 64 + kk;
            float z = 0.f;
#pragma unroll
            for (int d = 0; d < 64; ++d) z += q[d] * (float)Kt[kk * 128 + d0 + d];
            z += __shfl_xor(z, 1);
            const float sp = fmaxf(z, 0.f) + log1pf(__expf(-fabsf(z)));
            const float log_rest = -sp, log_beta = z - sp;
            const float a = (pos < t) ? __expf(log_beta + cum) : 0.f;
            if (pos < t) cum += log_rest;
#pragma unroll
            for (int d = 0; d < 64; ++d) o[d] += a * (float)Vt[kk * 128 + d0 + d];
        }
    }
#pragma unroll
    for (int d = 0; d < 64; ++d) osb[m * 1024 + h * HD + d0 + d] = o[d];
}

__global__ void __launch_bounds__(256) k_make_y(const float* __restrict__ osb, const float* __restrict__ onsa, const h16* __restrict__ proj, const float* __restrict__ gsb, const float* __restrict__ gnsa, h16* __restrict__ y) {
    const int lane = threadIdx.x & 63, w = (blockIdx.x * blockDim.x + threadIdx.x) >> 6, nw = (gridDim.x * blockDim.x) >> 6;
    for (int i = w; i < 2 * M; i += nw) {
        const int m = i >> 1, part = i & 1;
        const float* src = (part ? onsa : osb) + (size_t)m * 1024; const float* gg = part ? gnsa : gsb; const h16* zz = proj + (size_t)m * LDP + (part ? C_NZ : C_SBZ);
        float v[16]; float s = 0.f;
#pragma unroll
        for (int j = 0; j < 16; ++j) { v[j] = src[lane + 64 * j]; s += v[j] * v[j]; }
        const float r = rsqrtf(wave_sum(s) * (1.f / 1024.f) + RMS_EPS);
#pragma unroll
        for (int j = 0; j < 16; ++j) { const int c = lane + 64 * j; const float z = (float)zz[c]; y[(size_t)m * D + part * 1024 + c] = (h16)(v[j] * r * gg[c] * (z / (1.f + __expf(-z)))); }
    }
}
__global__ void __launch_bounds__(256) k_make_y2(const h16* __restrict__ og, const float* __restrict__ ssq16, const float* __restrict__ onsa, const h16* __restrict__ proj, const float* __restrict__ gnsa, h16* __restrict__ y) {
    const int lane = threadIdx.x & 63, w = (blockIdx.x * blockDim.x + threadIdx.x) >> 6, nw = (gridDim.x * blockDim.x) >> 6;
    for (int i = w; i < 2 * M; i += nw) {
        const int m = i >> 1, part = i & 1;
        if (part == 0) {
            float s = 0.f;
            for (int k = 0; k < 8; ++k) s += ssq16[(size_t)m * 16 + k];
            const float r = rsqrtf(s * (1.f / 1024.f) + RMS_EPS);
            for (int j = 0; j < 16; ++j) { const int c = lane + 64 * j; y[(size_t)m * D + c] = (h16)((float)og[(size_t)m * 2048 + c] * r); }
        } else {
            const float* src = onsa + (size_t)m * 1024; const h16* zz = proj + (size_t)m * LDP + C_NZ;
            float v[16]; float s = 0.f;
#pragma unroll
            for (int j = 0; j < 16; ++j) { v[j] = src[lane + 64 * j]; s += v[j] * v[j]; }
            const float r = rsqrtf(wave_sum(s) * (1.f / 1024.f) + RMS_EPS);
#pragma unroll
            for (int j = 0; j < 16; ++j) { const int c = lane + 64 * j; const float z = (float)zz[c]; y[(size_t)m * D + 1024 + c] = (h16)(v[j] * r * gnsa[c] * (z / (1.f + __expf(-z)))); }
        }
    }
}
__global__ void __launch_bounds__(256) k_make_y3(const h16* __restrict__ og, const float* __restrict__ ssq16, h16* __restrict__ y) {
    const int lane = threadIdx.x & 63, w = (blockIdx.x * blockDim.x + threadIdx.x) >> 6, nw = (gridDim.x * blockDim.x) >> 6;
    for (int i = w; i < 2 * M; i += nw) {
        const int m = i >> 1, part = i & 1;
        float s = 0.f;
        for (int k = 0; k < 8; ++k) s += ssq16[(size_t)m * 16 + 8 * part + k];
        const float r = rsqrtf(s * (1.f / 1024.f) + RMS_EPS);
        for (int j = 0; j < 16; ++j) { const int c = part * 1024 + lane + 64 * j; y[(size_t)m * D + c] = (h16)((float)og[(size_t)m * 2048 + c] * r); }
    }
}
__global__ void __launch_bounds__(256) k_final_norm(float* __restrict__ out, const float* __restrict__ g) {
    const int lane = threadIdx.x & 63, w = (blockIdx.x * blockDim.x + threadIdx.x) >> 6, nw = (gridDim.x * blockDim.x) >> 6;
    for (int m = w; m < M; m += nw) {
        float4* xr = (float4*)(out + (size_t)m * D);
        float4 v[8]; float s = 0.f;
#pragma unroll
        for (int j = 0; j < 8; ++j) { v[j] = xr[lane + 64 * j]; s += v[j].x * v[j].x + v[j].y * v[j].y + v[j].z * v[j].z + v[j].w * v[j].w; }
        const float r = rsqrtf(wave_sum(s) * (1.f / D) + RMS_EPS);
#pragma unroll
        for (int j = 0; j < 8; ++j) { const float4 gg = ((const float4*)g)[lane + 64 * j]; xr[lane + 64 * j] = make_float4(v[j].x * r * gg.x, v[j].y * r * gg.y, v[j].z * r * gg.z, v[j].w * r * gg.w); }
    }
}

namespace pg8 {
#define PG8_LAS __attribute__((address_space(3)))
typedef unsigned short bf16_t;
typedef _Float16 bf16x8 __attribute__((ext_vector_type(8)));
typedef float f32x4 __attribute__((ext_vector_type(4)));
typedef unsigned u32x4 __attribute__((ext_vector_type(4)));
constexpr int BM = 256, BK = 64, HALF = 128, HTB = HALF * BK * 2  , STAGE_BYTES = 8 * HTB, NXCD = 8, WGM = 8;

__host__ __device__ __forceinline__ int lds_byte(int r, int c) { const int st = (r >> 4) * 2 + (c >> 5), rr = r & 15, cc = c & 31, ob = rr * 64 + cc * 2; return st * 1024 + (ob ^ (((ob >> 9) & 1) << 5)); }
__host__ __device__ __forceinline__ void stage_rc(int b, int& R, int& C) { const int st = b / 1024, sb = b % 1024, swz = sb ^ (((sb >> 9) & 1) << 5); R = (st >> 1) * 16 + swz / 64; C = (st & 1) * 32 + (swz % 64) / 2; }
__host__ __device__ __forceinline__ int perm32(int rho) { const int n = rho >> 4, i = rho & 15; return 8 * (i >> 2) + 4 * n + (i & 3); }

struct Unit { int pm, pn; };
struct Gemm { const bf16_t* A; const bf16_t* Bt; int M, N, K; };

struct StaticOrder {
    int nM, nN, nwg, G, c;
    __host__ __device__ void init(int M, int N, int G_, int c_) { nM = M / BM; nN = N / BM; nwg = nM * nN; G = G_; c = c_; }
    __host__ __device__ bool next(int i, Unit& u) const {
        const long L = (long)i * G + c; if (L >= nwg) return false;
        int wgid = (int)L; { const int q = nwg / NXCD, r = nwg % NXCD, xcd = wgid % NXCD, off = wgid / NXCD; wgid = (xcd < r ? xcd * (q + 1) : r * (q + 1) + (xcd - r) * q) + off; }
        const int nig = WGM * nN, gid = wgid / nig, fm = gid * WGM, gsz = (nM - fm) < WGM ? (nM - fm) : WGM;
        u.pm = fm + ((wgid % nig) % gsz); u.pn = (wgid % nig) / gsz; return true;
    }
    __device__ __forceinline__ void a_ready(const Unit&) const {}
    __device__ __forceinline__ void done(const Unit&) const {}
};

struct EpiF16 {
    static constexpr bool PERM = true, AFTER_DRAIN = false;
    _Float16* O; int ldc; float qscale;
    __device__ __forceinline__ void operator()(const f32x4 (&acc)[2][2][4][2], const Unit& u, int wr, int wc, int fr, int fq) const {
        const int row0 = u.pm * BM + wr * 64 + fr, col0 = u.pn * BM + wc * 32 + 8 * fq;
        const float s = (u.pn < 4 || (u.pn >= 16 && u.pn < 20)) ? qscale : 1.0f;
#pragma unroll
        for (int ai = 0; ai < 2; ++ai)
#pragma unroll
            for (int m = 0; m < 4; ++m) { _Float16* rowp = O + (size_t)(row0 + ai * HALF + m * 16) * ldc + col0;
#pragma unroll
                for (int bj = 0; bj < 2; ++bj) { const f32x4 v0 = acc[ai][bj][m][0] * s, v1 = acc[ai][bj][m][1] * s;
                    bf16x8 w; w[0] = (_Float16)v0[0]; w[1] = (_Float16)v0[1]; w[2] = (_Float16)v0[2]; w[3] = (_Float16)v0[3]; w[4] = (_Float16)v1[0]; w[5] = (_Float16)v1[1]; w[6] = (_Float16)v1[2]; w[7] = (_Float16)v1[3];
                    *(bf16x8*)(rowp + bj * HALF) = w; } }
    }
};
struct EpiResF32 {
    static constexpr bool PERM = false, AFTER_DRAIN = false;
    const float* resid; float* C; int ldc; float* ssq;
    __device__ __forceinline__ void operator()(const f32x4 (&acc)[2][2][4][2], const Unit& u, int wr, int wc, int fr, int fq) const {
        const int row0 = u.pm * BM + wr * 64 + fr, col0 = u.pn * BM + wc * 32 + 4 * fq;
#pragma unroll
        for (int ai = 0; ai < 2; ++ai)
#pragma unroll
            for (int m = 0; m < 4; ++m) { const int row = row0 + ai * HALF + m * 16; const size_t off = (size_t)row * ldc + col0; float q = 0.f;
#pragma unroll
                for (int bj = 0; bj < 2; ++bj)
#pragma unroll
                    for (int n = 0; n < 2; ++n) { const f32x4 h = *(const f32x4*)(resid + off + bj * HALF + n * 16) + acc[ai][bj][m][n]; *(f32x4*)(C + off + bj * HALF + n * 16) = h;
                        q += (h[0] * h[0] + h[1] * h[1]) + (h[2] * h[2] + h[3] * h[3]); }
                q += __shfl_xor(q, 16); q += __shfl_xor(q, 32);
                if (fq == 0) ssq[(size_t)row * 32 + 4 * u.pn + wc] = q; }
    }
};
template <class Epi, class Sched, bool ALIGN_EPI = false, bool SP2 = false>
__device__ __forceinline__ void gemm_phase(PG8_LAS unsigned char* lds, const Gemm g, const Sched& S, const Epi& E) {
    const int tid = threadIdx.x, wid = __builtin_amdgcn_readfirstlane(tid >> 6), lane = tid & 63, wr = wid >> 2, wc = wid & 3, fr = lane & 15, fq = lane >> 4;
    const int K = g.K, nt = K / BK;
    unsigned voffA[2], voffB[2];
#pragma unroll
    for (int i = 0; i < 2; ++i) { int R, C; stage_rc(tid * 16 + i * 8192, R, C); const int Rb = Epi::PERM ? ((R & ~31) + perm32(R & 31)) : R;
        voffA[i] = (unsigned)(R * K + C) * 2u; voffB[i] = (unsigned)(Rb * K + C) * 2u; }
    const size_t kstep = (size_t)(BK * 2);
    const size_t hstep = (size_t)HALF * K * 2;
    const size_t tstep = 2 * hstep;
    const unsigned ldsw = (unsigned)wid * 1024u;
    const int aoff = lds_byte(wr * 64 + fr, fq * 8), boff = lds_byte(wc * 32 + fr, fq * 8);
#define PG8_SA(b, h) (((b) * 2 + (h)) * HTB)
#define PG8_SB(b, h) ((4 + (b) * 2 + (h)) * HTB)
#define PG8_STAGE(bufoff, gbase, voff) do { _Pragma("unroll") for (int _i = 0; _i < 2; ++_i) \
        __builtin_amdgcn_global_load_lds((const unsigned*)((const char*)(gbase) + (voff)[_i]), (PG8_LAS unsigned*)(lds + (bufoff) + ldsw + _i * 8192), 16, 0, 0); } while (0)
#define PG8_LDA(dst, b, h) do { _Pragma("unroll") for (int m = 0; m < 4; ++m) _Pragma("unroll") for (int k = 0; k < 2; ++k) dst[m][k] = *(const PG8_LAS bf16x8*)(lds + PG8_SA(b, h) + aoff + m * 2048 + k * 1024); } while (0)
#define PG8_LDB(dst, b, h) do { _Pragma("unroll") for (int n = 0; n < 2; ++n) _Pragma("unroll") for (int k = 0; k < 2; ++k) dst[n][k] = *(const PG8_LAS bf16x8*)(lds + PG8_SB(b, h) + boff + n * 2048 + k * 1024); } while (0)
#define PG8_MMA(ai, bj, At, Bt) do { __builtin_amdgcn_s_setprio(1); _Pragma("unroll") for (int m = 0; m < 4; ++m) _Pragma("unroll") for (int n = 0; n < 2; ++n) _Pragma("unroll") for (int k = 0; k < 2; ++k) \
        acc[ai][bj][m][n] = __builtin_amdgcn_mfma_f32_16x16x32_f16(Bt[n][k], At[m][k], acc[ai][bj][m][n], 0, 0, 0); __builtin_amdgcn_s_setprio(0); } while (0)
#define PG8_WAIT_V(n) asm volatile("s_waitcnt vmcnt(" #n ")" ::: "memory")
#define PG8_WAIT_L(n) asm volatile("s_waitcnt lgkmcnt(" #n ")" ::: "memory")
#define PG8_BAR __builtin_amdgcn_s_barrier()
#define PG8_SCHED __builtin_amdgcn_sched_barrier(0)
    Unit cur, nxt; int ui = 0;
    if (!S.next(0, cur)) return;
    f32x4 acc[2][2][4][2];
#pragma unroll
    for (int a = 0; a < 2; ++a)
#pragma unroll
        for (int b = 0; b < 2; ++b)
#pragma unroll
            for (int m = 0; m < 4; ++m)
#pragma unroll
                for (int n = 0; n < 2; ++n) acc[a][b][m][n] = (f32x4){0.f, 0.f, 0.f, 0.f};
    bf16x8 At[4][2], B0[2][2], B1[2][2];
    const char* cA = (const char*)g.A + (size_t)cur.pm * tstep; const char* cB = (const char*)g.Bt + (size_t)cur.pn * tstep;
    S.a_ready(cur);
    if constexpr (SP2) {
        PG8_STAGE(PG8_SB(0, 0), cB, voffB); PG8_STAGE(PG8_SB(0, 1), cB + hstep, voffB); PG8_STAGE(PG8_SA(0, 0), cA, voffA); PG8_STAGE(PG8_SA(0, 1), cA + hstep, voffA);
        if (wr == 1) PG8_BAR;
        PG8_WAIT_V(2); PG8_BAR;
        PG8_STAGE(PG8_SB(1, 0), cB + kstep, voffB); PG8_STAGE(PG8_SA(1, 0), cA + kstep, voffA); PG8_STAGE(PG8_SB(1, 1), cB + hstep + kstep, voffB);
        PG8_WAIT_V(6); PG8_BAR;
    } else {
        PG8_STAGE(PG8_SB(0, 0), cB, voffB); PG8_STAGE(PG8_SA(0, 0), cA, voffA); PG8_STAGE(PG8_SB(0, 1), cB + hstep, voffB); PG8_STAGE(PG8_SA(0, 1), cA + hstep, voffA);
        if (wr == 1) PG8_BAR;
        PG8_WAIT_V(4); PG8_BAR;
        PG8_STAGE(PG8_SB(1, 0), cB + kstep, voffB); PG8_STAGE(PG8_SA(1, 0), cA + kstep, voffA); PG8_STAGE(PG8_SB(1, 1), cB + hstep + kstep, voffB);
        PG8_WAIT_V(6); PG8_BAR;
    }
    for (;;) {
        const bool has_next = S.next(ui + 1, nxt);
        const char* nA = has_next ? (const char*)g.A + (size_t)nxt.pm * tstep : cA; const char* nB = has_next ? (const char*)g.Bt + (size_t)nxt.pn * tstep : cB;
        for (int t = 0; t < nt; t += 2) {
            const bool last = (t == nt - 2);
            const char* a1 = cA + (size_t)(t + 1) * kstep;
            const char* a2 = last ? nA : cA + (size_t)(t + 2) * kstep; const char* b2 = last ? nB : cB + (size_t)(t + 2) * kstep;
            const char* a3 = a2 + kstep; const char* b3 = b2 + kstep;
            if (last && has_next) S.a_ready(nxt);
            if constexpr (SP2) {
            PG8_LDB(B0, 0, 0); PG8_LDB(B1, 0, 1); PG8_SCHED; PG8_LDA(At, 0, 0); PG8_STAGE(PG8_SA(1, 1), a1 + hstep, voffA);
            PG8_WAIT_V(8); PG8_WAIT_L(0); PG8_BAR; PG8_MMA(0, 0, At, B0); PG8_MMA(0, 1, At, B1); PG8_BAR; PG8_SCHED;
            PG8_LDA(At, 0, 1); PG8_STAGE(PG8_SB(0, 0), b2, voffB); PG8_STAGE(PG8_SB(0, 1), b2 + hstep, voffB); PG8_STAGE(PG8_SA(0, 0), a2, voffA);
            PG8_WAIT_V(8); PG8_WAIT_L(0); PG8_BAR; PG8_MMA(1, 0, At, B0); PG8_MMA(1, 1, At, B1); PG8_BAR; PG8_SCHED;
            PG8_LDB(B0, 1, 0); PG8_LDB(B1, 1, 1); PG8_SCHED; PG8_LDA(At, 1, 0); PG8_STAGE(PG8_SA(0, 1), a2 + hstep, voffA);
            PG8_WAIT_V(8); PG8_WAIT_L(0); PG8_BAR; PG8_MMA(0, 0, At, B0); PG8_MMA(0, 1, At, B1); PG8_BAR; PG8_SCHED;
            PG8_LDA(At, 1, 1); PG8_STAGE(PG8_SB(1, 0), b3, voffB); PG8_STAGE(PG8_SB(1, 1), b3 + hstep, voffB); PG8_STAGE(PG8_SA(1, 0), a3, voffA);
            PG8_WAIT_V(8); PG8_WAIT_L(0); PG8_BAR; PG8_MMA(1, 0, At, B0); PG8_MMA(1, 1, At, B1); PG8_BAR; PG8_SCHED;
            } else {
            PG8_LDB(B0, 0, 0); PG8_SCHED; PG8_LDA(At, 0, 0); PG8_STAGE(PG8_SA(1, 1), a1 + hstep, voffA);
            PG8_WAIT_L(8); PG8_BAR; PG8_WAIT_L(0); PG8_MMA(0, 0, At, B0); PG8_BAR; PG8_SCHED;
            PG8_LDB(B1, 0, 1); PG8_STAGE(PG8_SB(0, 0), b2, voffB);
            PG8_BAR; PG8_WAIT_L(0); PG8_MMA(0, 1, At, B1); PG8_BAR;
            PG8_LDA(At, 0, 1); PG8_STAGE(PG8_SA(0, 0), a2, voffA);
            PG8_BAR; PG8_WAIT_L(0); PG8_MMA(1, 0, At, B0); PG8_BAR; PG8_SCHED;
            PG8_STAGE(PG8_SB(0, 1), b2 + hstep, voffB);
            PG8_WAIT_V(6); PG8_BAR; PG8_MMA(1, 1, At, B1); PG8_BAR;
            PG8_LDB(B0, 1, 0); PG8_SCHED; PG8_LDA(At, 1, 0); PG8_STAGE(PG8_SA(0, 1), a2 + hstep, voffA);
            PG8_WAIT_L(8); PG8_BAR; PG8_WAIT_L(0); PG8_MMA(0, 0, At, B0); PG8_BAR; PG8_SCHED;
            PG8_LDB(B1, 1, 1); PG8_STAGE(PG8_SB(1, 0), b3, voffB);
            PG8_BAR; PG8_WAIT_L(0); PG8_MMA(0, 1, At, B1); PG8_BAR;
            PG8_LDA(At, 1, 1); PG8_STAGE(PG8_SA(1, 0), a3, voffA);
            PG8_BAR; PG8_WAIT_L(0); PG8_MMA(1, 0, At, B0); PG8_BAR; PG8_SCHED;
            PG8_STAGE(PG8_SB(1, 1), b3 + hstep, voffB);
            PG8_WAIT_V(6); PG8_BAR; PG8_MMA(1, 1, At, B1); PG8_BAR;
            }
        }
        if constexpr (ALIGN_EPI) { if (wr == 0) PG8_BAR; }
        if constexpr (!Epi::AFTER_DRAIN) { E(acc, cur, wr, wc, fr, fq); S.done(cur); }
        if (!has_next) break;
#pragma unroll
        for (int a = 0; a < 2; ++a)
#pragma unroll
            for (int b = 0; b < 2; ++b)
#pragma unroll
                for (int m = 0; m < 4; ++m)
#pragma unroll
                    for (int n = 0; n < 2; ++n) acc[a][b][m][n] = (f32x4){0.f, 0.f, 0.f, 0.f};
        cur = nxt; cA = nA; cB = nB; ++ui;
        if constexpr (ALIGN_EPI) { if (wr == 1) PG8_BAR; }
    }
    PG8_WAIT_V(0);
    if constexpr (!ALIGN_EPI) { if (wr == 0) PG8_BAR; }
    PG8_BAR;
    if constexpr (Epi::AFTER_DRAIN) { E.fused(acc, cur, wr, wc, fr, fq, lds, wid, lane); S.done(cur); }
#undef PG8_SA
#undef PG8_SB
#undef PG8_STAGE
#undef PG8_LDA
#undef PG8_LDB
#undef PG8_MMA
#undef PG8_WAIT_V
#undef PG8_WAIT_L
#undef PG8_BAR
#undef PG8_SCHED
}
}

#define GAS __attribute__((address_space(1)))
#define LAS __attribute__((address_space(3)))
typedef unsigned v4u __attribute__((ext_vector_type(4)));
#define LDS_WAIT() asm volatile("s_waitcnt lgkmcnt(0)" ::: "memory")
#define VM_WAIT() asm volatile("s_waitcnt vmcnt(0)" ::: "memory")
constexpr int NWAVES = 8, NTHR = NWAVES * 64;
constexpr int RING_OFF = 0, RING_BYTES = 157696;
constexpr int LDSCTL_OFF = RING_BYTES, MISC_OFF = LDSCTL_OFF + 320;
constexpr int LDS_BYTES = 158720;
constexpr int CW_BAR = 4096;
constexpr size_t CTL_ZERO_BYTES = 65536;

#define XB_TMO      128
#define XB_XCNT(j)  (256  + 64 * (j))
#define XB_XSUB(j)  (1280 + 64 * (j))
#define XB_XGEN(j)  (2304 + 64 * (j))
#define XB_TOP      3328
#define XB_TOPGEN   3392
#define XCD_BAR_WORDS 3456
#define XB_SPIN_CAP (1u << 18)

__device__ __forceinline__ unsigned xb_ld(unsigned* p)              { return __hip_atomic_load(p, __ATOMIC_RELAXED, __HIP_MEMORY_SCOPE_AGENT); }
__device__ __forceinline__ unsigned xb_add(unsigned* p, unsigned v) { return __hip_atomic_fetch_add(p, v, __ATOMIC_RELAXED, __HIP_MEMORY_SCOPE_AGENT); }
__device__ __forceinline__ unsigned xb_xcc_id() { return (unsigned)__builtin_amdgcn_s_getreg((3 << 11) | 20) & 0xFu; }
#define XB_SPIN(cond, bar) do { unsigned _sp = 0; while (cond) { __builtin_amdgcn_s_sleep(1); \
    if ((++_sp & 255u) == 0u) { if (xb_ld(&(bar)[XB_TMO])) break; if (_sp > XB_SPIN_CAP) { atomicAdd(&(bar)[XB_TMO], 1u); break; } } } } while (0)

struct XcdBarrier {
    unsigned* bar; unsigned x;
    volatile LAS unsigned* st;
};

__device__ __forceinline__ XcdBarrier xcd_barrier_post(unsigned* bar, volatile LAS unsigned* st) {
    XcdBarrier b; b.bar = bar; b.x = xb_xcc_id(); b.st = st;
    if (threadIdx.x == 0) (void)xb_add(&bar[XB_XCNT(b.x)], 1u);
    return b;
}
__device__ __forceinline__ void xcd_barrier_complete(unsigned* bar, unsigned x, unsigned& nloc, unsigned& nx) {
    const unsigned G = gridDim.x * gridDim.y * gridDim.z;
    unsigned sum, cnt, mine, sp = 0u;
    for (;;) {
        sum = 0u; cnt = 0u; mine = 0u;
#pragma unroll
        for (unsigned j = 0; j < 16; ++j) { const unsigned c = xb_ld(&bar[XB_XCNT(j)]); sum += c; cnt += (c > 0u) ? 1u : 0u; mine = (j == x) ? c : mine; }
        if (sum == G) break;
        __builtin_amdgcn_s_sleep(1);
        if ((++sp & 255u) == 0u) { if (xb_ld(&bar[XB_TMO])) break; if (sp > XB_SPIN_CAP) { atomicAdd(&bar[XB_TMO], 1u); break; } }
    }
    nloc = mine > 0u ? mine : 1u; nx = cnt > 0u ? cnt : 1u;
}

__device__ __forceinline__ void xcd_barrier(const XcdBarrier& b) {
    asm volatile("s_waitcnt vmcnt(0)" ::: "memory");
    __syncthreads();
    if (threadIdx.x == 0) {
        unsigned* bar = b.bar;
        __builtin_amdgcn_s_waitcnt(0);
        unsigned nloc = b.st[0], nx = b.st[1];
        if (nloc == 0u) { xcd_barrier_complete(bar, b.x, nloc, nx); b.st[0] = nloc; b.st[1] = nx; }
        const unsigned old = xb_add(&bar[XB_XSUB(b.x)], 1u);
        const unsigned gen = old / nloc;
        if (old + 1u == (gen + 1u) * nloc) {
            __builtin_amdgcn_fence(__ATOMIC_RELEASE, "agent");
            asm volatile("s_waitcnt vmcnt(0)" ::: "memory");
            const unsigned og = xb_add(&bar[XB_TOP], 1u);
            const unsigned tg = og / nx;
            if (og + 1u == (tg + 1u) * nx) xb_add(&bar[XB_TOPGEN], 1u);
            else XB_SPIN(xb_ld(&bar[XB_TOPGEN]) == tg, bar);
            __builtin_amdgcn_fence(__ATOMIC_ACQUIRE, "agent");
            xb_add(&bar[XB_XGEN(b.x)], 1u);
            asm volatile("s_waitcnt vmcnt(0)" ::: "memory");
        } else {
            XB_SPIN(xb_ld(&bar[XB_XGEN(b.x)]) == gen, bar);
            __builtin_amdgcn_fence(__ATOMIC_ACQUIRE, "agent");
            asm volatile("s_waitcnt vmcnt(0)" ::: "memory");
        }
    }
    __syncthreads();
}

static_assert((CW_BAR + XCD_BAR_WORDS) * 4 <= (int)CTL_ZERO_BYTES, "barrier words inside the memset region");

__device__ __forceinline__ unsigned pk2h(float lo, float hi) { typedef _Float16 h2 __attribute__((ext_vector_type(2))); h2 v; v[0] = (_Float16)lo; v[1] = (_Float16)hi; return __builtin_bit_cast(unsigned, v); }

__device__ __forceinline__ void p0_transpose_item(const float* W, int K, int ldw, bool remap, h16* WT, LAS float* scr, int item, int nblk, int lane) {
    const int kb = item / nblk, nb = item % nblk, k0 = 64 * kb, n0 = 32 * nb;
    const int n = n0 + (lane & 31), sc = remap ? src_col(n) : n;
#pragma unroll 8
    for (int i = 0; i < 32; ++i) { const int kk = 2 * i + (lane >> 5); scr[kk * 33 + (lane & 31)] = sc >= 0 ? W[(size_t)(k0 + kk) * ldw + sc] : 0.f; }
    LDS_WAIT(); asm volatile("" ::: "memory");
    const int c = lane & 7;
#pragma unroll
    for (int j = 0; j < 4; ++j) { const int nn = (lane >> 3) + 8 * j; const LAS float* s = scr + (8 * c) * 33 + nn;
        v4u o; o.x = pk2h(s[0 * 33], s[1 * 33]); o.y = pk2h(s[2 * 33], s[3 * 33]); o.z = pk2h(s[4 * 33], s[5 * 33]); o.w = pk2h(s[6 * 33], s[7 * 33]);
        *(GAS v4u*)(WT + (size_t)(n0 + nn) * K + k0 + 8 * c) = o; }
    LDS_WAIT(); asm volatile("" ::: "memory");
}
typedef float f32x4v __attribute__((ext_vector_type(4)));
typedef float float4v __attribute__((ext_vector_type(4)));
typedef unsigned u32x2v __attribute__((ext_vector_type(2)));
__device__ __forceinline__ void p0_rms_row(const float* xrow, const float* g, h16* orow, int lane) {
    const f32x4v* xr = (const f32x4v*)xrow + lane; const f32x4v* gr = (const f32x4v*)g + lane;
    f32x4v v[8]; float s = 0.f;
#pragma unroll
    for (int j = 0; j < 8; ++j) { v[j] = xr[64 * j]; s += (v[j][0] * v[j][0] + v[j][1] * v[j][1]) + (v[j][2] * v[j][2] + v[j][3] * v[j][3]); }
    const float r = rsqrtf(wave_sum(s) * (1.f / D) + RMS_EPS);
    u32x2v* o8 = (u32x2v*)orow + lane;
#pragma unroll
    for (int j = 0; j < 8; ++j) { const f32x4v gg = gr[64 * j]; u32x2v w; w[0] = pk2h(v[j][0] * r * gg[0], v[j][1] * r * gg[1]); w[1] = pk2h(v[j][2] * r * gg[2], v[j][3] * r * gg[3]); o8[64 * j] = w; }
}


typedef _Float16 h16x2 __attribute__((ext_vector_type(2)));
typedef _Float16 h16x4 __attribute__((ext_vector_type(4)));
typedef _Float16 h16x8 __attribute__((ext_vector_type(8)));
typedef short s16x4 __attribute__((ext_vector_type(4)));
typedef float f32x16 __attribute__((ext_vector_type(16)));
constexpr int KPITCH = 272, VPITCH = 320;
constexpr int AT_V = 64 * KPITCH, AT_BUF = AT_V + 64 * VPITCH;
__device__ __forceinline__ h16x4 tr_read(LAS unsigned char* p) { return __builtin_bit_cast(h16x4, __builtin_amdgcn_ds_read_tr16_b64_v4i16((LAS s16x4*)p)); }
__device__ __forceinline__ int crow(int i, int h) { return (i & 3) + 8 * (i >> 2) + 4 * h; }
__device__ __forceinline__ void tile_gload(const h16* gK, const h16* gV, unsigned pitch, v4u (&kr)[2], v4u (&vr)[2], int tid) {
    asm volatile("" : "+v"(tid));
#pragma unroll
    for (int i = 0; i < 2; ++i) { const unsigned cidx = tid + 512 * i, boff = ((cidx >> 4) * pitch + (cidx & 15) * 8) * 2u;
        kr[i] = *(const v4u*)((const char*)gK + boff); vr[i] = *(const v4u*)((const char*)gV + boff); }
}
__device__ __forceinline__ void tile_lstore(LAS unsigned char* buf, const v4u (&kr)[2], const v4u (&vr)[2], int tid) {
    asm volatile("" : "+v"(tid));
#pragma unroll
    for (int i = 0; i < 2; ++i) { const int cidx = tid + 512 * i, row = cidx >> 4, ch = cidx & 15; *(LAS v4u*)(buf + row * KPITCH + ch * 16) = kr[i]; *(LAS v4u*)(buf + AT_V + row * VPITCH + ch * 16) = vr[i]; }
}
__device__ __forceinline__ f32x16 qk_block(LAS unsigned char* KT, int kb, const h16x8 (&qf)[8], int lane) {
    f32x16 sacc;
#pragma unroll
    for (int i = 0; i < 16; ++i) sacc[i] = 0.f;
    LAS unsigned char* base = KT + (lane & 31) * KPITCH + (lane >> 5) * 16;
#pragma unroll
    for (int s = 0; s < 8; ++s) { const h16x8 kf = *(const LAS h16x8*)(base + kb * 32 * KPITCH + 32 * s); sacc = __builtin_amdgcn_mfma_f32_32x32x16_f16(kf, qf[s], sacc, 0, 0, 0); }
    return sacc;
}
__device__ __forceinline__ void pv_block(LAS unsigned char* VT, int kb, const h16x8 (&pf)[2], f32x16 (&oacc)[4], int lane) {
    const int h = lane >> 5, blk = (lane >> 4) & 1, q = (lane & 15) >> 2, p = lane & 3;
    LAS unsigned char* base = VT + (4 * h + q) * VPITCH + 32 * blk + 8 * p;
#pragma unroll
    for (int c = 0; c < 4; ++c)
#pragma unroll
        for (int s = 0; s < 2; ++s) {
            const h16x4 lo = tr_read(base + (kb * 32 + 16 * s) * VPITCH + 64 * c), hi = tr_read(base + (kb * 32 + 16 * s + 8) * VPITCH + 64 * c);
            const h16x8 vf = __builtin_shufflevector(lo, hi, 0, 1, 2, 3, 4, 5, 6, 7);
            oacc[c] = __builtin_amdgcn_mfma_f32_32x32x16_f16(vf, pf[s], oacc[c], 0, 0, 0);
            if (c == 1 && s == 1) asm volatile("" ::: "memory");
        }
}
__device__ __forceinline__ float lane_partner(float x) {
    const auto r = __builtin_amdgcn_permlane32_swap(__builtin_bit_cast(unsigned, x), __builtin_bit_cast(unsigned, x), false, false);
    return __builtin_bit_cast(float, (threadIdx.x & 32) ? r[0] : r[1]);
}
template <bool DIAG>
__device__ __forceinline__ void sb_weights(const f32x16& sacc, h16x8 (&pf)[2], float& C, int lane, int pos0, int t) {
    const int h = lane >> 5;
    float E[16], T[4], m1[4], m2[4], f0[4];
#pragma unroll
    for (int i = 0; i < 16; ++i) { float e = __builtin_amdgcn_exp2f(fminf(sacc[i], 24.f)); if (DIAG) e = (pos0 + crow(i, h) < t) ? e : 0.f; E[i] = e; }
#pragma unroll
    for (int g = 0; g < 4; ++g) { f0[g] = 1.f + E[4 * g]; m1[g] = f0[g] * (1.f + E[4 * g + 1]); m2[g] = m1[g] * (1.f + E[4 * g + 2]); T[g] = m2[g] * (1.f + E[4 * g + 3]); }
    float U[4], TPs[4];
#pragma unroll
    for (int g = 0; g < 4; ++g) { const float tp = lane_partner(T[g]); U[g] = T[g] * tp; TPs[g] = h ? 1.f : tp; }
    float V[4]; V[3] = C; V[2] = V[3] * U[3]; V[1] = V[2] * U[2]; V[0] = V[1] * U[1]; C = V[0] * U[0];
    float a[16];
#pragma unroll
    for (int g = 0; g < 4; ++g) { const float r = __builtin_amdgcn_rcpf(T[g] * (V[g] * TPs[g]));
        a[4 * g] = E[4 * g] * r; a[4 * g + 1] = E[4 * g + 1] * (r * f0[g]); a[4 * g + 2] = E[4 * g + 2] * (r * m1[g]); a[4 * g + 3] = E[4 * g + 3] * (r * m2[g]); }
#pragma unroll
    for (int s = 0; s < 2; ++s)
#pragma unroll
        for (int j = 0; j < 8; ++j) pf[s][j] = (_Float16)a[8 * s + j];
}
__device__ __forceinline__ void sb_attn_unit(LAS unsigned char* lds, const h16* PROJ, const float* gsb, h16* OG, float* SSQ16, int b, int head, int qt, int tid, int lane, int wave) {
    const int h = lane >> 5, n = lane & 31, q0 = 256 * qt + 32 * wave, t = q0 + n;
    const unsigned mrow = (unsigned)b * S + t;
    const unsigned prow = mrow * (unsigned)(LDP * 2);
    h16x8 qf[8];
#pragma unroll
    for (int s = 0; s < 8; ++s) qf[s] = *(const h16x8*)((const char*)PROJ + prow + (C_SBQ + head * HD + 16 * s + 8 * h) * 2);
    f32x16 oacc[4];
#pragma unroll
    for (int c = 0; c < 4; ++c)
#pragma unroll
        for (int i = 0; i < 16; ++i) oacc[c][i] = 0.f;
    float C = 1.f;
    const int jmax = 4 * qt + 3;
    const h16* gK = PROJ + (size_t)b * S * LDP + C_SBK + head * HD; const h16* gV = PROJ + (size_t)b * S * LDP + C_SBV + head * HD;
    v4u kr[2], vr[2];
    __syncthreads();
    tile_gload(gK + (size_t)(64 * jmax) * LDP, gV + (size_t)(64 * jmax) * LDP, (unsigned)LDP, kr, vr, tid);
    tile_lstore(lds, kr, vr, tid);
    __syncthreads();
    for (int j = jmax; j >= 0; --j) {
        LAS unsigned char* buf = lds + ((jmax - j) & 1) * AT_BUF;
        if (j > 0) tile_gload(gK + (size_t)(64 * (j - 1)) * LDP, gV + (size_t)(64 * (j - 1)) * LDP, (unsigned)LDP, kr, vr, tid);
#pragma unroll
        for (int kb = 1; kb >= 0; --kb) {
            const int pos0 = 64 * j + 32 * kb;
            if (pos0 < q0 + 31) {
                const f32x16 sacc = qk_block(buf, kb, qf, lane);
                h16x8 pf[2];
                if (pos0 + 31 >= q0) sb_weights<true>(sacc, pf, C, lane, pos0, t); else sb_weights<false>(sacc, pf, C, lane, pos0, t);
                pv_block(buf + AT_V, kb, pf, oacc, lane);
            }
        }
        if (j > 0) tile_lstore(lds + (((jmax - j) & 1) ^ 1) * AT_BUF, kr, vr, tid);
        __syncthreads();
    }
    float ss = 0.f;
#pragma unroll
    for (int c = 0; c < 4; ++c)
#pragma unroll
        for (int i = 0; i < 16; ++i) ss += oacc[c][i] * oacc[c][i];
    ss += lane_partner(ss);
    if (h == 0) *(float*)((char*)SSQ16 + (mrow * 16u + head) * 4u) = ss;
#pragma unroll
    for (int c = 0; c < 4; ++c)
#pragma unroll
        for (int g = 0; g < 4; ++g) {
            const int d0 = 32 * c + 8 * g + 4 * h;
            const h16x4 z4 = *(const h16x4*)((const char*)PROJ + prow + (C_SBZ + head * HD + d0) * 2); const f32x4v g4 = *(const f32x4v*)(gsb + head * HD + d0);
            h16x4 o4;
#pragma unroll
            for (int e = 0; e < 4; ++e) { const float z = (float)z4[e]; o4[e] = (_Float16)(oacc[c][4 * g + e] * g4[e] * (z / (1.f + __expf(-z)))); }
            *(h16x4*)((char*)OG + mrow * 4096u + (head * HD + d0) * 2) = o4;
        }
}


constexpr float LOG2E = 1.4426950408889634f;
constexpr int NS_BT = 2 * AT_BUF, NS_IMPG = NS_BT + 16384, NS_IMPL = NS_IMPG + 16384, NS_OFIN = NS_IMPG;
static_assert(NS_OFIN + 65536 <= 157696, "NSA LDS map");
constexpr int BT_SHIFT = 96;
template <int CTRL> __device__ __forceinline__ float dpp_f(float x) { return __builtin_bit_cast(float, __builtin_amdgcn_update_dpp(0, __builtin_bit_cast(int, x), CTRL, 0xf, 0xf, true)); }
__device__ __forceinline__ float quad_sum(float x) { x += dpp_f<0xB1>(x); x += dpp_f<0x4E>(x); return x; }
template <int MODE>
__device__ __forceinline__ unsigned nsa_scores(const f32x16& sacc, float (&sv)[16], const LAS float* BTr, float b31, int d0, int h, bool selbit, bool far) {
    unsigned vm = 0u;
    const LAS float* bp = BTr + 4 * (d0 + BT_SHIFT - 4 * h - 27);
#pragma unroll
    for (int i = 0; i < 16; ++i) {
        const int dist = d0 - (MODE == 0 ? 16 : 1) * crow(i, h);
        bool ok = dist >= 0; if (MODE == 2) ok = ok && selbit; if (MODE == 3) ok = ok && dist < 512;
        float bias;
        if (MODE == 0) bias = far ? b31 : BTr[4 * (min(max(dist, 0), 1023 - BT_SHIFT) + BT_SHIFT)];
        else bias = far ? b31 : bp[4 * (27 - (i & 3) - 8 * (i >> 2))];
        sv[i] = ok ? sacc[i] + bias : -1e30f; vm |= ok ? (1u << i) : 0u;
    }
    return vm;
}
__device__ __forceinline__ float max16(const float (&sv)[16]) {
    float a = fmaxf(fmaxf(sv[0], sv[1]), fmaxf(sv[2], sv[3])), b = fmaxf(fmaxf(sv[4], sv[5]), fmaxf(sv[6], sv[7])), c = fmaxf(fmaxf(sv[8], sv[9]), fmaxf(sv[10], sv[11])), d = fmaxf(fmaxf(sv[12], sv[13]), fmaxf(sv[14], sv[15]));
    return fmaxf(fmaxf(a, b), fmaxf(c, d));
}
__device__ __forceinline__ void online_step(const float (&sv)[16], unsigned vm, float& m, float& l, float (&pv)[16], f32x16 (&oacc)[4]) {
    float bm = max16(sv); bm = fmaxf(bm, lane_partner(bm));
    const float mn = fmaxf(m, bm), alpha = __builtin_amdgcn_exp2f(m - mn);
    float ps = 0.f;
#pragma unroll
    for (int i = 0; i < 16; ++i) { pv[i] = ((vm >> i) & 1u) ? __builtin_amdgcn_exp2f(sv[i] - mn) : 0.f; ps += pv[i]; }
    ps += lane_partner(ps);
    l = l * alpha + ps; m = mn;
#pragma unroll
    for (int c = 0; c < 4; ++c)
#pragma unroll
        for (int i = 0; i < 16; ++i) oacc[c][i] *= alpha;
}
__device__ __forceinline__ void pack_p(const float (&pv)[16], float scale, h16x8 (&pf)[2]) {
#pragma unroll
    for (int s = 0; s < 2; ++s)
#pragma unroll
        for (int j = 0; j < 8; ++j) pf[s][j] = (_Float16)(pv[8 * s + j] * scale);
}
#define NSA_LOOP_BEGIN(GK, GV, PITCH, J0, J1) { \
    const h16* _gk = (GK); const h16* _gv = (GV); const int _j0 = (J0), _j1 = (J1); const unsigned _pitch = (PITCH); v4u _kr[2], _vr[2]; \
    __syncthreads(); \
    tile_gload(_gk + (size_t)(64 * _j0) * _pitch, _gv + (size_t)(64 * _j0) * _pitch, _pitch, _kr, _vr, tid); tile_lstore(lds, _kr, _vr, tid); \
    __syncthreads(); \
    for (int j = _j0; j <= _j1; ++j) { LAS unsigned char* buf = lds + ((j - _j0) & 1) * AT_BUF; \
        if (j < _j1) tile_gload(_gk + (size_t)(64 * (j + 1)) * _pitch, _gv + (size_t)(64 * (j + 1)) * _pitch, _pitch, _kr, _vr, tid);
#define NSA_LOOP_END() \
        if (j < _j1) tile_lstore(lds + (((j - _j0) & 1) ^ 1) * AT_BUF, _kr, _vr, tid); \
        __syncthreads(); } }

__device__ __forceinline__ void nsa_unit(LAS unsigned char* lds, const h16* PROJ, const h16* KCC, const h16* VCC, const float* rel_bias, const float* gnsa, h16* OG, float* SSQ16,
                                         int b, int g, int cur, int tid, int lane, int wave) {
    const int h = lane >> 5, n = lane & 31, tl = n >> 2, r = n & 3, hh = 4 * g + r, tw0 = 64 * cur + 8 * wave, t = tw0 + tl;
    const unsigned mrow = (unsigned)b * S + t;
    const unsigned prow = mrow * (unsigned)(LDP * 2);
    LAS float* BT = (LAS float*)(lds + NS_BT); LAS float* IMPG = (LAS float*)(lds + NS_IMPG); LAS float* IMPL = (LAS float*)(lds + NS_IMPL);
    __syncthreads();
    for (int i = tid; i < 4096; i += NTHR) BT[i] = rel_bias[rel_bucket(max((i >> 2) - BT_SHIFT, 0)) * NHEAD + 4 * g + (i & 3)] * LOG2E;
    for (int i = tid; i < 8192; i += NTHR) IMPG[i] = 0.f;
    h16x8 qf[8];
#pragma unroll
    for (int s = 0; s < 8; ++s) qf[s] = *(const h16x8*)((const char*)PROJ + prow + (C_NQ + hh * HD + 16 * s + 8 * h) * 2);
#define NSA_GATE(k) (1.f / (1.f + __expf(-(float)*(const h16*)((const char*)PROJ + prow + (C_GATE + hh * 3 + (k)) * 2))))
    f32x16 oacc[4];
    LAS unsigned char* OFIN = lds + NS_OFIN + wave * 8192 + lane * 16;
#pragma unroll
    for (int c = 0; c < 4; ++c)
#pragma unroll
        for (int i = 0; i < 16; ++i) oacc[c][i] = 0.f;
    __syncthreads();
    const LAS float* BTr = BT + r; const float b31 = BT[4 * 1023 + r];

    const h16* gKC = KCC + (size_t)(b * NG + g) * NCBP * HD; const h16* gVC = VCC + (size_t)(b * NG + g) * NCBP * HD;
    const int jc1 = (4 * cur + 2) >> 6;
    float mc = -1e30f, lc = 0.f;
    NSA_LOOP_BEGIN(gKC, gVC, HD, 0, jc1)
#pragma unroll
        for (int kb = 0; kb < 2; ++kb) {
            const int nb = 64 * j + 32 * kb;
            if (16 * nb + 31 <= tw0 + 7) {
                const f32x16 sacc = qk_block(buf, kb, qf, lane); float sv[16];
                const bool far = (tw0 - 31 - 16 * (nb + 31)) >= 790;
                const unsigned vm = nsa_scores<0>(sacc, sv, BTr, b31, t - 31 - 16 * nb, h, true, far);
                float bm = max16(sv); bm = fmaxf(bm, lane_partner(bm));
                const float mn = fmaxf(mc, bm), alpha = __builtin_amdgcn_exp2f(mc - mn); float ps = 0.f;
#pragma unroll
                for (int i = 0; i < 16; ++i) ps += ((vm >> i) & 1u) ? __builtin_amdgcn_exp2f(sv[i] - mn) : 0.f;
                ps += lane_partner(ps); lc = lc * alpha + ps; mc = mn;
            }
        }
    NSA_LOOP_END()
    const float invlc = lc > 0.f ? 1.f / lc : 0.f, g0 = NSA_GATE(0);
    NSA_LOOP_BEGIN(gKC, gVC, HD, 0, jc1)
#pragma unroll
        for (int kb = 0; kb < 2; ++kb) {
            const int nb = 64 * j + 32 * kb;
            if (16 * nb + 31 <= tw0 + 7) {
                const f32x16 sacc = qk_block(buf, kb, qf, lane); float sv[16], pv[16];
                const bool far = (tw0 - 31 - 16 * (nb + 31)) >= 790;
                const unsigned vm = nsa_scores<0>(sacc, sv, BTr, b31, t - 31 - 16 * nb, h, true, far);
#pragma unroll
                for (int i = 0; i < 16; ++i) pv[i] = ((vm >> i) & 1u) ? __builtin_amdgcn_exp2f(sv[i] - mc) * invlc : 0.f;
#pragma unroll
                for (int gq = 0; gq < 4; ++gq) {
                    const float gs = quad_sum((pv[4 * gq] + pv[4 * gq + 1]) + (pv[4 * gq + 2] + pv[4 * gq + 3])), ls = quad_sum(pv[4 * gq + 3]);
                    const int jsel = (nb >> 2) + 2 * gq + h;
                    if (r == 0) { IMPG[(8 * wave + tl) * 64 + jsel] = gs; if (jsel + 1 < 64) IMPL[(8 * wave + tl) * 64 + jsel + 1] = ls; }
                }
                h16x8 pf[2]; pack_p(pv, g0, pf);
                pv_block(buf + AT_V, kb, pf, oacc, lane);
            }
        }
    NSA_LOOP_END()
    unsigned sel_lo = 0u, sel_hi = 0u;
#pragma unroll 1
    for (int tk = 0; tk < 8; ++tk) {
        const int jb = lane; const float imp = IMPG[(8 * wave + tk) * 64 + jb] + IMPL[(8 * wave + tk) * 64 + jb];
        const bool valid = jb <= cur, forced = (jb == 0) || (jb == cur) || (jb == cur - 1);
        const unsigned key = (valid ? ((forced ? 0x4e6e6b28u   : __builtin_bit_cast(unsigned, imp)) & ~63u) : 0u) | (unsigned)(63 - jb);
        int rank = 0;
#pragma unroll
        for (int i = 0; i < 64; ++i) rank += ((unsigned)__builtin_amdgcn_readlane((int)key, i) > key) ? 1 : 0;
        const u64 mask = __ballot(rank < 16);
        if (tl == tk) { sel_lo = (unsigned)mask; sel_hi = (unsigned)(mask >> 32); }
    }
    __syncthreads();
#pragma unroll
    for (int c = 0; c < 4; ++c)
#pragma unroll
        for (int k = 0; k < 2; ++k) { h16x8 w;
#pragma unroll
            for (int e = 0; e < 8; ++e) w[e] = (_Float16)oacc[c][8 * k + e];
            *(LAS h16x8*)(OFIN + (2 * c + k) * 1024) = w; }
    {
#pragma unroll
        for (int c = 0; c < 4; ++c)
#pragma unroll
            for (int i = 0; i < 16; ++i) oacc[c][i] = 0.f;
        float m = -1e30f, l = 0.f;
        const h16* gK = PROJ + (size_t)b * S * LDP + C_KS + g * HD; const h16* gV = PROJ + (size_t)b * S * LDP + C_VS + g * HD;
        NSA_LOOP_BEGIN(gK, gV, LDP, 0, cur)
            const bool selbit = (((j < 32) ? (sel_lo >> j) : (sel_hi >> (j - 32))) & 1u) != 0u;
            if (__any(selbit)) {
#pragma unroll
                for (int kb = 0; kb < 2; ++kb) {
                    const int pos0 = 64 * j + 32 * kb;
                    if (pos0 <= tw0 + 7) {
                        const f32x16 sacc = qk_block(buf, kb, qf, lane); float sv[16], pv[16];
                        const bool far = (tw0 - (pos0 + 31)) >= 790;
                        const unsigned vm = nsa_scores<2>(sacc, sv, BTr, b31, t - pos0, h, selbit, far);
                        online_step(sv, vm, m, l, pv, oacc);
                        h16x8 pf[2]; pack_p(pv, 1.f, pf);
                        pv_block(buf + AT_V, kb, pf, oacc, lane);
                    }
                }
            }
    NSA_LOOP_END()
        const float cs = NSA_GATE(1) / l;
#pragma unroll
        for (int c = 0; c < 4; ++c)
#pragma unroll
            for (int k = 0; k < 2; ++k) { h16x8 w = *(const LAS h16x8*)(OFIN + (2 * c + k) * 1024);
#pragma unroll
                for (int e = 0; e < 8; ++e) w[e] = (_Float16)((float)w[e] + cs * oacc[c][8 * k + e]);
                *(LAS h16x8*)(OFIN + (2 * c + k) * 1024) = w; }
    }
    {
#pragma unroll
        for (int c = 0; c < 4; ++c)
#pragma unroll
            for (int i = 0; i < 16; ++i) oacc[c][i] = 0.f;
        float m = -1e30f, l = 0.f;
        const h16* gK = PROJ + (size_t)b * S * LDP + C_KW + g * HD; const h16* gV = PROJ + (size_t)b * S * LDP + C_VW + g * HD;
        NSA_LOOP_BEGIN(gK, gV, LDP, max(0, cur - 8), cur)
#pragma unroll
            for (int kb = 0; kb < 2; ++kb) {
                const int pos0 = 64 * j + 32 * kb;
                if (pos0 <= tw0 + 7 && (tw0 - (pos0 + 31)) < 512) {
                    const f32x16 sacc = qk_block(buf, kb, qf, lane); float sv[16], pv[16];
                    const unsigned vm = nsa_scores<3>(sacc, sv, BTr, b31, t - pos0, h, true, false);
                    online_step(sv, vm, m, l, pv, oacc);
                    h16x8 pf[2]; pack_p(pv, 1.f, pf);
                    pv_block(buf + AT_V, kb, pf, oacc, lane);
                }
            }
    NSA_LOOP_END()
        const float cs = NSA_GATE(2) / l;
#pragma unroll
        for (int c = 0; c < 4; ++c)
#pragma unroll
            for (int k = 0; k < 2; ++k) { const h16x8 w = *(const LAS h16x8*)(OFIN + (2 * c + k) * 1024);
#pragma unroll
                for (int e = 0; e < 8; ++e) oacc[c][8 * k + e] = (float)w[e] + cs * oacc[c][8 * k + e]; }
    }
    float ss = 0.f;
#pragma unroll
    for (int c = 0; c < 4; ++c)
#pragma unroll
        for (int i = 0; i < 16; ++i) ss += oacc[c][i] * oacc[c][i];
    ss += lane_partner(ss);
    if (h == 0) *(float*)((char*)SSQ16 + (mrow * 16u + 8 + hh) * 4u) = ss;
#pragma unroll
    for (int c = 0; c < 4; ++c)
#pragma unroll
        for (int gq = 0; gq < 4; ++gq) {
            const int d0 = 32 * c + 8 * gq + 4 * h;
            const h16x4 z4 = *(const h16x4*)((const char*)PROJ + prow + (C_NZ + hh * HD + d0) * 2); const f32x4v g4 = *(const f32x4v*)(gnsa + hh * HD + d0);
            h16x4 o4;
#pragma unroll
            for (int e = 0; e < 4; ++e) { const float z = (float)z4[e]; o4[e] = (_Float16)(oacc[c][4 * gq + e] * g4[e] * (z / (1.f + __expf(-z)))); }
            *(h16x4*)((char*)OG + mrow * 4096u + (1024 + hh * HD + d0) * 2) = o4;
        }
}


__device__ __forceinline__ void compress_item(LAS unsigned char* ldsh, const h16* PROJ, const float* pos, const float* w1, const float* w2, h16* out, int b, int g, int kv, int n, int e  ) {
    LAS float* in = (LAS float*)ldsh; LAS float* hid = in + 32 * 128;
    const int col0 = (kv ? C_VC : C_KC) + g * HD;
    for (int i = e; i < 32 * 128; i += 256) { const int l = i >> 7, d = i & 127; in[i] = (float)PROJ[(size_t)(b * S + 16 * n + l) * LDP + col0 + d] + pos[i]; }
    __syncthreads();
    float acc = 0.f;
    for (int i = 0; i < 32 * 128; ++i) acc += in[i] * w1[(size_t)i * 256 + e];
    const float u = 0.7978845608028654f * (acc + 0.044715f * acc * acc * acc);
    hid[e] = 0.5f * acc * (1.f + tanhf(u));
    __syncthreads();
    if (e < 128) { float o = 0.f; for (int i = 0; i < 256; ++i) o += hid[i] * w2[i * 128 + e]; out[((size_t)(b * NG + g) * NCBP + n) * HD + e] = (h16)o; }
}
struct Args { const float* in[14]; float* out; unsigned char* ws; int ph_lo, ph_hi; };

__global__ void __launch_bounds__(NTHR, 2) fwd(Args args) {
    extern __shared__ __attribute__((aligned(16))) unsigned char lds_raw[];
    LAS unsigned char* lds = (LAS unsigned char*)lds_raw;
    volatile LAS unsigned* MISC = (volatile LAS unsigned*)(lds + MISC_OFF);
    const int tid = threadIdx.x, lane = tid & 63, wave = __builtin_amdgcn_readfirstlane(tid >> 6);
    const int G = gridDim.x; const int bx = blockIdx.x; const int vcu = (G % 8 == 0) ? (bx % 8) * (G / 8) + bx / 8 : bx;
    unsigned char* ws = args.ws;
    unsigned* ctl = (unsigned*)(ws + WS_CTL);
    for (int u = tid; u < (LDS_BYTES - LDSCTL_OFF) / 4; u += NTHR) ((LAS unsigned*)(lds + LDSCTL_OFF))[u] = 0u;
    __syncthreads();
    XcdBarrier bar = xcd_barrier_post(ctl + CW_BAR, MISC + 8);
    const int lo = args.ph_lo, hi = args.ph_hi;
#define IN(k) (lo <= (k) && (k) < hi)
#define BOTH(k) (IN(k) && IN((k) + 1))
    h16* XN = (h16*)(ws + WS_XN); h16* WINT = (h16*)(ws + WS_WINT); h16* WOUTT = (h16*)(ws + WS_WOUTT); h16* PROJ = (h16*)(ws + WS_PROJ);

    if (IN(0)) {
        LAS float* scr = (LAS float*)(lds + RING_OFF + wave * 16384);
        const int gw = vcu * NWAVES + wave, NGW = G * NWAVES;
        constexpr int I_IN = (D / 64) * (LDP / 32), I_OUT = (D / 64) * (D / 32);
        for (int it = gw; it < I_IN + I_OUT; it += NGW) {
            if (it < I_IN) p0_transpose_item(args.in[2], D, NPROJ, true, WINT, scr, it, LDP / 32, lane);
            else p0_transpose_item(args.in[12], D, D, false, WOUTT, scr, it - I_IN, D / 32, lane);
        }
        for (int m = gw; m < M; m += NGW) p0_rms_row(args.in[0] + (size_t)m * D, args.in[1], XN + (size_t)m * D, lane);
        if (BOTH(0)) xcd_barrier(bar);
    }
    if (IN(1)) {
        pg8::Gemm g{(const pg8::bf16_t*)XN, (const pg8::bf16_t*)WINT, M, LDP, D}; pg8::StaticOrder SO; SO.init(M, LDP, G, bx);
        pg8::EpiF16 E{PROJ, LDP, QSCALE};
        pg8::gemm_phase<pg8::EpiF16, pg8::StaticOrder, true, true>(lds + RING_OFF, g, SO, E);
        if (BOTH(1)) xcd_barrier(bar);
    }
    h16* OG = (h16*)(ws + WS_OG); float* SSQ16 = (float*)(ws + WS_SSQ16); h16* KCC = (h16*)(ws + WS_KCC); h16* VCC = (h16*)(ws + WS_VCC); float* SSQ = (float*)(ws + WS_SSQ);
    if (IN(2)) {
        const int half = tid >> 8, e = tid & 255;
        LAS unsigned char* ldsh = lds + RING_OFF + half * 32768;
        constexpr int NIT = NB * NG * 2 * NCBP;
        for (int it0 = 2 * vcu; it0 < NIT; it0 += 2 * G) {
            const int it = it0 + half, n = it & 255, kv = (it >> 8) & 1, g = (it >> 9) & 1, b = it >> 10;
            __syncthreads();
            if (n == NCB) { if (e < 128) (kv ? VCC : KCC)[((size_t)(b * NG + g) * NCBP + n) * HD + e] = (h16)0.f; __syncthreads(); __syncthreads(); }
            else compress_item(ldsh, PROJ, kv ? args.in[6] : args.in[3], kv ? args.in[7] : args.in[4], kv ? args.in[8] : args.in[5], kv ? VCC : KCC, b, g, kv, n, e);
        }
        if (BOTH(2)) xcd_barrier(bar);
    }
    if (IN(3)) {
        for (int idx = vcu; idx < 1024; idx += G) {
            const int r = idx >> 8, v = idx & 255, c = v >> 6, bh = v & 63;
            const int qt = (r == 0) ? 15 - c : (r == 1) ? 8 + c : (r == 2) ? 7 - c : c;
            sb_attn_unit(lds + RING_OFF, PROJ, args.in[10], OG, SSQ16, bh >> 3, bh & 7, qt, tid, lane, wave);
        }
    }
    if (IN(4)) {
        for (int idx = vcu; idx < 1024; idx += G) {
            const int rr = idx >> 8, v = idx & 255, c = v >> 4, bg = v & 15;
            const int cur = (rr == 0) ? 63 - c : (rr == 1) ? 32 + c : (rr == 2) ? 31 - c : c;
            nsa_unit(lds + RING_OFF, PROJ, KCC, VCC, args.in[9], args.in[11], OG, SSQ16, bg >> 1, bg & 1, cur, tid, lane, wave);
        }
        if (BOTH(4)) xcd_barrier(bar);
    }
    if (IN(5)) {
        const int gw = vcu * NWAVES + wave, NGW = G * NWAVES;
        for (int m = gw; m < M; m += NGW) {
            const float4v sq = ((const float4v*)(SSQ16 + (size_t)m * 16))[lane & 3];
            float s4 = (sq[0] + sq[1]) + (sq[2] + sq[3]);
            s4 += __shfl_xor(s4, 1);
            const float r_sb = rsqrtf(__shfl(s4, 0) * (1.f / 1024.f) + RMS_EPS), r_ns = rsqrtf(__shfl(s4, 2) * (1.f / 1024.f) + RMS_EPS);
            const h16x8* src = (const h16x8*)(OG + (size_t)m * 2048); h16x8* dst = (h16x8*)(XN + (size_t)m * D);
#pragma unroll
            for (int k = 0; k < 4; ++k) { const int ci = lane + 64 * k; const float rr = (ci < 128) ? r_sb : r_ns; h16x8 v = src[ci];
#pragma unroll
                for (int e = 0; e < 8; ++e) v[e] = (_Float16)((float)v[e] * rr);
                dst[ci] = v; }
        }
        if (BOTH(5)) xcd_barrier(bar);
    }
    if (IN(6)) {
        pg8::Gemm g{(const pg8::bf16_t*)XN, (const pg8::bf16_t*)WOUTT, M, D, D}; pg8::StaticOrder SO; SO.init(M, D, G, bx);
        pg8::EpiResF32 E{args.in[0], args.out, D, SSQ};
        pg8::gemm_phase<pg8::EpiResF32, pg8::StaticOrder, true, true>(lds + RING_OFF, g, SO, E);
        if (BOTH(6)) xcd_barrier(bar);
    }
    if (IN(7)) {
        const int gw = vcu * NWAVES + wave, NGW = G * NWAVES;
        for (int m = gw; m < M; m += NGW) {
            float s = (lane < 32) ? SSQ[(size_t)m * 32 + lane] : 0.f;
            s = wave_sum(s);
            const float r = rsqrtf(s * (1.f / D) + RMS_EPS);
            float4v* xr = (float4v*)(args.out + (size_t)m * D) + lane; const float4v* gr = (const float4v*)args.in[13] + lane;
#pragma unroll
            for (int j = 0; j < 8; ++j) { const float4v v = xr[64 * j], gg = gr[64 * j]; xr[64 * j] = v * r * gg; }
        }
    }
#undef IN
#undef BOTH
}

extern "C" void kernel_launch(void* const* d_in, const int* in_sizes, int n_in, void* d_out, int out_size, void* d_ws, size_t ws_size, hipStream_t stream) {
    static int grid = 0;
    if (grid == 0) {
        if (n_in != 14 || in_sizes[0] != M * D || out_size != M * D || ws_size < WS_END) { fprintf(stderr, "kernel_launch: unexpected shapes (n_in %d in0 %d out %d ws %zu need %zu)\n", n_in, n_in > 0 ? in_sizes[0] : -1, out_size, ws_size, (size_t)WS_END); grid = -1; return; }
        int dev = 0, cus = 0, per_cu = 0;
        if (hipGetDevice(&dev) != hipSuccess || hipDeviceGetAttribute(&cus, hipDeviceAttributeMultiprocessorCount, dev) != hipSuccess) { grid = -1; return; }
        if (hipFuncSetAttribute((const void*)fwd, hipFuncAttributeMaxDynamicSharedMemorySize, LDS_BYTES) != hipSuccess) { fprintf(stderr, "kernel_launch: hipFuncSetAttribute failed\n"); grid = -1; return; }
        if (hipOccupancyMaxActiveBlocksPerMultiprocessor(&per_cu, (const void*)fwd, NTHR, LDS_BYTES) != hipSuccess || per_cu < 1) { fprintf(stderr, "kernel_launch: occupancy query says %d blocks per CU\n", per_cu); grid = -1; return; }
        (void)hipGetLastError();
        grid = cus;
    }
    if (grid < 0) return;
    const float* x = (const float*)d_in[0];
    const float* kpos = (const float*)d_in[3]; const float* kw1 = (const float*)d_in[4]; const float* kw2 = (const float*)d_in[5];
    const float* vpos = (const float*)d_in[6]; const float* vw1 = (const float*)d_in[7]; const float* vw2 = (const float*)d_in[8];
    const float* rel_bias = (const float*)d_in[9]; const float* norm_sb = (const float*)d_in[10]; const float* norm_nsa = (const float*)d_in[11];
    const float* norm_final = (const float*)d_in[13];
    unsigned char* ws = (unsigned char*)d_ws; float* out = (float*)d_out;
    h16* XN = (h16*)(ws + WS_XN); h16* WOUTT = (h16*)(ws + WS_WOUTT); h16* PROJ = (h16*)(ws + WS_PROJ);
    h16* KCC = (h16*)(ws + WS_KCC); h16* VCC = (h16*)(ws + WS_VCC); u64* SEL = (u64*)(ws + WS_SEL); float* OC = (float*)(ws + WS_OC);
    float* ONSA = out + (size_t)M * 1024;

    (void)hipMemsetAsync(ws + WS_CTL, 0, CTL_ZERO_BYTES, stream);
    Args a{};
    for (int i = 0; i < 14; ++i) a.in[i] = (const float*)d_in[i];
    a.out = out; a.ws = ws; a.ph_lo = 0; a.ph_hi = 8;
    hipLaunchKernelGGL(fwd, dim3(grid), dim3(NTHR), LDS_BYTES, stream, a);
}
```

```cpp
#include <hip/hip_runtime.h>
#include <cstdio>
#include <cstdint>

typedef _Float16 h16;
typedef unsigned long long u64;

constexpr int NB = 8, S = 4096, D = 2048, M = NB * S;
constexpr int HD = 128, NHEAD = 8, NG = 2, NR = 4;
constexpr int NPROJ = 7704, LDP = 7936;
constexpr int C_SBQ = 0, C_SBK = 1024, C_SBV = 2048, C_SBZ = 3072, C_NQ = 4096, C_KC = 5120, C_VC = 5376, C_KS = 5632, C_VS = 5888,
              C_KW = 6144, C_VW = 6400, C_NZ = 6656, C_GATE = 7680;
constexpr int NCB = 255, NCBP = 256;
constexpr float RMS_EPS = 1e-6f;
constexpr float QSCALE = 0.08838834764831845f * 1.4426950408889634f;
constexpr float QMUL = 0.6931471805599453f;

constexpr size_t MiB = 1u << 20;
constexpr size_t WS_CTL = 0;
constexpr size_t WS_XN = 1 * MiB;
constexpr size_t WS_WINT = WS_XN + (size_t)M * D * 2;
constexpr size_t WS_WOUTT = WS_WINT + (size_t)LDP * D * 2;
constexpr size_t WS_PROJ = WS_WOUTT + (size_t)D * D * 2;
constexpr size_t WS_KCC = WS_PROJ + (size_t)M * LDP * 2;
constexpr size_t WS_VCC = WS_KCC + (size_t)NB * NG * NCBP * HD * 2;
constexpr size_t WS_SEL = WS_VCC + (size_t)NB * NG * NCBP * HD * 2;
constexpr size_t WS_OC = WS_SEL + (size_t)M * NG * 8;
constexpr size_t WS_SSQ = WS_OC + (size_t)M * 1024 * 4;
constexpr size_t WS_OG = WS_SSQ + (size_t)M * 32 * 4;
constexpr size_t WS_SSQ16 = WS_OG + (size_t)M * 2048 * 2;
constexpr size_t WS_W1T = WS_SSQ16 + (size_t)M * 16 * 4;
constexpr size_t WS_W2T = WS_W1T + (size_t)2 * 256 * 4096 * 2;
constexpr size_t WS_PB = WS_W2T + (size_t)2 * 128 * 256 * 2;
constexpr size_t WS_END = WS_PB + (size_t)8 * 2 * 256 * 4;

__device__ __forceinline__ int src_col(int c) { return c < 6656 ? c : (c < 7680 ? c + 24 : (c < NPROJ ? c - 1024 : -1)); }

__device__ __forceinline__ int rel_bucket(int dist) {
    if (dist < 16) return dist < 0 ? 0 : dist;
    int b = 16;
    b += dist >= 21; b += dist >= 27; b += dist >= 35; b += dist >= 46; b += dist >= 59; b += dist >= 77; b += dist >= 99; b += dist >= 128;
    b += dist >= 166; b += dist >= 216; b += dist >= 280; b += dist >= 363; b += dist >= 470; b += dist >= 609; b += dist >= 790;
    return b;
}
__device__ __forceinline__ float wave_sum(float v) {
#pragma unroll
    for (int o = 1; o < 64; o <<= 1) v += __shfl_xor(v, o);
    return v;
}
__device__ __forceinline__ float wave_max(float v) {
#pragma unroll
    for (int o = 1; o < 64; o <<= 1) v = fmaxf(v, __shfl_xor(v, o));
    return v;
}

__global__ void __launch_bounds__(256) k_rmsnorm_in(const float* __restrict__ x, const float* __restrict__ g, h16* __restrict__ xn) {
    const int lane = threadIdx.x & 63, w = (blockIdx.x * blockDim.x + threadIdx.x) >> 6, nw = (gridDim.x * blockDim.x) >> 6;
    for (int m = w; m < M; m += nw) {
        const float4* xr = (const float4*)(x + (size_t)m * D);
        float4 v[8]; float s = 0.f;
#pragma unroll
        for (int j = 0; j < 8; ++j) { v[j] = xr[lane + 64 * j]; s += v[j].x * v[j].x + v[j].y * v[j].y + v[j].z * v[j].z + v[j].w * v[j].w; }
        const float r = rsqrtf(wave_sum(s) * (1.f / D) + RMS_EPS);
#pragma unroll
        for (int j = 0; j < 8; ++j) {
            const float4 gg = ((const float4*)g)[lane + 64 * j];
            h16* o = xn + (size_t)m * D + 4 * (lane + 64 * j);
            o[0] = (h16)(v[j].x * r * gg.x); o[1] = (h16)(v[j].y * r * gg.y); o[2] = (h16)(v[j].z * r * gg.z); o[3] = (h16)(v[j].w * r * gg.w);
        }
    }
}
__global__ void __launch_bounds__(256) k_transpose_w(const float* __restrict__ W, h16* __restrict__ WT, int K, int ldw, int N_out, int remap) {
    __shared__ float t[32][33];
    const int k0 = blockIdx.x * 32, n0 = blockIdx.y * 32, tx = threadIdx.x & 31, ty = threadIdx.x >> 5;
    for (int i = ty; i < 32; i += 8) { const int n = n0 + tx; const int sc = remap ? src_col(n) : n; t[i][tx] = (sc >= 0) ? W[(size_t)(k0 + i) * ldw + sc] : 0.f; }
    __syncthreads();
    for (int i = ty; i < 32; i += 8) WT[(size_t)(n0 + i) * K + k0 + tx] = (h16)t[tx][i];
}

template <int MODE>
__global__ void __launch_bounds__(256) k_gemm_naive(const h16* __restrict__ A, const h16* __restrict__ Bt, void* __restrict__ Cv, const float* __restrict__ resid, int K, int ldc) {
    __shared__ float As[32][68], Bs[32][68];
    const int tx = threadIdx.x & 15, ty = threadIdx.x >> 4, m0 = blockIdx.y * 64, n0 = blockIdx.x * 64;
    float acc[4][4] = {};
    for (int k0 = 0; k0 < K; k0 += 32) {
        for (int i = threadIdx.x; i < 64 * 32; i += 256) { const int r = i >> 5, c = i & 31; As[c][r] = (float)A[(size_t)(m0 + r) * K + k0 + c]; Bs[c][r] = (float)Bt[(size_t)(n0 + r) * K + k0 + c]; }
        __syncthreads();
#pragma unroll 8
        for (int kk = 0; kk < 32; ++kk) {
            const float4 a = *(const float4*)&As[kk][ty * 4], b = *(const float4*)&Bs[kk][tx * 4];
            const float av[4] = {a.x, a.y, a.z, a.w}, bv[4] = {b.x, b.y, b.z, b.w};
#pragma unroll
            for (int i = 0; i < 4; ++i)
#pragma unroll
                for (int j = 0; j < 4; ++j) acc[i][j] += av[i] * bv[j];
        }
        __syncthreads();
    }
#pragma unroll
    for (int i = 0; i < 4; ++i)
#pragma unroll
        for (int j = 0; j < 4; ++j) {
            const size_t o = (size_t)(m0 + ty * 4 + i) * ldc + n0 + tx * 4 + j;
            if (MODE == 0) ((h16*)Cv)[o] = (h16)acc[i][j]; else ((float*)Cv)[o] = resid[o] + acc[i][j];
        }
}

__global__ void __launch_bounds__(256) k_compress(const h16* __restrict__ proj, const float* __restrict__ posk, const float* __restrict__ w1k, const float* __restrict__ w2k,
                                                  const float* __restrict__ posv, const float* __restrict__ w1v, const float* __restrict__ w2v, h16* __restrict__ kcc, h16* __restrict__ vcc) {
    __shared__ float in[32 * 128]; __shared__ float hid[256];
    const int n = blockIdx.x, g = blockIdx.y & 1, kv = blockIdx.y >> 1, b = blockIdx.z, e = threadIdx.x;
    const float* pos = kv ? posv : posk; const float* w1 = kv ? w1v : w1k; const float* w2 = kv ? w2v : w2k; h16* out = kv ? vcc : kcc;
    const int col0 = (kv ? C_VC : C_KC) + g * HD;
    if (n == NCB) { if (e < 128) out[((size_t)(b * NG + g) * NCBP + n) * HD + e] = (h16)0.f; return; }
    for (int i = e; i < 32 * 128; i += 256) { const int l = i >> 7, d = i & 127; in[i] = (float)proj[(size_t)(b * S + 16 * n + l) * LDP + col0 + d] + pos[i]; }
    __syncthreads();
    float acc = 0.f;
    for (int i = 0; i < 32 * 128; ++i) acc += in[i] * w1[(size_t)i * 256 + e];
    const float u = 0.7978845608028654f * (acc + 0.044715f * acc * acc * acc);
    hid[e] = 0.5f * acc * (1.f + tanhf(u));
    __syncthreads();
    if (e < 128) { float o = 0.f; for (int i = 0; i < 256; ++i) o += hid[i] * w2[i * 128 + e]; out[((size_t)(b * NG + g) * NCBP + n) * HD + e] = (h16)o; }
}

__global__ void __launch_bounds__(64) k_nsa_cmp(const h16* __restrict__ proj, const h16* __restrict__ kcc, const h16* __restrict__ vcc, const float* __restrict__ rel_bias,
                                                float* __restrict__ oc, u64* __restrict__ sel) {
    __shared__ float q[128]; __shared__ float P[4][256];
    const int t = blockIdx.x, g = blockIdx.y, b = blockIdx.z, lane = threadIdx.x; const size_t m = (size_t)b * S + t;
    const int nvalid = t < 31 ? 0 : min((t - 31) / 16 + 1, NCB);
    const h16* kc = kcc + (size_t)(b * NG + g) * NCBP * HD; const h16* vc = vcc + (size_t)(b * NG + g) * NCBP * HD;
    for (int r = 0; r < 4; ++r) {
        const int hh = g * 4 + r;
        __syncthreads();
        q[lane] = (float)proj[m * LDP + C_NQ + hh * HD + lane]; q[lane + 64] = (float)proj[m * LDP + C_NQ + hh * HD + lane + 64];
        __syncthreads();
        float sc[4]; float mx = -1e30f;
#pragma unroll
        for (int i = 0; i < 4; ++i) { const int n = lane + 64 * i; sc[i] = -1e30f;
            if (n < nvalid) { float s = 0.f; for (int d = 0; d < 128; ++d) s += q[d] * (float)kc[(size_t)n * HD + d];
                sc[i] = s * QMUL + rel_bias[rel_bucket(t - (16 * n + 31)) * NHEAD + hh]; }
            mx = fmaxf(mx, sc[i]); }
        mx = wave_max(mx); float l = 0.f;
#pragma unroll
        for (int i = 0; i < 4; ++i) { const int n = lane + 64 * i; sc[i] = (n < nvalid) ? __expf(sc[i] - mx) : 0.f; l += sc[i]; }
        l = wave_sum(l); const float inv = nvalid > 0 ? 1.f / l : 0.f;
#pragma unroll
        for (int i = 0; i < 4; ++i) P[r][lane + 64 * i] = sc[i] * inv;
        __syncthreads();
        float o0 = 0.f, o1 = 0.f;
        for (int n = 0; n < nvalid; ++n) { const float p = P[r][n]; o0 += p * (float)vc[(size_t)n * HD + lane]; o1 += p * (float)vc[(size_t)n * HD + lane + 64]; }
        oc[m * 1024 + hh * HD + lane] = o0; oc[m * 1024 + hh * HD + lane + 64] = o1;
    }
    __syncthreads();
    const int j = lane; float imp = 0.f;
    for (int r = 0; r < 4; ++r) for (int n = 4 * j - 1; n <= 4 * j + 3; ++n) if (n >= 0 && n < NCB) imp += P[r][n];
    const int cur = t >> 6; const bool valid = j * 64 <= t, forced = (j == 0) || (j == cur) || (j == cur - 1);
    const float score = valid ? (forced ? 1e9f : imp) : -1e9f;
    int rank = 0;
    for (int i = 0; i < 64; ++i) { const float si = __shfl(score, i); rank += (si > score) || (si == score && i < j); }
    const u64 mask = __ballot(rank < 16);
    if (lane == 0) sel[m * NG + g] = mask;
}

__global__ void __launch_bounds__(128) k_nsa_selwin(const h16* __restrict__ proj, const float* __restrict__ rel_bias, const u64* __restrict__ sel, const float* __restrict__ oc, float* __restrict__ onsa) {
    __shared__ h16 Kt[64 * 128]; __shared__ h16 Vt[64 * 128]; __shared__ float bt[1024];
    const int cur = blockIdx.x, hh = blockIdx.y, b = blockIdx.z, g = hh >> 2, tid = threadIdx.x, t = cur * 64 + (tid >> 1), d0 = (tid & 1) * 64; const size_t m = (size_t)b * S + t;
    for (int i = tid; i < 1024; i += 128) bt[i] = rel_bias[rel_bucket(i) * NHEAD + hh];
    __syncthreads();
    float q[64];
#pragma unroll
    for (int d = 0; d < 64; ++d) q[d] = (float)proj[m * LDP + C_NQ + hh * HD + d0 + d] * QMUL;
    const u64 mysel = sel[m * NG + g];
    const float g0 = 1.f / (1.f + __expf(-(float)proj[m * LDP + C_GATE + hh * 3 + 0])), g1 = 1.f / (1.f + __expf(-(float)proj[m * LDP + C_GATE + hh * 3 + 1])), g2 = 1.f / (1.f + __expf(-(float)proj[m * LDP + C_GATE + hh * 3 + 2]));
    for (int br = 0; br < 2; ++br) {
        float o[64];
#pragma unroll
        for (int d = 0; d < 64; ++d) o[d] = 0.f;
        float mx = -1e30f, l = 0.f;
        const int kcol = (br ? C_KW : C_KS) + g * HD, vcol = (br ? C_VW : C_VS) + g * HD;
        const int j0 = br ? max(0, cur - 8) : 0;
        for (int j = j0; j <= cur; ++j) {
            const bool act = br ? true : ((mysel >> j) & 1ull) != 0ull;
            if (!__syncthreads_or(act ? 1 : 0)) continue;
            for (int i = tid; i < 64 * 128 / 8; i += 128) { const int r = i >> 4, c = (i & 15) * 8; const size_t row = (size_t)(b * S + j * 64 + r) * LDP;
                *(uint4*)&Kt[r * 128 + c] = *(const uint4*)&proj[row + kcol + c]; *(uint4*)&Vt[r * 128 + c] = *(const uint4*)&proj[row + vcol + c]; }
            __syncthreads();
            for (int c0 = 0; c0 < 64; c0 += 16) {
                float sc[16]; float cm = -1e30f;
#pragma unroll
                for (int kk = 0; kk < 16; ++kk) { const int pos = j * 64 + c0 + kk, dist = t - pos; const bool ok = act && dist >= 0 && (br == 0 || dist < 512);
                    float s = 0.f;
#pragma unroll
                    for (int d = 0; d < 64; ++d) s += q[d] * (float)Kt[(c0 + kk) * 128 + d0 + d];
                    s += __shfl_xor(s, 1);
                    s += bt[min(max(dist, 0), 1023)];
                    sc[kk] = ok ? s : -1e30f; cm = fmaxf(cm, sc[kk]); }
                if (cm > -1e29f) {
                    const float mn = fmaxf(mx, cm), al = __expf(mx - mn); mx = mn; l *= al;
#pragma unroll
                    for (int d = 0; d < 64; ++d) o[d] *= al;
#pragma unroll
                    for (int kk = 0; kk < 16; ++kk) { const float p = sc[kk] > -1e29f ? __expf(sc[kk] - mn) : 0.f; l += p;
#pragma unroll
                        for (int d = 0; d < 64; ++d) o[d] += p * (float)Vt[(c0 + kk) * 128 + d0 + d]; }
                }
            }
        }
        const float inv = 1.f / l;
        float* dst = onsa + m * 1024 + hh * HD + d0; const float* ocr = oc + m * 1024 + hh * HD + d0;
        if (br == 0) {
#pragma unroll
            for (int d = 0; d < 64; ++d) dst[d] = g0 * ocr[d] + g1 * o[d] * inv;
        } else {
#pragma unroll
            for (int d = 0; d < 64; ++d) dst[d] += g2 * o[d] * inv;
        }
    }
}

__global__ void __launch_bounds__(128) k_sb_naive(const h16* __restrict__ proj, float* __restrict__ osb) {
    __shared__ h16 Kt[64 * 128]; __shared__ h16 Vt[64 * 128];
    const int cur = blockIdx.x, h = blockIdx.y, b = blockIdx.z, tid = threadIdx.x, t = cur * 64 + (tid >> 1), d0 = (tid & 1) * 64; const size_t m = (size_t)b * S + t;
    float q[64], o[64];
#pragma unroll
    for (int d = 0; d < 64; ++d) { q[d] = (float)proj[m * LDP + C_SBQ + h * HD + d0 + d] * QMUL; o[d] = 0.f; }
    float cum = 0.f;
    for (int j = cur; j >= 0; --j) {
        __syncthreads();
        for (int i = tid; i < 64 * 128 / 8; i += 128) { const int r = i >> 4, c = (i & 15) * 8; const size_t row = (size_t)(b * S + j * 64 + r) * LDP;
            *(uint4*)&Kt[r * 128 + c] = *(const uint4*)&proj[row + C_SBK + h * HD + c]; *(uint4*)&Vt[r * 128 + c] = *(const uint4*)&proj[row + C_SBV + h * HD + c]; }
        __syncthreads();
        for (int kk = 63; kk >= 0; --kk) {
            const int pos = j * 64 + kk;
            float z = 0.f;
#pragma unroll
            for (int d = 0; d < 64; ++d) z += q[d] * (float)Kt[kk * 128 + d0 + d];
            z += __shfl_xor(z, 1);
            const float sp = fmaxf(z, 0.f) + log1pf(__expf(-fabsf(z)));
            const float log_rest = -sp, log_beta = z - sp;
            const float a = (pos < t) ? __expf(log_beta + cum) : 0.f;
            if (pos < t) cum += log_rest;
#pragma unroll
            for (int d = 0; d < 64; ++d) o[d] += a * (float)Vt[kk * 128 + d0 + d];
        }
    }
#pragma unroll
    for (int d = 0; d < 64; ++d) osb[m * 1024 + h * HD + d0 + d] = o[d];
}

__global__ void __launch_bounds__(256) k_make_y(const float* __restrict__ osb, const float* __restrict__ onsa, const h16* __restrict__ proj, const float* __restrict__ gsb, const float* __restrict__ gnsa, h16* __restrict__ y) {
    const int lane = threadIdx.x & 63, w = (blockIdx.x * blockDim.x + threadIdx.x) >> 6, nw = (gridDim.x * blockDim.x) >> 6;
    for (int i = w; i < 2 * M; i += nw) {
        const int m = i >> 1, part = i & 1;
        const float* src = (part ? onsa : osb) + (size_t)m * 1024; const float* gg = part ? gnsa : gsb; const h16* zz = proj + (size_t)m * LDP + (part ? C_NZ : C_SBZ);
        float v[16]; float s = 0.f;
#pragma unroll
        for (int j = 0; j < 16; ++j) { v[j] = src[lane + 64 * j]; s += v[j] * v[j]; }
        const float r = rsqrtf(wave_sum(s) * (1.f / 1024.f) + RMS_EPS);
#pragma unroll
        for (int j = 0; j < 16; ++j) { const int c = lane + 64 * j; const float z = (float)zz[c]; y[(size_t)m * D + part * 1024 + c] = (h16)(v[j] * r * gg[c] * (z / (1.f + __expf(-z)))); }
    }
}
__global__ void __launch_bounds__(256) k_make_y2(const h16* __restrict__ og, const float* __restrict__ ssq16, const float* __restrict__ onsa, const h16* __restrict__ proj, const float* __restrict__ gnsa, h16* __restrict__ y) {
    const int lane = threadIdx.x & 63, w = (blockIdx.x * blockDim.x + threadIdx.x) >> 6, nw = (gridDim.x * blockDim.x) >> 6;
    for (int i = w; i < 2 * M; i += nw) {
        const int m = i >> 1, part = i & 1;
        if (part == 0) {
            float s = 0.f;
            for (int k = 0; k < 8; ++k) s += ssq16[(size_t)m * 16 + k];
            const float r = rsqrtf(s * (1.f / 1024.f) + RMS_EPS);
            for (int j = 0; j < 16; ++j) { const int c = lane + 64 * j; y[(size_t)m * D + c] = (h16)((float)og[(size_t)m * 2048 + c] * r); }
        } else {
            const float* src = onsa + (size_t)m * 1024; const h16* zz = proj + (size_t)m * LDP + C_NZ;
            float v[16]; float s = 0.f;
#pragma unroll
            for (int j = 0; j < 16; ++j) { v[j] = src[lane + 64 * j]; s += v[j] * v[j]; }
            const float r = rsqrtf(wave_sum(s) * (1.f / 1024.f) + RMS_EPS);
#pragma unroll
            for (int j = 0; j < 16; ++j) { const int c = lane + 64 * j; const float z = (float)zz[c]; y[(size_t)m * D + 1024 + c] = (h16)(v[j] * r * gnsa[c] * (z / (1.f + __expf(-z)))); }
        }
    }
}
__global__ void __launch_bounds__(256) k_make_y3(const h16* __restrict__ og, const float* __restrict__ ssq16, h16* __restrict__ y) {
    const int lane = threadIdx.x & 63, w = (blockIdx.x * blockDim.x + threadIdx.x) >> 6, nw = (gridDim.x * blockDim.x) >> 6;
    for (int i = w; i < 2 * M; i += nw) {
        const int m = i >> 1, part = i & 1;
        float s = 0.f;
        for (int k = 0; k < 8; ++k) s += ssq16[(size_t)m * 16 + 8 * part + k];
        const float r = rsqrtf(s * (1.f / 1024.f) + RMS_EPS);
        for (int j = 0; j < 16; ++j) { const int c = part * 1024 + lane + 64 * j; y[(size_t)m * D + c] = (h16)((float)og[(size_t)m * 2048 + c] * r); }
    }
}
__global__ void __launch_bounds__(256) k_final_norm(float* __restrict__ out, const float* __restrict__ g) {
    const int lane = threadIdx.x & 63, w = (blockIdx.x * blockDim.x + threadIdx.x) >> 6, nw = (gridDim.x * blockDim.x) >> 6;
    for (int m = w; m < M; m += nw) {
        float4* xr = (float4*)(out + (size_t)m * D);
        float4 v[8]; float s = 0.f;
#pragma unroll
        for (int j = 0; j < 8; ++j) { v[j] = xr[lane + 64 * j]; s += v[j].x * v[j].x + v[j].y * v[j].y + v[j].z * v[j].z + v[j].w * v[j].w; }
        const float r = rsqrtf(wave_sum(s) * (1.f / D) + RMS_EPS);
#pragma unroll
        for (int j = 0; j < 8; ++j) { const float4 gg = ((const float4*)g)[lane + 64 * j]; xr[lane + 64 * j] = make_float4(v[j].x * r * gg.x, v[j].y * r * gg.y, v[j].z * r * gg.z, v[j].w * r * gg.w); }
    }
}

namespace pg8 {
#define PG8_LAS __attribute__((address_space(3)))
typedef unsigned short bf16_t;
typedef _Float16 bf16x8 __attribute__((ext_vector_type(8)));
typedef float f32x4 __attribute__((ext_vector_type(4)));
typedef unsigned u32x4 __attribute__((ext_vector_type(4)));
constexpr int BM = 256, BK = 64, HALF = 128, HTB = HALF * BK * 2  , STAGE_BYTES = 8 * HTB, NXCD = 8, WGM = 8;

__host__ __device__ __forceinline__ int lds_byte(int r, int c) { const int st = (r >> 4) * 2 + (c >> 5), rr = r & 15, cc = c & 31, ob = rr * 64 + cc * 2; return st * 1024 + (ob ^ (((ob >> 9) & 1) << 5)); }
__host__ __device__ __forceinline__ void stage_rc(int b, int& R, int& C) { const int st = b / 1024, sb = b % 1024, swz = sb ^ (((sb >> 9) & 1) << 5); R = (st >> 1) * 16 + swz / 64; C = (st & 1) * 32 + (swz % 64) / 2; }
__host__ __device__ __forceinline__ int perm32(int rho) { const int n = rho >> 4, i = rho & 15; return 8 * (i >> 2) + 4 * n + (i & 3); }

struct Unit { int pm, pn; };
struct Gemm { const bf16_t* A; const bf16_t* Bt; int M, N, K; };

struct StaticOrder {
    int nM, nN, nwg, G, c;
    __host__ __device__ void init(int M, int N, int G_, int c_) { nM = M / BM; nN = N / BM; nwg = nM * nN; G = G_; c = c_; }
    __host__ __device__ bool next(int i, Unit& u) const {
        const long L = (long)i * G + c; if (L >= nwg) return false;
        int wgid = (int)L; { const int q = nwg / NXCD, r = nwg % NXCD, xcd = wgid % NXCD, off = wgid / NXCD; wgid = (xcd < r ? xcd * (q + 1) : r * (q + 1) + (xcd - r) * q) + off; }
        const int nig = WGM * nN, gid = wgid / nig, fm = gid * WGM, gsz = (nM - fm) < WGM ? (nM - fm) : WGM;
        u.pm = fm + ((wgid % nig) % gsz); u.pn = (wgid % nig) / gsz; return true;
    }
    __device__ __forceinline__ void a_ready(const Unit&) const {}
    __device__ __forceinline__ void done(const Unit&) const {}
};

struct EpiF16 {
    static constexpr bool PERM = true, AFTER_DRAIN = false;
    _Float16* O; int ldc; float qscale;
    __device__ __forceinline__ void operator()(const f32x4 (&acc)[2][2][4][2], const Unit& u, int wr, int wc, int fr, int fq) const {
        const int row0 = u.pm * BM + wr * 64 + fr, col0 = u.pn * BM + wc * 32 + 8 * fq;
        const float s = (u.pn < 4 || (u.pn >= 16 && u.pn < 20)) ? qscale : 1.0f;
#pragma unroll
        for (int ai = 0; ai < 2; ++ai)
#pragma unroll
            for (int m = 0; m < 4; ++m) { _Float16* rowp = O + (size_t)(row0 + ai * HALF + m * 16) * ldc + col0;
#pragma unroll
                for (int bj = 0; bj < 2; ++bj) { const f32x4 v0 = acc[ai][bj][m][0] * s, v1 = acc[ai][bj][m][1] * s;
                    bf16x8 w; w[0] = (_Float16)v0[0]; w[1] = (_Float16)v0[1]; w[2] = (_Float16)v0[2]; w[3] = (_Float16)v0[3]; w[4] = (_Float16)v1[0]; w[5] = (_Float16)v1[1]; w[6] = (_Float16)v1[2]; w[7] = (_Float16)v1[3];
                    *(bf16x8*)(rowp + bj * HALF) = w; } }
    }
};
struct EpiResF32 {
    static constexpr bool PERM = false, AFTER_DRAIN = false;
    const float* resid; float* C; int ldc; float* ssq;
    __device__ __forceinline__ void operator()(const f32x4 (&acc)[2][2][4][2], const Unit& u, int wr, int wc, int fr, int fq) const {
        const int row0 = u.pm * BM + wr * 64 + fr, col0 = u.pn * BM + wc * 32 + 4 * fq;
#pragma unroll
        for (int ai = 0; ai < 2; ++ai)
#pragma unroll
            for (int m = 0; m < 4; ++m) { const int row = row0 + ai * HALF + m * 16; const size_t off = (size_t)row * ldc + col0; float q = 0.f;
#pragma unroll
                for (int bj = 0; bj < 2; ++bj)
#pragma unroll
                    for (int n = 0; n < 2; ++n) { const f32x4 h = *(const f32x4*)(resid + off + bj * HALF + n * 16) + acc[ai][bj][m][n]; *(f32x4*)(C + off + bj * HALF + n * 16) = h;
                        q += (h[0] * h[0] + h[1] * h[1]) + (h[2] * h[2] + h[3] * h[3]); }
                q += __shfl_xor(q, 16); q += __shfl_xor(q, 32);
                if (fq == 0) ssq[(size_t)row * 32 + 4 * u.pn + wc] = q; }
    }
};
template <class Epi, class Sched, bool ALIGN_EPI = false, bool SP2 = false>
__device__ __forceinline__ void gemm_phase(PG8_LAS unsigned char* lds, const Gemm g, const Sched& S, const Epi& E) {
    const int tid = threadIdx.x, wid = __builtin_amdgcn_readfirstlane(tid >> 6), lane = tid & 63, wr = wid >> 2, wc = wid & 3, fr = lane & 15, fq = lane >> 4;
    const int K = g.K, nt = K / BK;
    unsigned voffA[2], voffB[2];
#pragma unroll
    for (int i = 0; i < 2; ++i) { int R, C; stage_rc(tid * 16 + i * 8192, R, C); const int Rb = Epi::PERM ? ((R & ~31) + perm32(R & 31)) : R;
        voffA[i] = (unsigned)(R * K + C) * 2u; voffB[i] = (unsigned)(Rb * K + C) * 2u; }
    const size_t kstep = (size_t)(BK * 2);
    const size_t hstep = (size_t)HALF * K * 2;
    const size_t tstep = 2 * hstep;
    const unsigned ldsw = (unsigned)wid * 1024u;
    const int aoff = lds_byte(wr * 64 + fr, fq * 8), boff = lds_byte(wc * 32 + fr, fq * 8);
#define PG8_SA(b, h) (((b) * 2 + (h)) * HTB)
#define PG8_SB(b, h) ((4 + (b) * 2 + (h)) * HTB)
#define PG8_STAGE(bufoff, gbase, voff) do { _Pragma("unroll") for (int _i = 0; _i < 2; ++_i) \
        __builtin_amdgcn_global_load_lds((const unsigned*)((const char*)(gbase) + (voff)[_i]), (PG8_LAS unsigned*)(lds + (bufoff) + ldsw + _i * 8192), 16, 0, 0); } while (0)
#define PG8_LDA(dst, b, h) do { _Pragma("unroll") for (int m = 0; m < 4; ++m) _Pragma("unroll") for (int k = 0; k < 2; ++k) dst[m][k] = *(const PG8_LAS bf16x8*)(lds + PG8_SA(b, h) + aoff + m * 2048 + k * 1024); } while (0)
#define PG8_LDB(dst, b, h) do { _Pragma("unroll") for (int n = 0; n < 2; ++n) _Pragma("unroll") for (int k = 0; k < 2; ++k) dst[n][k] = *(const PG8_LAS bf16x8*)(lds + PG8_SB(b, h) + boff + n * 2048 + k * 1024); } while (0)
#define PG8_MMA(ai, bj, At, Bt) do { __builtin_amdgcn_s_setprio(1); _Pragma("unroll") for (int m = 0; m < 4; ++m) _Pragma("unroll") for (int n = 0; n < 2; ++n) _Pragma("unroll") for (int k = 0; k < 2; ++k) \
        acc[ai][bj][m][n] = __builtin_amdgcn_mfma_f32_16x16x32_f16(Bt[n][k], At[m][k], acc[ai][bj][m][n], 0, 0, 0); __builtin_amdgcn_s_setprio(0); } while (0)
#define PG8_WAIT_V(n) asm volatile("s_waitcnt vmcnt(" #n ")" ::: "memory")
#define PG8_WAIT_L(n) asm volatile("s_waitcnt lgkmcnt(" #n ")" ::: "memory")
#define PG8_BAR __builtin_amdgcn_s_barrier()
#define PG8_SCHED __builtin_amdgcn_sched_barrier(0)
    Unit cur, nxt; int ui = 0;
    if (!S.next(0, cur)) return;
    f32x4 acc[2][2][4][2];
#pragma unroll
    for (int a = 0; a < 2; ++a)
#pragma unroll
        for (int b = 0; b < 2; ++b)
#pragma unroll
            for (int m = 0; m < 4; ++m)
#pragma unroll
                for (int n = 0; n < 2; ++n) acc[a][b][m][n] = (f32x4){0.f, 0.f, 0.f, 0.f};
    bf16x8 At[4][2], B0[2][2], B1[2][2];
    const char* cA = (const char*)g.A + (size_t)cur.pm * tstep; const char* cB = (const char*)g.Bt + (size_t)cur.pn * tstep;
    S.a_ready(cur);
    if constexpr (SP2) {
        PG8_STAGE(PG8_SB(0, 0), cB, voffB); PG8_STAGE(PG8_SB(0, 1), cB + hstep, voffB); PG8_STAGE(PG8_SA(0, 0), cA, voffA); PG8_STAGE(PG8_SA(0, 1), cA + hstep, voffA);
        if (wr == 1) PG8_BAR;
        PG8_WAIT_V(2); PG8_BAR;
        PG8_STAGE(PG8_SB(1, 0), cB + kstep, voffB); PG8_STAGE(PG8_SA(1, 0), cA + kstep, voffA); PG8_STAGE(PG8_SB(1, 1), cB + hstep + kstep, voffB);
        PG8_WAIT_V(6); PG8_BAR;
    } else {
        PG8_STAGE(PG8_SB(0, 0), cB, voffB); PG8_STAGE(PG8_SA(0, 0), cA, voffA); PG8_STAGE(PG8_SB(0, 1), cB + hstep, voffB); PG8_STAGE(PG8_SA(0, 1), cA + hstep, voffA);
        if (wr == 1) PG8_BAR;
        PG8_WAIT_V(4); PG8_BAR;
        PG8_STAGE(PG8_SB(1, 0), cB + kstep, voffB); PG8_STAGE(PG8_SA(1, 0), cA + kstep, voffA); PG8_STAGE(PG8_SB(1, 1), cB + hstep + kstep, voffB);
        PG8_WAIT_V(6); PG8_BAR;
    }
    for (;;) {
        const bool has_next = S.next(ui + 1, nxt);
        const char* nA = has_next ? (const char*)g.A + (size_t)nxt.pm * tstep : cA; const char* nB = has_next ? (const char*)g.Bt + (size_t)nxt.pn * tstep : cB;
        for (int t = 0; t < nt; t += 2) {
            const bool last = (t == nt - 2);
            const char* a1 = cA + (size_t)(t + 1) * kstep;
            const char* a2 = last ? nA : cA + (size_t)(t + 2) * kstep; const char* b2 = last ? nB : cB + (size_t)(t + 2) * kstep;
            const char* a3 = a2 + kstep; const char* b3 = b2 + kstep;
            if (last && has_next) S.a_ready(nxt);
            if constexpr (SP2) {
            PG8_LDB(B0, 0, 0); PG8_LDB(B1, 0, 1); PG8_SCHED; PG8_LDA(At, 0, 0); PG8_STAGE(PG8_SA(1, 1), a1 + hstep, voffA);
            PG8_WAIT_V(8); PG8_WAIT_L(0); PG8_BAR; PG8_MMA(0, 0, At, B0); PG8_MMA(0, 1, At, B1); PG8_BAR; PG8_SCHED;
            PG8_LDA(At, 0, 1); PG8_STAGE(PG8_SB(0, 0), b2, voffB); PG8_STAGE(PG8_SB(0, 1), b2 + hstep, voffB); PG8_STAGE(PG8_SA(0, 0), a2, voffA);
            PG8_WAIT_V(8); PG8_WAIT_L(0); PG8_BAR; PG8_MMA(1, 0, At, B0); PG8_MMA(1, 1, At, B1); PG8_BAR; PG8_SCHED;
            PG8_LDB(B0, 1, 0); PG8_LDB(B1, 1, 1); PG8_SCHED; PG8_LDA(At, 1, 0); PG8_STAGE(PG8_SA(0, 1), a2 + hstep, voffA);
            PG8_WAIT_V(8); PG8_WAIT_L(0); PG8_BAR; PG8_MMA(0, 0, At, B0); PG8_MMA(0, 1, At, B1); PG8_BAR; PG8_SCHED;
            PG8_LDA(At, 1, 1); PG8_STAGE(PG8_SB(1, 0), b3, voffB); PG8_STAGE(PG8_SB(1, 1), b3 + hstep, voffB); PG8_STAGE(PG8_SA(1, 0), a3, voffA);
            PG8_WAIT_V(8); PG8_WAIT_L(0); PG8_BAR; PG8_MMA(1, 0, At, B0); PG8_MMA(1, 1, At, B1); PG8_BAR; PG8_SCHED;
            } else {
            PG8_LDB(B0, 0, 0); PG8_SCHED; PG8_LDA(At, 0, 0); PG8_STAGE(PG8_SA(1, 1), a1 + hstep, voffA);
            PG8_WAIT_L(8); PG8_BAR; PG8_WAIT_L(0); PG8_MMA(0, 0, At, B0); PG8_BAR; PG8_SCHED;
            PG8_LDB(B1, 0, 1); PG8_STAGE(PG8_SB(0, 0), b2, voffB);
            PG8_BAR; PG8_WAIT_L(0); PG8_MMA(0, 1, At, B1); PG8_BAR;
            PG8_LDA(At, 0, 1); PG8_STAGE(PG8_SA(0, 0), a2, voffA);
            PG8_BAR; PG8_WAIT_L(0); PG8_MMA(1, 0, At, B0); PG8_BAR; PG8_SCHED;
            PG8_STAGE(PG8_SB(0, 1), b2 + hstep, voffB);
            PG8_WAIT_V(6); PG8_BAR; PG8_MMA(1, 1, At, B1); PG8_BAR;
            PG8_LDB(B0, 1, 0); PG8_SCHED; PG8_LDA(At, 1, 0); PG8_STAGE(PG8_SA(0, 1), a2 + hstep, voffA);
            PG8_WAIT_L(8); PG8_BAR; PG8_WAIT_L(0); PG8_MMA(0, 0, At, B0); PG8_BAR; PG8_SCHED;
            PG8_LDB(B1, 1, 1); PG8_STAGE(PG8_SB(1, 0), b3, voffB);
            PG8_BAR; PG8_WAIT_L(0); PG8_MMA(0, 1, At, B1); PG8_BAR;
            PG8_LDA(At, 1, 1); PG8_STAGE(PG8_SA(1, 0), a3, voffA);
            PG8_BAR; PG8_WAIT_L(0); PG8_MMA(1, 0, At, B0); PG8_BAR; PG8_SCHED;
            PG8_STAGE(PG8_SB(1, 1), b3 + hstep, voffB);
            PG8_WAIT_V(6); PG8_BAR; PG8_MMA(1, 1, At, B1); PG8_BAR;
            }
        }
        if constexpr (ALIGN_EPI) { if (wr == 0) PG8_BAR; }
        if constexpr (!Epi::AFTER_DRAIN) { E(acc, cur, wr, wc, fr, fq); S.done(cur); }
        if (!has_next) break;
#pragma unroll
        for (int a = 0; a < 2; ++a)
#pragma unroll
            for (int b = 0; b < 2; ++b)
#pragma unroll
                for (int m = 0; m < 4; ++m)
#pragma unroll
                    for (int n = 0; n < 2; ++n) acc[a][b][m][n] = (f32x4){0.f, 0.f, 0.f, 0.f};
        cur = nxt; cA = nA; cB = nB; ++ui;
        if constexpr (ALIGN_EPI) { if (wr == 1) PG8_BAR; }
    }
    PG8_WAIT_V(0);
    if constexpr (!ALIGN_EPI) { if (wr == 0) PG8_BAR; }
    PG8_BAR;
    if constexpr (Epi::AFTER_DRAIN) { E.fused(acc, cur, wr, wc, fr, fq, lds, wid, lane); S.done(cur); }
#undef PG8_SA
#undef PG8_SB
#undef PG8_STAGE
#undef PG8_LDA
#undef PG8_LDB
#undef PG8_MMA
#undef PG8_WAIT_V
#undef PG8_WAIT_L
#undef PG8_BAR
#undef PG8_SCHED
}
}

#define GAS __attribute__((address_space(1)))
#define LAS __attribute__((address_space(3)))
typedef unsigned v4u __attribute__((ext_vector_type(4)));
#define LDS_WAIT() asm volatile("s_waitcnt lgkmcnt(0)" ::: "memory")
#define VM_WAIT() asm volatile("s_waitcnt vmcnt(0)" ::: "memory")
constexpr int NWAVES = 8, NTHR = NWAVES * 64;
constexpr int RING_OFF = 0, RING_BYTES = 157696;
constexpr int LDSCTL_OFF = RING_BYTES, MISC_OFF = LDSCTL_OFF + 320;
constexpr int LDS_BYTES = 158720;
constexpr int CW_BAR = 4096;
constexpr size_t CTL_ZERO_BYTES = 65536;

#define XB_TMO      128
#define XB_XCNT(j)  (256  + 64 * (j))
#define XB_XSUB(j)  (1280 + 64 * (j))
#define XB_XGEN(j)  (2304 + 64 * (j))
#define XB_TOP      3328
#define XB_TOPGEN   3392
#define XCD_BAR_WORDS 3456
#define XB_SPIN_CAP (1u << 18)

__device__ __forceinline__ unsigned xb_ld(unsigned* p)              { return __hip_atomic_load(p, __ATOMIC_RELAXED, __HIP_MEMORY_SCOPE_AGENT); }
__device__ __forceinline__ unsigned xb_add(unsigned* p, unsigned v) { return __hip_atomic_fetch_add(p, v, __ATOMIC_RELAXED, __HIP_MEMORY_SCOPE_AGENT); }
__device__ __forceinline__ unsigned xb_xcc_id() { return (unsigned)__builtin_amdgcn_s_getreg((3 << 11) | 20) & 0xFu; }
#define XB_SPIN(cond, bar) do { unsigned _sp = 0; while (cond) { __builtin_amdgcn_s_sleep(1); \
    if ((++_sp & 255u) == 0u) { if (xb_ld(&(bar)[XB_TMO])) break; if (_sp > XB_SPIN_CAP) { atomicAdd(&(bar)[XB_TMO], 1u); break; } } } } while (0)

struct XcdBarrier {
    unsigned* bar; unsigned x;
    volatile LAS unsigned* st;
};

__device__ __forceinline__ XcdBarrier xcd_barrier_post(unsigned* bar, volatile LAS unsigned* st) {
    XcdBarrier b; b.bar = bar; b.x = xb_xcc_id(); b.st = st;
    if (threadIdx.x == 0) (void)xb_add(&bar[XB_XCNT(b.x)], 1u);
    return b;
}
__device__ __forceinline__ void xcd_barrier_complete(unsigned* bar, unsigned x, unsigned& nloc, unsigned& nx) {
    const unsigned G = gridDim.x * gridDim.y * gridDim.z;
    unsigned sum, cnt, mine, sp = 0u;
    for (;;) {
        sum = 0u; cnt = 0u; mine = 0u;
#pragma unroll
        for (unsigned j = 0; j < 16; ++j) { const unsigned c = xb_ld(&bar[XB_XCNT(j)]); sum += c; cnt += (c > 0u) ? 1u : 0u; mine = (j == x) ? c : mine; }
        if (sum == G) break;
        __builtin_amdgcn_s_sleep(1);
        if ((++sp & 255u) == 0u) { if (xb_ld(&bar[XB_TMO])) break; if (sp > XB_SPIN_CAP) { atomicAdd(&bar[XB_TMO], 1u); break; } }
    }
    nloc = mine > 0u ? mine : 1u; nx = cnt > 0u ? cnt : 1u;
}

__device__ __forceinline__ void xcd_barrier(const XcdBarrier& b) {
    asm volatile("s_waitcnt vmcnt(0)" ::: "memory");
    __syncthreads();
    if (threadIdx.x == 0) {
        unsigned* bar = b.bar;
        __builtin_amdgcn_s_waitcnt(0);
        unsigned nloc = b.st[0], nx = b.st[1];
        if (nloc == 0u) { xcd_barrier_complete(bar, b.x, nloc, nx); b.st[0] = nloc; b.st[1] = nx; }
        const unsigned old = xb_add(&bar[XB_XSUB(b.x)], 1u);
        const unsigned gen = old / nloc;
        if (old + 1u == (gen + 1u) * nloc) {
            __builtin_amdgcn_fence(__ATOMIC_RELEASE, "agent");
            asm volatile("s_waitcnt vmcnt(0)" ::: "memory");
            const unsigned og = xb_add(&bar[XB_TOP], 1u);
            const unsigned tg = og / nx;
            if (og + 1u == (tg + 1u) * nx) xb_add(&bar[XB_TOPGEN], 1u);
            else XB_SPIN(xb_ld(&bar[XB_TOPGEN]) == tg, bar);
            __builtin_amdgcn_fence(__ATOMIC_ACQUIRE, "agent");
            xb_add(&bar[XB_XGEN(b.x)], 1u);
            asm volatile("s_waitcnt vmcnt(0)" ::: "memory");
        } else {
            XB_SPIN(xb_ld(&bar[XB_XGEN(b.x)]) == gen, bar);
            __builtin_amdgcn_fence(__ATOMIC_ACQUIRE, "agent");
            asm volatile("s_waitcnt vmcnt(0)" ::: "memory");
        }
    }
    __syncthreads();
}

static_assert((CW_BAR + XCD_BAR_WORDS) * 4 <= (int)CTL_ZERO_BYTES, "barrier words inside the memset region");

__device__ __forceinline__ unsigned pk2h(float lo, float hi) { typedef _Float16 h2 __attribute__((ext_vector_type(2))); h2 v; v[0] = (_Float16)lo; v[1] = (_Float16)hi; return __builtin_bit_cast(unsigned, v); }

__device__ __forceinline__ void p0_transpose_item(const float* W, int K, int ldw, bool remap, h16* WT, LAS float* scr, int item, int nblk, int lane) {
    const int kb = item / nblk, nb = item % nblk, k0 = 64 * kb, n0 = 32 * nb;
    const int n = n0 + (lane & 31), sc = remap ? src_col(n) : n;
#pragma unroll 8
    for (int i = 0; i < 32; ++i) { const int kk = 2 * i + (lane >> 5); scr[kk * 33 + (lane & 31)] = sc >= 0 ? W[(size_t)(k0 + kk) * ldw + sc] : 0.f; }
    LDS_WAIT(); asm volatile("" ::: "memory");
    const int c = lane & 7;
#pragma unroll
    for (int j = 0; j < 4; ++j) { const int nn = (lane >> 3) + 8 * j; const LAS float* s = scr + (8 * c) * 33 + nn;
        v4u o; o.x = pk2h(s[0 * 33], s[1 * 33]); o.y = pk2h(s[2 * 33], s[3 * 33]); o.z = pk2h(s[4 * 33], s[5 * 33]); o.w = pk2h(s[6 * 33], s[7 * 33]);
        *(GAS v4u*)(WT + (size_t)(n0 + nn) * K + k0 + 8 * c) = o; }
    LDS_WAIT(); asm volatile("" ::: "memory");
}
typedef float f32x4v __attribute__((ext_vector_type(4)));
typedef float float4v __attribute__((ext_vector_type(4)));
typedef unsigned u32x2v __attribute__((ext_vector_type(2)));
__device__ __forceinline__ void p0_rms_row(const float* xrow, const float* g, h16* orow, int lane) {
    const f32x4v* xr = (const f32x4v*)xrow + lane; const f32x4v* gr = (const f32x4v*)g + lane;
    f32x4v v[8]; float s = 0.f;
#pragma unroll
    for (int j = 0; j < 8; ++j) { v[j] = xr[64 * j]; s += (v[j][0] * v[j][0] + v[j][1] * v[j][1]) + (v[j][2] * v[j][2] + v[j][3] * v[j][3]); }
    const float r = rsqrtf(wave_sum(s) * (1.f / D) + RMS_EPS);
    u32x2v* o8 = (u32x2v*)orow + lane;
#pragma unroll
    for (int j = 0; j < 8; ++j) { const f32x4v gg = gr[64 * j]; u32x2v w; w[0] = pk2h(v[j][0] * r * gg[0], v[j][1] * r * gg[1]); w[1] = pk2h(v[j][2] * r * gg[2], v[j][3] * r * gg[3]); o8[64 * j] = w; }
}


typedef _Float16 h16x2 __attribute__((ext_vector_type(2)));
typedef _Float16 h16x4 __attribute__((ext_vector_type(4)));
typedef _Float16 h16x8 __attribute__((ext_vector_type(8)));
typedef short s16x4 __attribute__((ext_vector_type(4)));
typedef float f32x16 __attribute__((ext_vector_type(16)));
constexpr int KPITCH = 272, VPITCH = 320;
constexpr int AT_V = 64 * KPITCH, AT_BUF = AT_V + 64 * VPITCH;
__device__ __forceinline__ h16x4 tr_read(LAS unsigned char* p) { return __builtin_bit_cast(h16x4, __builtin_amdgcn_ds_read_tr16_b64_v4i16((LAS s16x4*)p)); }
__device__ __forceinline__ int crow(int i, int h) { return (i & 3) + 8 * (i >> 2) + 4 * h; }
__device__ __forceinline__ void tile_gload(const h16* gK, const h16* gV, unsigned pitch, v4u (&kr)[2], v4u (&vr)[2], int tid) {
    asm volatile("" : "+v"(tid));
#pragma unroll
    for (int i = 0; i < 2; ++i) { const unsigned cidx = tid + 512 * i, boff = ((cidx >> 4) * pitch + (cidx & 15) * 8) * 2u;
        kr[i] = *(const v4u*)((const char*)gK + boff); vr[i] = *(const v4u*)((const char*)gV + boff); }
}
__device__ __forceinline__ void tile_lstore(LAS unsigned char* buf, const v4u (&kr)[2], const v4u (&vr)[2], int tid) {
    asm volatile("" : "+v"(tid));
#pragma unroll
    for (int i = 0; i < 2; ++i) { const int cidx = tid + 512 * i, row = cidx >> 4, ch = cidx & 15; *(LAS v4u*)(buf + row * KPITCH + ch * 16) = kr[i]; *(LAS v4u*)(buf + AT_V + row * VPITCH + ch * 16) = vr[i]; }
}
__device__ __forceinline__ f32x16 qk_block(LAS unsigned char* KT, int kb, const h16x8 (&qf)[8], int lane) {
    f32x16 sacc;
#pragma unroll
    for (int i = 0; i < 16; ++i) sacc[i] = 0.f;
    LAS unsigned char* base = KT + (lane & 31) * KPITCH + (lane >> 5) * 16;
#pragma unroll
    for (int s = 0; s < 8; ++s) { const h16x8 kf = *(const LAS h16x8*)(base + kb * 32 * KPITCH + 32 * s); sacc = __builtin_amdgcn_mfma_f32_32x32x16_f16(kf, qf[s], sacc, 0, 0, 0); }
    return sacc;
}
__device__ __forceinline__ void pv_block(LAS unsigned char* VT, int kb, const h16x8 (&pf)[2], f32x16 (&oacc)[4], int lane) {
    const int h = lane >> 5, blk = (lane >> 4) & 1, q = (lane & 15) >> 2, p = lane & 3;
    LAS unsigned char* base = VT + (4 * h + q) * VPITCH + 32 * blk + 8 * p;
#pragma unroll
    for (int c = 0; c < 4; ++c)
#pragma unroll
        for (int s = 0; s < 2; ++s) {
            const h16x4 lo = tr_read(base + (kb * 32 + 16 * s) * VPITCH + 64 * c), hi = tr_read(base + (kb * 32 + 16 * s + 8) * VPITCH + 64 * c);
            const h16x8 vf = __builtin_shufflevector(lo, hi, 0, 1, 2, 3, 4, 5, 6, 7);
            oacc[c] = __builtin_amdgcn_mfma_f32_32x32x16_f16(vf, pf[s], oacc[c], 0, 0, 0);
            if (c == 1 && s == 1) asm volatile("" ::: "memory");
        }
}
__device__ __forceinline__ float lane_partner(float x) {
    const auto r = __builtin_amdgcn_permlane32_swap(__builtin_bit_cast(unsigned, x), __builtin_bit_cast(unsigned, x), false, false);
    return __builtin_bit_cast(float, (threadIdx.x & 32) ? r[0] : r[1]);
}
template <bool DIAG>
__device__ __forceinline__ void sb_weights(const f32x16& sacc, h16x8 (&pf)[2], float& C, int lane, int pos0, int t) {
    const int h = lane >> 5;
    float E[16], T[4], m1[4], m2[4], f0[4];
#pragma unroll
    for (int i = 0; i < 16; ++i) { float e = __builtin_amdgcn_exp2f(fminf(sacc[i], 24.f)); if (DIAG) e = (pos0 + crow(i, h) < t) ? e : 0.f; E[i] = e; }
#pragma unroll
    for (int g = 0; g < 4; ++g) { f0[g] = 1.f + E[4 * g]; m1[g] = f0[g] * (1.f + E[4 * g + 1]); m2[g] = m1[g] * (1.f + E[4 * g + 2]); T[g] = m2[g] * (1.f + E[4 * g + 3]); }
    float U[4], TPs[4];
#pragma unroll
    for (int g = 0; g < 4; ++g) { const float tp = lane_partner(T[g]); U[g] = T[g] * tp; TPs[g] = h ? 1.f : tp; }
    float V[4]; V[3] = C; V[2] = V[3] * U[3]; V[1] = V[2] * U[2]; V[0] = V[1] * U[1]; C = V[0] * U[0];
    float a[16];
#pragma unroll
    for (int g = 0; g < 4; ++g) { const float r = __builtin_amdgcn_rcpf(T[g] * (V[g] * TPs[g]));
        a[4 * g] = E[4 * g] * r; a[4 * g + 1] = E[4 * g + 1] * (r * f0[g]); a[4 * g + 2] = E[4 * g + 2] * (r * m1[g]); a[4 * g + 3] = E[4 * g + 3] * (r * m2[g]); }
#pragma unroll
    for (int s = 0; s < 2; ++s)
#pragma unroll
        for (int j = 0; j < 8; ++j) pf[s][j] = (_Float16)a[8 * s + j];
}
__device__ __forceinline__ void sb_attn_unit(LAS unsigned char* lds, const h16* PROJ, const float* gsb, h16* OG, float* SSQ16, int b, int head, int qt, int tid, int lane, int wave) {
    const int h = lane >> 5, n = lane & 31, q0 = 256 * qt + 32 * wave, t = q0 + n;
    const unsigned mrow = (unsigned)b * S + t;
    const unsigned prow = mrow * (unsigned)(LDP * 2);
    h16x8 qf[8];
#pragma unroll
    for (int s = 0; s < 8; ++s) qf[s] = *(const h16x8*)((const char*)PROJ + prow + (C_SBQ + head * HD + 16 * s + 8 * h) * 2);
    f32x16 oacc[4];
#pragma unroll
    for (int c = 0; c < 4; ++c)
#pragma unroll
        for (int i = 0; i < 16; ++i) oacc[c][i] = 0.f;
    float C = 1.f;
    const int jmax = 4 * qt + 3;
    const h16* gK = PROJ + (size_t)b * S * LDP + C_SBK + head * HD; const h16* gV = PROJ + (size_t)b * S * LDP + C_SBV + head * HD;
    v4u kr[2], vr[2];
    __syncthreads();
    tile_gload(gK + (size_t)(64 * jmax) * LDP, gV + (size_t)(64 * jmax) * LDP, (unsigned)LDP, kr, vr, tid);
    tile_lstore(lds, kr, vr, tid);
    __syncthreads();
    for (int j = jmax; j >= 0; --j) {
        LAS unsigned char* buf = lds + ((jmax - j) & 1) * AT_BUF;
        if (j > 0) tile_gload(gK + (size_t)(64 * (j - 1)) * LDP, gV + (size_t)(64 * (j - 1)) * LDP, (unsigned)LDP, kr, vr, tid);
#pragma unroll
        for (int kb = 1; kb >= 0; --kb) {
            const int pos0 = 64 * j + 32 * kb;
            if (pos0 < q0 + 31) {
                const f32x16 sacc = qk_block(buf, kb, qf, lane);
                h16x8 pf[2];
                if (pos0 + 31 >= q0) sb_weights<true>(sacc, pf, C, lane, pos0, t); else sb_weights<false>(sacc, pf, C, lane, pos0, t);
                pv_block(buf + AT_V, kb, pf, oacc, lane);
            }
        }
        if (j > 0) tile_lstore(lds + (((jmax - j) & 1) ^ 1) * AT_BUF, kr, vr, tid);
        __syncthreads();
    }
    float ss = 0.f;
#pragma unroll
    for (int c = 0; c < 4; ++c)
#pragma unroll
        for (int i = 0; i < 16; ++i) ss += oacc[c][i] * oacc[c][i];
    ss += lane_partner(ss);
    if (h == 0) *(float*)((char*)SSQ16 + (mrow * 16u + head) * 4u) = ss;
#pragma unroll
    for (int c = 0; c < 4; ++c)
#pragma unroll
        for (int g = 0; g < 4; ++g) {
            const int d0 = 32 * c + 8 * g + 4 * h;
            const h16x4 z4 = *(const h16x4*)((const char*)PROJ + prow + (C_SBZ + head * HD + d0) * 2); const f32x4v g4 = *(const f32x4v*)(gsb + head * HD + d0);
            h16x4 o4;
#pragma unroll
            for (int e = 0; e < 4; ++e) { const float z = (float)z4[e]; o4[e] = (_Float16)(oacc[c][4 * g + e] * g4[e] * (z / (1.f + __expf(-z)))); }
            *(h16x4*)((char*)OG + mrow * 4096u + (head * HD + d0) * 2) = o4;
        }
}


constexpr float LOG2E = 1.4426950408889634f;
constexpr int NS_BT = 2 * AT_BUF, NS_IMPG = NS_BT + 16384, NS_IMPL = NS_IMPG + 16384, NS_OFIN = NS_IMPG;
static_assert(NS_OFIN + 65536 <= 157696, "NSA LDS map");
constexpr int BT_SHIFT = 96;
template <int CTRL> __device__ __forceinline__ float dpp_f(float x) { return __builtin_bit_cast(float, __builtin_amdgcn_update_dpp(0, __builtin_bit_cast(int, x), CTRL, 0xf, 0xf, true)); }
__device__ __forceinline__ float quad_sum(float x) { x += dpp_f<0xB1>(x); x += dpp_f<0x4E>(x); return x; }
template <int MODE>
__device__ __forceinline__ unsigned nsa_scores(const f32x16& sacc, float (&sv)[16], const LAS float* BTr, float b31, int d0, int h, bool selbit, bool far) {
    unsigned vm = 0u;
    const LAS float* bp = BTr + 4 * (d0 + BT_SHIFT - 4 * h - 27);
#pragma unroll
    for (int i = 0; i < 16; ++i) {
        const int dist = d0 - (MODE == 0 ? 16 : 1) * crow(i, h);
        bool ok = dist >= 0; if (MODE == 2) ok = ok && selbit; if (MODE == 3) ok = ok && dist < 512;
        float bias;
        if (MODE == 0) bias = far ? b31 : BTr[4 * (min(max(dist, 0), 1023 - BT_SHIFT) + BT_SHIFT)];
        else bias = far ? b31 : bp[4 * (27 - (i & 3) - 8 * (i >> 2))];
        sv[i] = ok ? sacc[i] + bias : -1e30f; vm |= ok ? (1u << i) : 0u;
    }
    return vm;
}
__device__ __forceinline__ float max16(const float (&sv)[16]) {
    float a = fmaxf(fmaxf(sv[0], sv[1]), fmaxf(sv[2], sv[3])), b = fmaxf(fmaxf(sv[4], sv[5]), fmaxf(sv[6], sv[7])), c = fmaxf(fmaxf(sv[8], sv[9]), fmaxf(sv[10], sv[11])), d = fmaxf(fmaxf(sv[12], sv[13]), fmaxf(sv[14], sv[15]));
    return fmaxf(fmaxf(a, b), fmaxf(c, d));
}
__device__ __forceinline__ void online_step(const float (&sv)[16], unsigned vm, float& m, float& l, float (&pv)[16], f32x16 (&oacc)[4]) {
    float bm = max16(sv); bm = fmaxf(bm, lane_partner(bm));
    const float mn = fmaxf(m, bm), alpha = __builtin_amdgcn_exp2f(m - mn);
    float ps = 0.f;
#pragma unroll
    for (int i = 0; i < 16; ++i) { pv[i] = ((vm >> i) & 1u) ? __builtin_amdgcn_exp2f(sv[i] - mn) : 0.f; ps += pv[i]; }
    ps += lane_partner(ps);
    l = l * alpha + ps; m = mn;
#pragma unroll
    for (int c = 0; c < 4; ++c)
#pragma unroll
        for (int i = 0; i < 16; ++i) oacc[c][i] *= alpha;
}
__device__ __forceinline__ void pack_p(const float (&pv)[16], float scale, h16x8 (&pf)[2]) {
#pragma unroll
    for (int s = 0; s < 2; ++s)
#pragma unroll
        for (int j = 0; j < 8; ++j) pf[s][j] = (_Float16)(pv[8 * s + j] * scale);
}
#define NSA_LOOP_BEGIN(GK, GV, PITCH, J0, J1) { \
    const h16* _gk = (GK); const h16* _gv = (GV); const int _j0 = (J0), _j1 = (J1); const unsigned _pitch = (PITCH); v4u _kr[2], _vr[2]; \
    __syncthreads(); \
    tile_gload(_gk + (size_t)(64 * _j0) * _pitch, _gv + (size_t)(64 * _j0) * _pitch, _pitch, _kr, _vr, tid); tile_lstore(lds, _kr, _vr, tid); \
    __syncthreads(); \
    for (int j = _j0; j <= _j1; ++j) { LAS unsigned char* buf = lds + ((j - _j0) & 1) * AT_BUF; \
        if (j < _j1) tile_gload(_gk + (size_t)(64 * (j + 1)) * _pitch, _gv + (size_t)(64 * (j + 1)) * _pitch, _pitch, _kr, _vr, tid);
#define NSA_LOOP_END() \
        if (j < _j1) tile_lstore(lds + (((j - _j0) & 1) ^ 1) * AT_BUF, _kr, _vr, tid); \
        __syncthreads(); } }

__device__ __forceinline__ void nsa_unit(LAS unsigned char* lds, const h16* PROJ, const h16* KCC, const h16* VCC, const float* rel_bias, const float* gnsa, h16* OG, float* SSQ16,
                                         int b, int g, int cur, int tid, int lane, int wave) {
    const int h = lane >> 5, n = lane & 31, tl = n >> 2, r = n & 3, hh = 4 * g + r, tw0 = 64 * cur + 8 * wave, t = tw0 + tl;
    const unsigned mrow = (unsigned)b * S + t;
    const unsigned prow = mrow * (unsigned)(LDP * 2);
    LAS float* BT = (LAS float*)(lds + NS_BT); LAS float* IMPG = (LAS float*)(lds + NS_IMPG); LAS float* IMPL = (LAS float*)(lds + NS_IMPL);
    __syncthreads();
    for (int i = tid; i < 4096; i += NTHR) BT[i] = rel_bias[rel_bucket(max((i >> 2) - BT_SHIFT, 0)) * NHEAD + 4 * g + (i & 3)] * LOG2E;
    for (int i = tid; i < 8192; i += NTHR) IMPG[i] = 0.f;
    h16x8 qf[8];
#pragma unroll
    for (int s = 0; s < 8; ++s) qf[s] = *(const h16x8*)((const char*)PROJ + prow + (C_NQ + hh * HD + 16 * s + 8 * h) * 2);
#define NSA_GATE(k) (1.f / (1.f + __expf(-(float)*(const h16*)((const char*)PROJ + prow + (C_GATE + hh * 3 + (k)) * 2))))
    f32x16 oacc[4];
    LAS unsigned char* OFIN = lds + NS_OFIN + wave * 8192 + lane * 16;
#pragma unroll
    for (int c = 0; c < 4; ++c)
#pragma unroll
        for (int i = 0; i < 16; ++i) oacc[c][i] = 0.f;
    __syncthreads();
    const LAS float* BTr = BT + r; const float b31 = BT[4 * 1023 + r];

    const h16* gKC = KCC + (size_t)(b * NG + g) * NCBP * HD; const h16* gVC = VCC + (size_t)(b * NG + g) * NCBP * HD;
    const int jc1 = (4 * cur + 2) >> 6;
    float mc = -1e30f, lc = 0.f;
    NSA_LOOP_BEGIN(gKC, gVC, HD, 0, jc1)
#pragma unroll
        for (int kb = 0; kb < 2; ++kb) {
            const int nb = 64 * j + 32 * kb;
            if (16 * nb + 31 <= tw0 + 7) {
                const f32x16 sacc = qk_block(buf, kb, qf, lane); float sv[16];
                const bool far = (tw0 - 31 - 16 * (nb + 31)) >= 790;
                const unsigned vm = nsa_scores<0>(sacc, sv, BTr, b31, t - 31 - 16 * nb, h, true, far);
                float bm = max16(sv); bm = fmaxf(bm, lane_partner(bm));
                const float mn = fmaxf(mc, bm), alpha = __builtin_amdgcn_exp2f(mc - mn); float ps = 0.f;
#pragma unroll
                for (int i = 0; i < 16; ++i) ps += ((vm >> i) & 1u) ? __builtin_amdgcn_exp2f(sv[i] - mn) : 0.f;
                ps += lane_partner(ps); lc = lc * alpha + ps; mc = mn;
            }
        }
    NSA_LOOP_END()
    const float invlc = lc > 0.f ? 1.f / lc : 0.f, g0 = NSA_GATE(0);
    NSA_LOOP_BEGIN(gKC, gVC, HD, 0, jc1)
#pragma unroll
        for (int kb = 0; kb < 2; ++kb) {
            const int nb = 64 * j + 32 * kb;
            if (16 * nb + 31 <= tw0 + 7) {
                const f32x16 sacc = qk_block(buf, kb, qf, lane); float sv[16], pv[16];
                const bool far = (tw0 - 31 - 16 * (nb + 31)) >= 790;
                const unsigned vm = nsa_scores<0>(sacc, sv, BTr, b31, t - 31 - 16 * nb, h, true, far);
#pragma unroll
                for (int i = 0; i < 16; ++i) pv[i] = ((vm >> i) & 1u) ? __builtin_amdgcn_exp2f(sv[i] - mc) * invlc : 0.f;
#pragma unroll
                for (int gq = 0; gq < 4; ++gq) {
                    const float gs = quad_sum((pv[4 * gq] + pv[4 * gq + 1]) + (pv[4 * gq + 2] + pv[4 * gq + 3])), ls = quad_sum(pv[4 * gq + 3]);
                    const int jsel = (nb >> 2) + 2 * gq + h;
                    if (r == 0) { IMPG[(8 * wave + tl) * 64 + jsel] = gs; if (jsel + 1 < 64) IMPL[(8 * wave + tl) * 64 + jsel + 1] = ls; }
                }
                h16x8 pf[2]; pack_p(pv, g0, pf);
                pv_block(buf + AT_V, kb, pf, oacc, lane);
            }
        }
    NSA_LOOP_END()
    unsigned sel_lo = 0u, sel_hi = 0u;
#pragma unroll 1
    for (int tk = 0; tk < 8; ++tk) {
        const int jb = lane; const float imp = IMPG[(8 * wave + tk) * 64 + jb] + IMPL[(8 * wave + tk) * 64 + jb];
        const bool valid = jb <= cur, forced = (jb == 0) || (jb == cur) || (jb == cur - 1);
        const unsigned key = (valid ? ((forced ? 0x4e6e6b28u   : __builtin_bit_cast(unsigned, imp)) & ~63u) : 0u) | (unsigned)(63 - jb);
        int rank = 0;
#pragma unroll
        for (int i = 0; i < 64; ++i) rank += ((unsigned)__builtin_amdgcn_readlane((int)key, i) > key) ? 1 : 0;
        const u64 mask = __ballot(rank < 16);
        if (tl == tk) { sel_lo = (unsigned)mask; sel_hi = (unsigned)(mask >> 32); }
    }
    __syncthreads();
#pragma unroll
    for (int c = 0; c < 4; ++c)
#pragma unroll
        for (int k = 0; k < 2; ++k) { h16x8 w;
#pragma unroll
            for (int e = 0; e < 8; ++e) w[e] = (_Float16)oacc[c][8 * k + e];
            *(LAS h16x8*)(OFIN + (2 * c + k) * 1024) = w; }
    {
#pragma unroll
        for (int c = 0; c < 4; ++c)
#pragma unroll
            for (int i = 0; i < 16; ++i) oacc[c][i] = 0.f;
        float m = -1e30f, l = 0.f;
        const h16* gK = PROJ + (size_t)b * S * LDP + C_KS + g * HD; const h16* gV = PROJ + (size_t)b * S * LDP + C_VS + g * HD;
        NSA_LOOP_BEGIN(gK, gV, LDP, 0, cur)
            const bool selbit = (((j < 32) ? (sel_lo >> j) : (sel_hi >> (j - 32))) & 1u) != 0u;
            if (__any(selbit)) {
#pragma unroll
                for (int kb = 0; kb < 2; ++kb) {
                    const int pos0 = 64 * j + 32 * kb;
                    if (pos0 <= tw0 + 7) {
                        const f32x16 sacc = qk_block(buf, kb, qf, lane); float sv[16], pv[16];
                        const bool far = (tw0 - (pos0 + 31)) >= 790;
                        const unsigned vm = nsa_scores<2>(sacc, sv, BTr, b31, t - pos0, h, selbit, far);
                        online_step(sv, vm, m, l, pv, oacc);
                        h16x8 pf[2]; pack_p(pv, 1.f, pf);
                        pv_block(buf + AT_V, kb, pf, oacc, lane);
                    }
                }
            }
    NSA_LOOP_END()
        const float cs = NSA_GATE(1) / l;
#pragma unroll
        for (int c = 0; c < 4; ++c)
#pragma unroll
            for (int k = 0; k < 2; ++k) { h16x8 w = *(const LAS h16x8*)(OFIN + (2 * c + k) * 1024);
#pragma unroll
                for (int e = 0; e < 8; ++e) w[e] = (_Float16)((float)w[e] + cs * oacc[c][8 * k + e]);
                *(LAS h16x8*)(OFIN + (2 * c + k) * 1024) = w; }
    }
    {
#pragma unroll
        for (int c = 0; c < 4; ++c)
#pragma unroll
            for (int i = 0; i < 16; ++i) oacc[c][i] = 0.f;
        float m = -1e30f, l = 0.f;
        const h16* gK = PROJ + (size_t)b * S * LDP + C_KW + g * HD; const h16* gV = PROJ + (size_t)b * S * LDP + C_VW + g * HD;
        NSA_LOOP_BEGIN(gK, gV, LDP, max(0, cur - 8), cur)
#pragma unroll
            for (int kb = 0; kb < 2; ++kb) {
                const int pos0 = 64 * j + 32 * kb;
                if (pos0 <= tw0 + 7 && (tw0 - (pos0 + 31)) < 512) {
                    const f32x16 sacc = qk_block(buf, kb, qf, lane); float sv[16], pv[16];
                    const unsigned vm = nsa_scores<3>(sacc, sv, BTr, b31, t - pos0, h, true, false);
                    online_step(sv, vm, m, l, pv, oacc);
                    h16x8 pf[2]; pack_p(pv, 1.f, pf);
                    pv_block(buf + AT_V, kb, pf, oacc, lane);
                }
            }
    NSA_LOOP_END()
        const float cs = NSA_GATE(2) / l;
#pragma unroll
        for (int c = 0; c < 4; ++c)
#pragma unroll
            for (int k = 0; k < 2; ++k) { const h16x8 w = *(const LAS h16x8*)(OFIN + (2 * c + k) * 1024);
#pragma unroll
                for (int e = 0; e < 8; ++e) oacc[c][8 * k + e] = (float)w[e] + cs * oacc[c][8 * k + e]; }
    }
    float ss = 0.f;
#pragma unroll
    for (int c = 0; c < 4; ++c)
#pragma unroll
        for (int i = 0; i < 16; ++i) ss += oacc[c][i] * oacc[c][i];
    ss += lane_partner(ss);
    if (h == 0) *(float*)((char*)SSQ16 + (mrow * 16u + 8 + hh) * 4u) = ss;
#pragma unroll
    for (int c = 0; c < 4; ++c)
#pragma unroll
        for (int gq = 0; gq < 4; ++gq) {
            const int d0 = 32 * c + 8 * gq + 4 * h;
            const h16x4 z4 = *(const h16x4*)((const char*)PROJ + prow + (C_NZ + hh * HD + d0) * 2); const f32x4v g4 = *(const f32x4v*)(gnsa + hh * HD + d0);
            h16x4 o4;
#pragma unroll
            for (int e = 0; e < 4; ++e) { const float z = (float)z4[e]; o4[e] = (_Float16)(oacc[c][4 * gq + e] * g4[e] * (z / (1.f + __expf(-z)))); }
            *(h16x4*)((char*)OG + mrow * 4096u + (1024 + hh * HD + d0) * 2) = o4;
        }
}


constexpr int CP_PITCH = 272, CP_HID = 0, CP_HPITCH = 528;
static_assert(16 * 33 * CP_PITCH <= RING_BYTES, "compress LDS map");
__device__ __forceinline__ void compress_unit(LAS unsigned char* lds, const h16* PROJ, const h16* W1T, const h16* W2T, const float* PB, h16* out, int b, int g, int kv, int ch, int tid, int lane, int wave) {
    const int n0 = 32 * ch, h = lane >> 5, r = lane & 31;
    const h16* src = PROJ + (size_t)(b * S + 16 * n0) * LDP + (kv ? C_VC : C_KC) + g * HD;
    __syncthreads();
    for (int i = tid; i < 528 * 16; i += NTHR) {
        const int row = i >> 4, chn = i & 15; v4u v = {0u, 0u, 0u, 0u};
        if (16 * n0 + row < S) v = *(const v4u*)(src + (size_t)row * LDP + chn * 8);
        *(LAS v4u*)(lds + ((row & 15) * 33 + (row >> 4)) * CP_PITCH + chn * 16) = v;
    }
    __syncthreads();
    f32x16 acc;
#pragma unroll
    for (int i = 0; i < 16; ++i) acc[i] = 0.f;
    const h16* wrow = W1T + (size_t)(32 * wave + r) * 4096 + 8 * h;
    LAS unsigned char* abase = lds + r * CP_PITCH + h * 16;
#pragma unroll 2
    for (int l = 0; l < 32; ++l) {
        LAS unsigned char* ap = abase + ((l & 15) * 33 + (l >> 4)) * CP_PITCH;
#pragma unroll
        for (int s = 0; s < 8; ++s) {
            const h16x8 af = *(const LAS h16x8*)(ap + 32 * s), bf = *(const h16x8*)(wrow + l * 128 + 16 * s);
            acc = __builtin_amdgcn_mfma_f32_32x32x16_f16(af, bf, acc, 0, 0, 0);
        }
    }
    __syncthreads();
    { const int e = 32 * wave + r; float pb = 0.f;
#pragma unroll
      for (int k = 0; k < 8; ++k) pb += PB[(k * 2 + kv) * 256 + e];
#pragma unroll
      for (int i = 0; i < 16; ++i) { const float x = acc[i] + pb, u = 0.7978845608028654f * (x + 0.044715f * x * x * x);
          const float th = 1.f - 2.f / (1.f + __expf(2.f * u));
          *(LAS h16*)(lds + CP_HID + crow(i, h) * CP_HPITCH + e * 2) = (h16)(0.5f * x * (1.f + th)); } }
    __syncthreads();
    if (wave < 4) {
        f32x16 o;
#pragma unroll
        for (int i = 0; i < 16; ++i) o[i] = 0.f;
        const h16* w2row = W2T + (size_t)(32 * wave + r) * 256 + 8 * h;
        LAS unsigned char* hb = lds + CP_HID + r * CP_HPITCH + h * 16;
#pragma unroll
        for (int s = 0; s < 16; ++s) { const h16x8 af = *(const LAS h16x8*)(hb + 32 * s), bf = *(const h16x8*)(w2row + 16 * s); o = __builtin_amdgcn_mfma_f32_32x32x16_f16(af, bf, o, 0, 0, 0); }
        h16* dst = out + ((size_t)(b * NG + g) * NCBP + n0) * HD + 32 * wave + r;
#pragma unroll
        for (int i = 0; i < 16; ++i) { const int row = crow(i, h); dst[(size_t)row * HD] = (n0 + row < NCB) ? (h16)o[i] : (h16)0.f; }
    }
}

struct Args { const float* in[14]; float* out; unsigned char* ws; int ph_lo, ph_hi; };

__global__ void __launch_bounds__(NTHR, 2) fwd(Args args) {
    extern __shared__ __attribute__((aligned(16))) unsigned char lds_raw[];
    LAS unsigned char* lds = (LAS unsigned char*)lds_raw;
    volatile LAS unsigned* MISC = (volatile LAS unsigned*)(lds + MISC_OFF);
    const int tid = threadIdx.x, lane = tid & 63, wave = __builtin_amdgcn_readfirstlane(tid >> 6);
    const int G = gridDim.x; const int bx = blockIdx.x; const int vcu = (G % 8 == 0) ? (bx % 8) * (G / 8) + bx / 8 : bx;
    unsigned char* ws = args.ws;
    unsigned* ctl = (unsigned*)(ws + WS_CTL);
    for (int u = tid; u < (LDS_BYTES - LDSCTL_OFF) / 4; u += NTHR) ((LAS unsigned*)(lds + LDSCTL_OFF))[u] = 0u;
    __syncthreads();
    XcdBarrier bar = xcd_barrier_post(ctl + CW_BAR, MISC + 8);
    const int lo = args.ph_lo, hi = args.ph_hi;
#define IN(k) (lo <= (k) && (k) < hi)
#define BOTH(k) (IN(k) && IN((k) + 1))
    h16* XN = (h16*)(ws + WS_XN); h16* WINT = (h16*)(ws + WS_WINT); h16* WOUTT = (h16*)(ws + WS_WOUTT); h16* PROJ = (h16*)(ws + WS_PROJ);

    if (IN(0)) {
        LAS float* scr = (LAS float*)(lds + RING_OFF + wave * 16384);
        const int gw = vcu * NWAVES + wave, NGW = G * NWAVES;
        constexpr int I_IN = (D / 64) * (LDP / 32), I_OUT = (D / 64) * (D / 32), I_W1 = (4096 / 64) * (256 / 32), I_W2 = (256 / 64) * (128 / 32), I_PB = 2 * 8 * 4;
        h16* W1T = (h16*)(ws + WS_W1T); h16* W2T = (h16*)(ws + WS_W2T); float* PB = (float*)(ws + WS_PB);
        for (int it = gw; it < I_IN + I_OUT + 2 * I_W1 + 2 * I_W2 + I_PB; it += NGW) {
            int q = it;
            if (q < I_IN) { p0_transpose_item(args.in[2], D, NPROJ, true, WINT, scr, q, LDP / 32, lane); continue; } q -= I_IN;
            if (q < I_OUT) { p0_transpose_item(args.in[12], D, D, false, WOUTT, scr, q, D / 32, lane); continue; } q -= I_OUT;
            if (q < 2 * I_W1) { const int kv = q / I_W1; p0_transpose_item(args.in[kv ? 7 : 4], 4096, 256, false, W1T + (size_t)kv * 256 * 4096, scr, q % I_W1, 256 / 32, lane); continue; } q -= 2 * I_W1;
            if (q < 2 * I_W2) { const int kv = q / I_W2; p0_transpose_item(args.in[kv ? 8 : 5], 256, 128, false, W2T + (size_t)kv * 128 * 256, scr, q % I_W2, 128 / 32, lane); continue; } q -= 2 * I_W2;
            { const int kv = q & 1, ec = (q >> 1) & 3, kc = q >> 3;
              const float* pos = args.in[kv ? 6 : 3]; const float* w1 = args.in[kv ? 7 : 4]; float a = 0.f;
              for (int k = 512 * kc; k < 512 * kc + 512; ++k) a += pos[k] * w1[(size_t)k * 256 + 64 * ec + lane];
              PB[(kc * 2 + kv) * 256 + 64 * ec + lane] = a; }
        }
        for (int m = gw; m < M; m += NGW) p0_rms_row(args.in[0] + (size_t)m * D, args.in[1], XN + (size_t)m * D, lane);
        if (BOTH(0)) xcd_barrier(bar);
    }
    if (IN(1)) {
        pg8::Gemm g{(const pg8::bf16_t*)XN, (const pg8::bf16_t*)WINT, M, LDP, D}; pg8::StaticOrder SO; SO.init(M, LDP, G, bx);
        pg8::EpiF16 E{PROJ, LDP, QSCALE};
        pg8::gemm_phase<pg8::EpiF16, pg8::StaticOrder, true, true>(lds + RING_OFF, g, SO, E);
        if (BOTH(1)) xcd_barrier(bar);
    }
    h16* OG = (h16*)(ws + WS_OG); float* SSQ16 = (float*)(ws + WS_SSQ16); h16* KCC = (h16*)(ws + WS_KCC); h16* VCC = (h16*)(ws + WS_VCC); float* SSQ = (float*)(ws + WS_SSQ);
    if (IN(2)) {
        const h16* W1T = (const h16*)(ws + WS_W1T); const h16* W2T = (const h16*)(ws + WS_W2T); const float* PB = (const float*)(ws + WS_PB);
        for (int idx = vcu; idx < 256; idx += G) {
            const int ch = idx & 7, kv = (idx >> 3) & 1, g = (idx >> 4) & 1, b = idx >> 5;
            compress_unit(lds + RING_OFF, PROJ, W1T + (size_t)kv * 256 * 4096, W2T + (size_t)kv * 128 * 256, PB, kv ? VCC : KCC, b, g, kv, ch, tid, lane, wave);
        }
        if (BOTH(2)) xcd_barrier(bar);
    }
    if (IN(3)) {
        for (int idx = vcu; idx < 1024; idx += G) {
            const int r = idx >> 8, v = idx & 255, c = v >> 6, bh = v & 63;
            const int qt = (r == 0) ? 15 - c : (r == 1) ? 8 + c : (r == 2) ? 7 - c : c;
            sb_attn_unit(lds + RING_OFF, PROJ, args.in[10], OG, SSQ16, bh >> 3, bh & 7, qt, tid, lane, wave);
        }
    }
    if (IN(4)) {
        for (int idx = vcu; idx < 1024; idx += G) {
            const int rr = idx >> 8, v = idx & 255, c = v >> 4, bg = v & 15;
            const int cur = (rr == 0) ? 63 - c : (rr == 1) ? 32 + c : (rr == 2) ? 31 - c : c;
            nsa_unit(lds + RING_OFF, PROJ, KCC, VCC, args.in[9], args.in[11], OG, SSQ16, bg >> 1, bg & 1, cur, tid, lane, wave);
        }
        if (BOTH(4)) xcd_barrier(bar);
    }
    if (IN(5)) {
        const int gw = vcu * NWAVES + wave, NGW = G * NWAVES;
        for (int m = gw; m < M; m += NGW) {
            const float4v sq = ((const float4v*)(SSQ16 + (size_t)m * 16))[lane & 3];
            float s4 = (sq[0] + sq[1]) + (sq[2] + sq[3]);
            s4 += __shfl_xor(s4, 1);
            const float r_sb = rsqrtf(__shfl(s4, 0) * (1.f / 1024.f) + RMS_EPS), r_ns = rsqrtf(__shfl(s4, 2) * (1.f / 1024.f) + RMS_EPS);
            const h16x8* src = (const h16x8*)(OG + (size_t)m * 2048); h16x8* dst = (h16x8*)(XN + (size_t)m * D);
#pragma unroll
            for (int k = 0; k < 4; ++k) { const int ci = lane + 64 * k; const float rr = (ci < 128) ? r_sb : r_ns; h16x8 v = src[ci];
#pragma unroll
                for (int e = 0; e < 8; ++e) v[e] = (_Float16)((float)v[e] * rr);
                dst[ci] = v; }
        }
        if (BOTH(5)) xcd_barrier(bar);
    }
    if (IN(6)) {
        pg8::Gemm g{(const pg8::bf16_t*)XN, (const pg8::bf16_t*)WOUTT, M, D, D}; pg8::StaticOrder SO; SO.init(M, D, G, bx);
        pg8::EpiResF32 E{args.in[0], args.out, D, SSQ};
        pg8::gemm_phase<pg8::EpiResF32, pg8::StaticOrder, true, true>(lds + RING_OFF, g, SO, E);
        if (BOTH(6)) xcd_barrier(bar);
    }
    if (IN(7)) {
        const int gw = vcu * NWAVES + wave, NGW = G * NWAVES;
        for (int m = gw; m < M; m += NGW) {
            float s = (lane < 32) ? SSQ[(size_t)m * 32 + lane] : 0.f;
            s = wave_sum(s);
            const float r = rsqrtf(s * (1.f / D) + RMS_EPS);
            float4v* xr = (float4v*)(args.out + (size_t)m * D) + lane; const float4v* gr = (const float4v*)args.in[13] + lane;
#pragma unroll
            for (int j = 0; j < 8; ++j) { const float4v v = xr[64 * j], gg = gr[64 * j]; xr[64 * j] = v * r * gg; }
        }
    }
#undef IN
#undef BOTH
}

extern "C" void kernel_launch(void* const* d_in, const int* in_sizes, int n_in, void* d_out, int out_size, void* d_ws, size_t ws_size, hipStream_t stream) {
    static int grid = 0;
    if (grid == 0) {
        if (n_in != 14 || in_sizes[0] != M * D || out_size != M * D || ws_size < WS_END) { fprintf(stderr, "kernel_launch: unexpected shapes (n_in %d in0 %d out %d ws %zu need %zu)\n", n_in, n_in > 0 ? in_sizes[0] : -1, out_size, ws_size, (size_t)WS_END); grid = -1; return; }
        int dev = 0, cus = 0, per_cu = 0;
        if (hipGetDevice(&dev) != hipSuccess || hipDeviceGetAttribute(&cus, hipDeviceAttributeMultiprocessorCount, dev) != hipSuccess) { grid = -1; return; }
        if (hipFuncSetAttribute((const void*)fwd, hipFuncAttributeMaxDynamicSharedMemorySize, LDS_BYTES) != hipSuccess) { fprintf(stderr, "kernel_launch: hipFuncSetAttribute failed\n"); grid = -1; return; }
        if (hipOccupancyMaxActiveBlocksPerMultiprocessor(&per_cu, (const void*)fwd, NTHR, LDS_BYTES) != hipSuccess || per_cu < 1) { fprintf(stderr, "kernel_launch: occupancy query says %d blocks per CU\n", per_cu); grid = -1; return; }
        (void)hipGetLastError();
        grid = cus;
    }
    if (grid < 0) return;
    const float* x = (const float*)d_in[0];
    const float* kpos = (const float*)d_in[3]; const float* kw1 = (const float*)d_in[4]; const float* kw2 = (const float*)d_in[5];
    const float* vpos = (const float*)d_in[6]; const float* vw1 = (const float*)d_in[7]; const float* vw2 = (const float*)d_in[8];
    const float* rel_bias = (const float*)d_in[9]; const float* norm_sb = (const float*)d_in[10]; const float* norm_nsa = (const float*)d_in[11];
    const float* norm_final = (const float*)d_in[13];
    unsigned char* ws = (unsigned char*)d_ws; float* out = (float*)d_out;
    h16* XN = (h16*)(ws + WS_XN); h16* WOUTT = (h16*)(ws + WS_WOUTT); h16* PROJ = (h16*)(ws + WS_PROJ);
    h16* KCC = (h16*)(ws + WS_KCC); h16* VCC = (h16*)(ws + WS_VCC); u64* SEL = (u64*)(ws + WS_SEL); float* OC = (float*)(ws + WS_OC);
    float* ONSA = out + (size_t)M * 1024;

    (void)hipMemsetAsync(ws + WS_CTL, 0, CTL_ZERO_BYTES, stream);
    Args a{};
    for (int i = 0; i < 14; ++i) a.in[i] = (const float*)d_in[i];
    a.out = out; a.ws = ws; a.ph_lo = 0; a.ph_hi = 8;
    hipLaunchKernelGGL(fwd, dim3(grid), dim3(NTHR), LDS_BYTES, stream, a);
}
```

```cpp
#include <hip/hip_runtime.h>
#include <cstdio>
#include <cstdint>

typedef _Float16 h16;
typedef unsigned long long u64;

constexpr int NB = 8, S = 4096, D = 2048, M = NB * S;
constexpr int HD = 128, NHEAD = 8, NG = 2, NR = 4;
constexpr int NPROJ = 7704, LDP = 7936;
constexpr int C_SBQ = 0, C_SBK = 1024, C_SBV = 2048, C_SBZ = 3072, C_NQ = 4096, C_KC = 5120, C_VC = 5376, C_KS = 5632, C_VS = 5888,
              C_KW = 6144, C_VW = 6400, C_NZ = 6656, C_GATE = 7680;
constexpr int HS_SBQ = 0, HS_SBK = 8, HS_SBV = 16, HS_SBZ = 24, HS_NQ = 32, HS_KC = 40, HS_VC = 42, HS_KS = 44, HS_VS = 46, HS_KW = 48, HS_VW = 50, HS_NZ = 52, HS_GATE = 60;
constexpr unsigned SLOT_BYTES = (unsigned)M * HD * 2;
constexpr int NCB = 255, NCBP = 256;
constexpr float RMS_EPS = 1e-6f;
constexpr float QSCALE = 0.08838834764831845f * 1.4426950408889634f;
constexpr float QMUL = 0.6931471805599453f;

constexpr size_t MiB = 1u << 20;
constexpr size_t WS_CTL = 0;
constexpr size_t WS_XN = 1 * MiB;
constexpr size_t WS_WINT = WS_XN + (size_t)M * D * 2;
constexpr size_t WS_WOUTT = WS_WINT + (size_t)LDP * D * 2;
constexpr size_t WS_PROJ = WS_WOUTT + (size_t)D * D * 2;
constexpr size_t WS_KCC = WS_PROJ + (size_t)M * LDP * 2;
constexpr size_t WS_VCC = WS_KCC + (size_t)NB * NG * NCBP * HD * 2;
constexpr size_t WS_SEL = WS_VCC + (size_t)NB * NG * NCBP * HD * 2;
constexpr size_t WS_OC = WS_SEL + (size_t)M * NG * 8;
constexpr size_t WS_SSQ = WS_OC + (size_t)M * 1024 * 4;
constexpr size_t WS_OG = WS_SSQ + (size_t)M * 32 * 4;
constexpr size_t WS_SSQ16 = WS_OG + (size_t)M * 2048 * 2;
constexpr size_t WS_W1T = WS_SSQ16 + (size_t)M * 16 * 4;
constexpr size_t WS_W2T = WS_W1T + (size_t)2 * 256 * 4096 * 2;
constexpr size_t WS_PB = WS_W2T + (size_t)2 * 128 * 256 * 2;
constexpr size_t WS_END = WS_PB + (size_t)32 * 2 * 256 * 4;

__device__ __forceinline__ int src_col(int c) { return c < 6656 ? c : (c < 7680 ? c + 24 : (c < NPROJ ? c - 1024 : -1)); }

__device__ __forceinline__ int rel_bucket(int dist) {
    if (dist < 16) return dist < 0 ? 0 : dist;
    int b = 16;
    b += dist >= 21; b += dist >= 27; b += dist >= 35; b += dist >= 46; b += dist >= 59; b += dist >= 77; b += dist >= 99; b += dist >= 128;
    b += dist >= 166; b += dist >= 216; b += dist >= 280; b += dist >= 363; b += dist >= 470; b += dist >= 609; b += dist >= 790;
    return b;
}
__device__ __forceinline__ float wave_sum(float v) {
#pragma unroll
    for (int o = 1; o < 64; o <<= 1) v += __shfl_xor(v, o);
    return v;
}
__device__ __forceinline__ float wave_max(float v) {
#pragma unroll
    for (int o = 1; o < 64; o <<= 1) v = fmaxf(v, __shfl_xor(v, o));
    return v;
}

namespace pg8 {
#define PG8_LAS __attribute__((address_space(3)))
typedef unsigned short bf16_t;
typedef _Float16 bf16x8 __attribute__((ext_vector_type(8)));
typedef float f32x4 __attribute__((ext_vector_type(4)));
typedef unsigned u32x4 __attribute__((ext_vector_type(4)));
constexpr int BM = 256, BK = 64, HALF = 128, HTB = HALF * BK * 2  , STAGE_BYTES = 8 * HTB, NXCD = 8, WGM = 8;

__host__ __device__ __forceinline__ int lds_byte(int r, int c) { const int st = (r >> 4) * 2 + (c >> 5), rr = r & 15, cc = c & 31, ob = rr * 64 + cc * 2; return st * 1024 + (ob ^ (((ob >> 9) & 1) << 5)); }
__host__ __device__ __forceinline__ void stage_rc(int b, int& R, int& C) { const int st = b / 1024, sb = b % 1024, swz = sb ^ (((sb >> 9) & 1) << 5); R = (st >> 1) * 16 + swz / 64; C = (st & 1) * 32 + (swz % 64) / 2; }
__host__ __device__ __forceinline__ int perm32(int rho) { const int n = rho >> 4, i = rho & 15; return 8 * (i >> 2) + 4 * n + (i & 3); }

struct Unit { int pm, pn; };
struct Gemm { const bf16_t* A; const bf16_t* Bt; int M, N, K; };

struct StaticOrder {
    int nM, nN, nwg, G, c;
    __host__ __device__ void init(int M, int N, int G_, int c_) { nM = M / BM; nN = N / BM; nwg = nM * nN; G = G_; c = c_; }
    __host__ __device__ bool next(int i, Unit& u) const {
        const long L = (long)i * G + c; if (L >= nwg) return false;
        int wgid = (int)L; { const int q = nwg / NXCD, r = nwg % NXCD, xcd = wgid % NXCD, off = wgid / NXCD; wgid = (xcd < r ? xcd * (q + 1) : r * (q + 1) + (xcd - r) * q) + off; }
        const int nig = WGM * nN, gid = wgid / nig, fm = gid * WGM, gsz = (nM - fm) < WGM ? (nM - fm) : WGM;
        u.pm = fm + ((wgid % nig) % gsz); u.pn = (wgid % nig) / gsz; return true;
    }
    __device__ __forceinline__ void a_ready(const Unit&) const {}
    __device__ __forceinline__ void done(const Unit&) const {}
};

struct EpiF16 {
    static constexpr bool PERM = true, AFTER_DRAIN = false;
    _Float16* O; int Mrows; float qscale;
    __device__ __forceinline__ void operator()(const f32x4 (&acc)[2][2][4][2], const Unit& u, int wr, int wc, int fr, int fq) const {
        const int row0 = u.pm * BM + wr * 64 + fr, d0 = wc * 32 + 8 * fq;
        const float s = (u.pn < 4 || (u.pn >= 16 && u.pn < 20)) ? qscale : 1.0f;
#pragma unroll
        for (int bj = 0; bj < 2; ++bj) { _Float16* slot = O + (size_t)(2 * u.pn + bj) * Mrows * 128 + d0;
#pragma unroll
            for (int ai = 0; ai < 2; ++ai)
#pragma unroll
                for (int m = 0; m < 4; ++m) { const f32x4 v0 = acc[ai][bj][m][0] * s, v1 = acc[ai][bj][m][1] * s;
                    bf16x8 w; w[0] = (_Float16)v0[0]; w[1] = (_Float16)v0[1]; w[2] = (_Float16)v0[2]; w[3] = (_Float16)v0[3]; w[4] = (_Float16)v1[0]; w[5] = (_Float16)v1[1]; w[6] = (_Float16)v1[2]; w[7] = (_Float16)v1[3];
                    *(bf16x8*)(slot + (size_t)(row0 + ai * HALF + m * 16) * 128) = w; } }
    }
};
struct EpiResF32 {
    static constexpr bool PERM = false, AFTER_DRAIN = false;
    const float* resid; float* C; int ldc; float* ssq;
    __device__ __forceinline__ void operator()(const f32x4 (&acc)[2][2][4][2], const Unit& u, int wr, int wc, int fr, int fq) const {
        const int row0 = u.pm * BM + wr * 64 + fr, col0 = u.pn * BM + wc * 32 + 4 * fq;
#pragma unroll
        for (int ai = 0; ai < 2; ++ai)
#pragma unroll
            for (int m = 0; m < 4; ++m) { const int row = row0 + ai * HALF + m * 16; const size_t off = (size_t)row * ldc + col0; float q = 0.f;
#pragma unroll
                for (int bj = 0; bj < 2; ++bj)
#pragma unroll
                    for (int n = 0; n < 2; ++n) { const f32x4 h = *(const f32x4*)(resid + off + bj * HALF + n * 16) + acc[ai][bj][m][n]; *(f32x4*)(C + off + bj * HALF + n * 16) = h;
                        q += (h[0] * h[0] + h[1] * h[1]) + (h[2] * h[2] + h[3] * h[3]); }
                q += __shfl_xor(q, 16); q += __shfl_xor(q, 32);
                if (fq == 0) ssq[(size_t)row * 32 + 4 * u.pn + wc] = q; }
    }
};
template <class Epi, class Sched, bool ALIGN_EPI = false, bool SP2 = false>
__device__ __forceinline__ void gemm_phase(PG8_LAS unsigned char* lds, const Gemm g, const Sched& S, const Epi& E) {
    const int tid = threadIdx.x, wid = __builtin_amdgcn_readfirstlane(tid >> 6), lane = tid & 63, wr = wid >> 2, wc = wid & 3, fr = lane & 15, fq = lane >> 4;
    const int K = g.K, nt = K / BK;
    unsigned voffA[2], voffB[2];
#pragma unroll
    for (int i = 0; i < 2; ++i) { int R, C; stage_rc(tid * 16 + i * 8192, R, C); const int Rb = Epi::PERM ? ((R & ~31) + perm32(R & 31)) : R;
        voffA[i] = (unsigned)(R * K + C) * 2u; voffB[i] = (unsigned)(Rb * K + C) * 2u; }
    const size_t kstep = (size_t)(BK * 2);
    const size_t hstep = (size_t)HALF * K * 2;
    const size_t tstep = 2 * hstep;
    const unsigned ldsw = (unsigned)wid * 1024u;
    const int aoff = lds_byte(wr * 64 + fr, fq * 8), boff = lds_byte(wc * 32 + fr, fq * 8);
#define PG8_SA(b, h) (((b) * 2 + (h)) * HTB)
#define PG8_SB(b, h) ((4 + (b) * 2 + (h)) * HTB)
#define PG8_STAGE(bufoff, gbase, voff) do { _Pragma("unroll") for (int _i = 0; _i < 2; ++_i) \
        __builtin_amdgcn_global_load_lds((const unsigned*)((const char*)(gbase) + (voff)[_i]), (PG8_LAS unsigned*)(lds + (bufoff) + ldsw + _i * 8192), 16, 0, 0); } while (0)
#define PG8_LDA(dst, b, h) do { _Pragma("unroll") for (int m = 0; m < 4; ++m) _Pragma("unroll") for (int k = 0; k < 2; ++k) dst[m][k] = *(const PG8_LAS bf16x8*)(lds + PG8_SA(b, h) + aoff + m * 2048 + k * 1024); } while (0)
#define PG8_LDB(dst, b, h) do { _Pragma("unroll") for (int n = 0; n < 2; ++n) _Pragma("unroll") for (int k = 0; k < 2; ++k) dst[n][k] = *(const PG8_LAS bf16x8*)(lds + PG8_SB(b, h) + boff + n * 2048 + k * 1024); } while (0)
#define PG8_MMA(ai, bj, At, Bt) do { __builtin_amdgcn_s_setprio(1); _Pragma("unroll") for (int m = 0; m < 4; ++m) _Pragma("unroll") for (int n = 0; n < 2; ++n) _Pragma("unroll") for (int k = 0; k < 2; ++k) \
        acc[ai][bj][m][n] = __builtin_amdgcn_mfma_f32_16x16x32_f16(Bt[n][k], At[m][k], acc[ai][bj][m][n], 0, 0, 0); __builtin_amdgcn_s_setprio(0); } while (0)
#define PG8_WAIT_V(n) asm volatile("s_waitcnt vmcnt(" #n ")" ::: "memory")
#define PG8_WAIT_L(n) asm volatile("s_waitcnt lgkmcnt(" #n ")" ::: "memory")
#define PG8_BAR __builtin_amdgcn_s_barrier()
#define PG8_SCHED __builtin_amdgcn_sched_barrier(0)
    Unit cur, nxt; int ui = 0;
    if (!S.next(0, cur)) return;
    f32x4 acc[2][2][4][2];
#pragma unroll
    for (int a = 0; a < 2; ++a)
#pragma unroll
        for (int b = 0; b < 2; ++b)
#pragma unroll
            for (int m = 0; m < 4; ++m)
#pragma unroll
                for (int n = 0; n < 2; ++n) acc[a][b][m][n] = (f32x4){0.f, 0.f, 0.f, 0.f};
    bf16x8 At[4][2], B0[2][2], B1[2][2];
    const char* cA = (const char*)g.A + (size_t)cur.pm * tstep; const char* cB = (const char*)g.Bt + (size_t)cur.pn * tstep;
    S.a_ready(cur);
    if constexpr (SP2) {
        PG8_STAGE(PG8_SB(0, 0), cB, voffB); PG8_STAGE(PG8_SB(0, 1), cB + hstep, voffB); PG8_STAGE(PG8_SA(0, 0), cA, voffA); PG8_STAGE(PG8_SA(0, 1), cA + hstep, voffA);
        if (wr == 1) PG8_BAR;
        PG8_WAIT_V(2); PG8_BAR;
        PG8_STAGE(PG8_SB(1, 0), cB + kstep, voffB); PG8_STAGE(PG8_SA(1, 0), cA + kstep, voffA); PG8_STAGE(PG8_SB(1, 1), cB + hstep + kstep, voffB);
        PG8_WAIT_V(6); PG8_BAR;
    } else {
        PG8_STAGE(PG8_SB(0, 0), cB, voffB); PG8_STAGE(PG8_SA(0, 0), cA, voffA); PG8_STAGE(PG8_SB(0, 1), cB + hstep, voffB); PG8_STAGE(PG8_SA(0, 1), cA + hstep, voffA);
        if (wr == 1) PG8_BAR;
        PG8_WAIT_V(4); PG8_BAR;
        PG8_STAGE(PG8_SB(1, 0), cB + kstep, voffB); PG8_STAGE(PG8_SA(1, 0), cA + kstep, voffA); PG8_STAGE(PG8_SB(1, 1), cB + hstep + kstep, voffB);
        PG8_WAIT_V(6); PG8_BAR;
    }
    for (;;) {
        const bool has_next = S.next(ui + 1, nxt);
        const char* nA = has_next ? (const char*)g.A + (size_t)nxt.pm * tstep : cA; const char* nB = has_next ? (const char*)g.Bt + (size_t)nxt.pn * tstep : cB;
        for (int t = 0; t < nt; t += 2) {
            const bool last = (t == nt - 2);
            const char* a1 = cA + (size_t)(t + 1) * kstep;
            const char* a2 = last ? nA : cA + (size_t)(t + 2) * kstep; const char* b2 = last ? nB : cB + (size_t)(t + 2) * kstep;
            const char* a3 = a2 + kstep; const char* b3 = b2 + kstep;
            if (last && has_next) S.a_ready(nxt);
            if constexpr (SP2) {
            PG8_LDB(B0, 0, 0); PG8_LDB(B1, 0, 1); PG8_SCHED; PG8_LDA(At, 0, 0); PG8_STAGE(PG8_SA(1, 1), a1 + hstep, voffA);
            PG8_WAIT_V(8); PG8_WAIT_L(0); PG8_BAR; PG8_MMA(0, 0, At, B0); PG8_MMA(0, 1, At, B1); PG8_BAR; PG8_SCHED;
            PG8_LDA(At, 0, 1); PG8_STAGE(PG8_SB(0, 0), b2, voffB); PG8_STAGE(PG8_SB(0, 1), b2 + hstep, voffB); PG8_STAGE(PG8_SA(0, 0), a2, voffA);
            PG8_WAIT_V(8); PG8_WAIT_L(0); PG8_BAR; PG8_MMA(1, 0, At, B0); PG8_MMA(1, 1, At, B1); PG8_BAR; PG8_SCHED;
            PG8_LDB(B0, 1, 0); PG8_LDB(B1, 1, 1); PG8_SCHED; PG8_LDA(At, 1, 0); PG8_STAGE(PG8_SA(0, 1), a2 + hstep, voffA);
            PG8_WAIT_V(8); PG8_WAIT_L(0); PG8_BAR; PG8_MMA(0, 0, At, B0); PG8_MMA(0, 1, At, B1); PG8_BAR; PG8_SCHED;
            PG8_LDA(At, 1, 1); PG8_STAGE(PG8_SB(1, 0), b3, voffB); PG8_STAGE(PG8_SB(1, 1), b3 + hstep, voffB); PG8_STAGE(PG8_SA(1, 0), a3, voffA);
            PG8_WAIT_V(8); PG8_WAIT_L(0); PG8_BAR; PG8_MMA(1, 0, At, B0); PG8_MMA(1, 1, At, B1); PG8_BAR; PG8_SCHED;
            } else {
            PG8_LDB(B0, 0, 0); PG8_SCHED; PG8_LDA(At, 0, 0); PG8_STAGE(PG8_SA(1, 1), a1 + hstep, voffA);
            PG8_WAIT_L(8); PG8_BAR; PG8_WAIT_L(0); PG8_MMA(0, 0, At, B0); PG8_BAR; PG8_SCHED;
            PG8_LDB(B1, 0, 1); PG8_STAGE(PG8_SB(0, 0), b2, voffB);
            PG8_BAR; PG8_WAIT_L(0); PG8_MMA(0, 1, At, B1); PG8_BAR;
            PG8_LDA(At, 0, 1); PG8_STAGE(PG8_SA(0, 0), a2, voffA);
            PG8_BAR; PG8_WAIT_L(0); PG8_MMA(1, 0, At, B0); PG8_BAR; PG8_SCHED;
            PG8_STAGE(PG8_SB(0, 1), b2 + hstep, voffB);
            PG8_WAIT_V(6); PG8_BAR; PG8_MMA(1, 1, At, B1); PG8_BAR;
            PG8_LDB(B0, 1, 0); PG8_SCHED; PG8_LDA(At, 1, 0); PG8_STAGE(PG8_SA(0, 1), a2 + hstep, voffA);
            PG8_WAIT_L(8); PG8_BAR; PG8_WAIT_L(0); PG8_MMA(0, 0, At, B0); PG8_BAR; PG8_SCHED;
            PG8_LDB(B1, 1, 1); PG8_STAGE(PG8_SB(1, 0), b3, voffB);
            PG8_BAR; PG8_WAIT_L(0); PG8_MMA(0, 1, At, B1); PG8_BAR;
            PG8_LDA(At, 1, 1); PG8_STAGE(PG8_SA(1, 0), a3, voffA);
            PG8_BAR; PG8_WAIT_L(0); PG8_MMA(1, 0, At, B0); PG8_BAR; PG8_SCHED;
            PG8_STAGE(PG8_SB(1, 1), b3 + hstep, voffB);
            PG8_WAIT_V(6); PG8_BAR; PG8_MMA(1, 1, At, B1); PG8_BAR;
            }
        }
        if constexpr (ALIGN_EPI) { if (wr == 0) PG8_BAR; }
        if constexpr (!Epi::AFTER_DRAIN) { E(acc, cur, wr, wc, fr, fq); S.done(cur); }
        if (!has_next) break;
#pragma unroll
        for (int a = 0; a < 2; ++a)
#pragma unroll
            for (int b = 0; b < 2; ++b)
#pragma unroll
                for (int m = 0; m < 4; ++m)
#pragma unroll
                    for (int n = 0; n < 2; ++n) acc[a][b][m][n] = (f32x4){0.f, 0.f, 0.f, 0.f};
        cur = nxt; cA = nA; cB = nB; ++ui;
        if constexpr (ALIGN_EPI) { if (wr == 1) PG8_BAR; }
    }
    PG8_WAIT_V(0);
    if constexpr (!ALIGN_EPI) { if (wr == 0) PG8_BAR; }
    PG8_BAR;
    if constexpr (Epi::AFTER_DRAIN) { E.fused(acc, cur, wr, wc, fr, fq, lds, wid, lane); S.done(cur); }
#undef PG8_SA
#undef PG8_SB
#undef PG8_STAGE
#undef PG8_LDA
#undef PG8_LDB
#undef PG8_MMA
#undef PG8_WAIT_V
#undef PG8_WAIT_L
#undef PG8_BAR
#undef PG8_SCHED
}
}

#define GAS __attribute__((address_space(1)))
#define LAS __attribute__((address_space(3)))
typedef unsigned v4u __attribute__((ext_vector_type(4)));
#define LDS_WAIT() asm volatile("s_waitcnt lgkmcnt(0)" ::: "memory")
#define VM_WAIT() asm volatile("s_waitcnt vmcnt(0)" ::: "memory")
constexpr int NWAVES = 8, NTHR = NWAVES * 64;
constexpr int RING_OFF = 0, RING_BYTES = 157696;
constexpr int LDSCTL_OFF = RING_BYTES, MISC_OFF = LDSCTL_OFF + 320;
constexpr int LDS_BYTES = 158720;
constexpr int CW_BAR = 4096;
constexpr size_t CTL_ZERO_BYTES = 65536;

#define XB_TMO      128
#define XB_XCNT(j)  (256  + 64 * (j))
#define XB_XSUB(j)  (1280 + 64 * (j))
#define XB_XGEN(j)  (2304 + 64 * (j))
#define XB_TOP      3328
#define XB_TOPGEN   3392
#define XCD_BAR_WORDS 3456
#define XB_SPIN_CAP (1u << 18)

__device__ __forceinline__ unsigned xb_ld(unsigned* p)              { return __hip_atomic_load(p, __ATOMIC_RELAXED, __HIP_MEMORY_SCOPE_AGENT); }
__device__ __forceinline__ unsigned xb_add(unsigned* p, unsigned v) { return __hip_atomic_fetch_add(p, v, __ATOMIC_RELAXED, __HIP_MEMORY_SCOPE_AGENT); }
__device__ __forceinline__ unsigned xb_xcc_id() { return (unsigned)__builtin_amdgcn_s_getreg((3 << 11) | 20) & 0xFu; }
#define XB_SPIN(cond, bar) do { unsigned _sp = 0; while (cond) { __builtin_amdgcn_s_sleep(1); \
    if ((++_sp & 255u) == 0u) { if (xb_ld(&(bar)[XB_TMO])) break; if (_sp > XB_SPIN_CAP) { atomicAdd(&(bar)[XB_TMO], 1u); break; } } } } while (0)

struct XcdBarrier {
    unsigned* bar; unsigned x;
    volatile LAS unsigned* st;
};

__device__ __forceinline__ XcdBarrier xcd_barrier_post(unsigned* bar, volatile LAS unsigned* st) {
    XcdBarrier b; b.bar = bar; b.x = xb_xcc_id(); b.st = st;
    if (threadIdx.x == 0) (void)xb_add(&bar[XB_XCNT(b.x)], 1u);
    return b;
}
__device__ __forceinline__ void xcd_barrier_complete(unsigned* bar, unsigned x, unsigned& nloc, unsigned& nx) {
    const unsigned G = gridDim.x * gridDim.y * gridDim.z;
    unsigned sum, cnt, mine, sp = 0u;
    for (;;) {
        sum = 0u; cnt = 0u; mine = 0u;
#pragma unroll
        for (unsigned j = 0; j < 16; ++j) { const unsigned c = xb_ld(&bar[XB_XCNT(j)]); sum += c; cnt += (c > 0u) ? 1u : 0u; mine = (j == x) ? c : mine; }
        if (sum == G) break;
        __builtin_amdgcn_s_sleep(1);
        if ((++sp & 255u) == 0u) { if (xb_ld(&bar[XB_TMO])) break; if (sp > XB_SPIN_CAP) { atomicAdd(&bar[XB_TMO], 1u); break; } }
    }
    nloc = mine > 0u ? mine : 1u; nx = cnt > 0u ? cnt : 1u;
}

__device__ __forceinline__ void xcd_barrier(const XcdBarrier& b) {
    asm volatile("s_waitcnt vmcnt(0)" ::: "memory");
    __syncthreads();
    if (threadIdx.x == 0) {
        unsigned* bar = b.bar;
        __builtin_amdgcn_s_waitcnt(0);
        unsigned nloc = b.st[0], nx = b.st[1];
        if (nloc == 0u) { xcd_barrier_complete(bar, b.x, nloc, nx); b.st[0] = nloc; b.st[1] = nx; }
        const unsigned old = xb_add(&bar[XB_XSUB(b.x)], 1u);
        const unsigned gen = old / nloc;
        if (old + 1u == (gen + 1u) * nloc) {
            __builtin_amdgcn_fence(__ATOMIC_RELEASE, "agent");
            asm volatile("s_waitcnt vmcnt(0)" ::: "memory");
            const unsigned og = xb_add(&bar[XB_TOP], 1u);
            const unsigned tg = og / nx;
            if (og + 1u == (tg + 1u) * nx) xb_add(&bar[XB_TOPGEN], 1u);
            else XB_SPIN(xb_ld(&bar[XB_TOPGEN]) == tg, bar);
            __builtin_amdgcn_fence(__ATOMIC_ACQUIRE, "agent");
            xb_add(&bar[XB_XGEN(b.x)], 1u);
            asm volatile("s_waitcnt vmcnt(0)" ::: "memory");
        } else {
            XB_SPIN(xb_ld(&bar[XB_XGEN(b.x)]) == gen, bar);
            __builtin_amdgcn_fence(__ATOMIC_ACQUIRE, "agent");
            asm volatile("s_waitcnt vmcnt(0)" ::: "memory");
        }
    }
    __syncthreads();
}

static_assert((CW_BAR + XCD_BAR_WORDS) * 4 <= (int)CTL_ZERO_BYTES, "barrier words inside the memset region");

__device__ __forceinline__ unsigned pk2h(float lo, float hi) { typedef _Float16 h2 __attribute__((ext_vector_type(2))); h2 v; v[0] = (_Float16)lo; v[1] = (_Float16)hi; return __builtin_bit_cast(unsigned, v); }

__device__ __forceinline__ void p0_transpose_item(const float* W, int K, int ldw, bool remap, h16* WT, LAS float* scr, int item, int nblk, int lane) {
    const int kb = item / nblk, nb = item % nblk, k0 = 64 * kb, n0 = 32 * nb;
    const int n = n0 + (lane & 31), sc = remap ? src_col(n) : n;
#pragma unroll 8
    for (int i = 0; i < 32; ++i) { const int kk = 2 * i + (lane >> 5); scr[kk * 33 + (lane & 31)] = sc >= 0 ? W[(size_t)(k0 + kk) * ldw + sc] : 0.f; }
    LDS_WAIT(); asm volatile("" ::: "memory");
    const int c = lane & 7;
#pragma unroll
    for (int j = 0; j < 4; ++j) { const int nn = (lane >> 3) + 8 * j; const LAS float* s = scr + (8 * c) * 33 + nn;
        v4u o; o.x = pk2h(s[0 * 33], s[1 * 33]); o.y = pk2h(s[2 * 33], s[3 * 33]); o.z = pk2h(s[4 * 33], s[5 * 33]); o.w = pk2h(s[6 * 33], s[7 * 33]);
        *(GAS v4u*)(WT + (size_t)(n0 + nn) * K + k0 + 8 * c) = o; }
    LDS_WAIT(); asm volatile("" ::: "memory");
}
typedef float f32x4v __attribute__((ext_vector_type(4)));
typedef float float4v __attribute__((ext_vector_type(4)));
typedef unsigned u32x2v __attribute__((ext_vector_type(2)));
template <int NR>
__device__ __forceinline__ void p0_rms_rows(const float* x0, const float* g, h16* o0, int lane) {
    f32x4v v[NR][8]; float s[NR];
#pragma unroll
    for (int r = 0; r < NR; ++r) { const f32x4v* xr = (const f32x4v*)(x0 + (size_t)r * D) + lane; s[r] = 0.f;
#pragma unroll
        for (int j = 0; j < 8; ++j) v[r][j] = __builtin_nontemporal_load(xr + 64 * j); }
#pragma unroll
    for (int r = 0; r < NR; ++r) {
#pragma unroll
        for (int j = 0; j < 8; ++j) s[r] += (v[r][j][0] * v[r][j][0] + v[r][j][1] * v[r][j][1]) + (v[r][j][2] * v[r][j][2] + v[r][j][3] * v[r][j][3]);
        s[r] = rsqrtf(wave_sum(s[r]) * (1.f / D) + RMS_EPS); }
    const f32x4v* gr = (const f32x4v*)g + lane;
#pragma unroll
    for (int j = 0; j < 8; ++j) { const f32x4v gg = gr[64 * j];
#pragma unroll
        for (int r = 0; r < NR; ++r) { u32x2v w; w[0] = pk2h(v[r][j][0] * s[r] * gg[0], v[r][j][1] * s[r] * gg[1]); w[1] = pk2h(v[r][j][2] * s[r] * gg[2], v[r][j][3] * s[r] * gg[3]);
            ((u32x2v*)(o0 + (size_t)r * D) + lane)[64 * j] = w; } }
}

typedef _Float16 h16x2 __attribute__((ext_vector_type(2)));
typedef _Float16 h16x4 __attribute__((ext_vector_type(4)));
typedef _Float16 h16x8 __attribute__((ext_vector_type(8)));
typedef short s16x4 __attribute__((ext_vector_type(4)));
typedef float f32x16 __attribute__((ext_vector_type(16)));
constexpr int KPITCH = 272, VPITCH = 320;
constexpr int AT_V = 64 * KPITCH, AT_BUF = AT_V + 64 * VPITCH;
__device__ __forceinline__ h16x4 tr_read(LAS unsigned char* p) { return __builtin_bit_cast(h16x4, __builtin_amdgcn_ds_read_tr16_b64_v4i16((LAS s16x4*)p)); }
__device__ __forceinline__ int crow(int i, int h) { return (i & 3) + 8 * (i >> 2) + 4 * h; }
__device__ __forceinline__ void tile_gload(const h16* gK, const h16* gV, unsigned pitch, v4u (&kr)[2], v4u (&vr)[2], int tid) {
    asm volatile("" : "+v"(tid));
#pragma unroll
    for (int i = 0; i < 2; ++i) { const unsigned cidx = tid + 512 * i, boff = ((cidx >> 4) * pitch + (cidx & 15) * 8) * 2u;
        kr[i] = *(const v4u*)((const char*)gK + boff); vr[i] = *(const v4u*)((const char*)gV + boff); }
}
__device__ __forceinline__ void tile_lstore(LAS unsigned char* buf, const v4u (&kr)[2], const v4u (&vr)[2], int tid) {
    asm volatile("" : "+v"(tid));
#pragma unroll
    for (int i = 0; i < 2; ++i) { const int cidx = tid + 512 * i, row = cidx >> 4, ch = cidx & 15; *(LAS v4u*)(buf + row * KPITCH + ch * 16) = kr[i]; *(LAS v4u*)(buf + AT_V + row * VPITCH + ch * 16) = vr[i]; }
}
__device__ __forceinline__ f32x16 qk_block(LAS unsigned char* KT, int kb, const h16x8 (&qf)[8], int lane) {
    f32x16 sacc;
#pragma unroll
    for (int i = 0; i < 16; ++i) sacc[i] = 0.f;
    LAS unsigned char* base = KT + (lane & 31) * KPITCH + (lane >> 5) * 16;
    h16x8 kf[8];
#pragma unroll
    for (int s = 0; s < 8; ++s) kf[s] = *(const LAS h16x8*)(base + kb * 32 * KPITCH + 32 * s);
    __builtin_amdgcn_sched_barrier(0);
#pragma unroll
    for (int s = 0; s < 8; ++s) sacc = __builtin_amdgcn_mfma_f32_32x32x16_f16(kf[s], qf[s], sacc, 0, 0, 0);
    return sacc;
}
__device__ __forceinline__ void pv_block(LAS unsigned char* VT, int kb, const h16x8 (&pf)[2], f32x16 (&oacc)[4], int lane) {
    const int h = lane >> 5, blk = (lane >> 4) & 1, q = (lane & 15) >> 2, p = lane & 3;
    LAS unsigned char* base = VT + (4 * h + q) * VPITCH + 32 * blk + 8 * p;
    h16x4 lo[4][2], hi[4][2];
#pragma unroll
    for (int c = 0; c < 2; ++c)
#pragma unroll
        for (int s = 0; s < 2; ++s) { lo[c][s] = tr_read(base + (kb * 32 + 16 * s) * VPITCH + 64 * c); hi[c][s] = tr_read(base + (kb * 32 + 16 * s + 8) * VPITCH + 64 * c); }
    __builtin_amdgcn_sched_barrier(0);
#pragma unroll
    for (int c = 2; c < 4; ++c)
#pragma unroll
        for (int s = 0; s < 2; ++s) { lo[c][s] = tr_read(base + (kb * 32 + 16 * s) * VPITCH + 64 * c); hi[c][s] = tr_read(base + (kb * 32 + 16 * s + 8) * VPITCH + 64 * c); }
    __builtin_amdgcn_sched_barrier(0);
#pragma unroll
    for (int c = 0; c < 4; ++c)
#pragma unroll
        for (int s = 0; s < 2; ++s) {
            const h16x8 vf = __builtin_shufflevector(lo[c][s], hi[c][s], 0, 1, 2, 3, 4, 5, 6, 7);
            oacc[c] = __builtin_amdgcn_mfma_f32_32x32x16_f16(vf, pf[s], oacc[c], 0, 0, 0);
        }
}
__device__ __forceinline__ float lane_partner(float x) {
    const auto r = __builtin_amdgcn_permlane32_swap(__builtin_bit_cast(unsigned, x), __builtin_bit_cast(unsigned, x), false, false);
    return __builtin_bit_cast(float, (threadIdx.x & 32) ? r[0] : r[1]);
}
template <bool DIAG>
__device__ __forceinline__ void sb_weights(const f32x16& sacc, h16x8 (&pf)[2], float& C, int lane, int pos0, int t) {
    const int h = lane >> 5;
    float E[16], T[4], m1[4], m2[4], f0[4];
#pragma unroll
    for (int i = 0; i < 16; ++i) { float e = __builtin_amdgcn_exp2f(fminf(sacc[i], 24.f)); if (DIAG) e = (pos0 + crow(i, h) < t) ? e : 0.f; E[i] = e; }
#pragma unroll
    for (int g = 0; g < 4; ++g) { f0[g] = 1.f + E[4 * g]; m1[g] = f0[g] * (1.f + E[4 * g + 1]); m2[g] = m1[g] * (1.f + E[4 * g + 2]); T[g] = m2[g] * (1.f + E[4 * g + 3]); }
    float U[4], TPs[4];
#pragma unroll
    for (int g = 0; g < 4; ++g) { const float tp = lane_partner(T[g]); U[g] = T[g] * tp; TPs[g] = h ? 1.f : tp; }
    float V[4]; V[3] = C; V[2] = V[3] * U[3]; V[1] = V[2] * U[2]; V[0] = V[1] * U[1]; C = V[0] * U[0];
    float a[16];
#pragma unroll
    for (int g = 0; g < 4; ++g) { const float r = __builtin_amdgcn_rcpf(T[g] * (V[g] * TPs[g]));
        a[4 * g] = E[4 * g] * r; a[4 * g + 1] = E[4 * g + 1] * (r * f0[g]); a[4 * g + 2] = E[4 * g + 2] * (r * m1[g]); a[4 * g + 3] = E[4 * g + 3] * (r * m2[g]); }
#pragma unroll
    for (int s = 0; s < 2; ++s)
#pragma unroll
        for (int j = 0; j < 8; ++j) pf[s][j] = (_Float16)a[8 * s + j];
}
__device__ __forceinline__ void sb_attn_unit(LAS unsigned char* lds, const h16* PROJ, const float* gsb, h16* OG, float* SSQ16, int b, int head, int qt, int tid, int lane, int wave) {
    const int h = lane >> 5, n = lane & 31, q0 = 256 * qt + 32 * wave, t = q0 + n;
    const unsigned mrow = (unsigned)b * S + t;
    const unsigned prow = mrow * 256u;
    h16x8 qf[8];
#pragma unroll
    for (int s = 0; s < 8; ++s) qf[s] = *(const h16x8*)((const char*)PROJ + (size_t)(HS_SBQ + head) * SLOT_BYTES + prow + (16 * s + 8 * h) * 2);
    f32x16 oacc[4];
#pragma unroll
    for (int c = 0; c < 4; ++c)
#pragma unroll
        for (int i = 0; i < 16; ++i) oacc[c][i] = 0.f;
    float C = 1.f;
    const int jmax = 4 * qt + 3;
    const h16* gK = PROJ + ((size_t)(HS_SBK + head) * M + (size_t)b * S) * HD; const h16* gV = PROJ + ((size_t)(HS_SBV + head) * M + (size_t)b * S) * HD;
    v4u kr[2], vr[2];
    __syncthreads();
    tile_gload(gK + (size_t)(64 * jmax) * HD, gV + (size_t)(64 * jmax) * HD, (unsigned)HD, kr, vr, tid);
    tile_lstore(lds, kr, vr, tid);
    __syncthreads();
    for (int j = jmax; j >= 0; --j) {
        LAS unsigned char* buf = lds + ((jmax - j) & 1) * AT_BUF;
        if (j > 0) tile_gload(gK + (size_t)(64 * (j - 1)) * HD, gV + (size_t)(64 * (j - 1)) * HD, (unsigned)HD, kr, vr, tid);
#pragma unroll
        for (int kb = 1; kb >= 0; --kb) {
            const int pos0 = 64 * j + 32 * kb;
            if (pos0 < q0 + 31) {
                const f32x16 sacc = qk_block(buf, kb, qf, lane);
                h16x8 pf[2];
                if (pos0 + 31 >= q0) sb_weights<true>(sacc, pf, C, lane, pos0, t); else sb_weights<false>(sacc, pf, C, lane, pos0, t);
                pv_block(buf + AT_V, kb, pf, oacc, lane);
            }
        }
        if (j > 0) tile_lstore(lds + (((jmax - j) & 1) ^ 1) * AT_BUF, kr, vr, tid);
        __syncthreads();
    }
    float ss = 0.f;
#pragma unroll
    for (int c = 0; c < 4; ++c)
#pragma unroll
        for (int i = 0; i < 16; ++i) ss += oacc[c][i] * oacc[c][i];
    ss += lane_partner(ss);
    if (h == 0) *(float*)((char*)SSQ16 + (mrow * 16u + head) * 4u) = ss;
#pragma unroll
    for (int c = 0; c < 4; ++c)
#pragma unroll
        for (int g = 0; g < 4; ++g) {
            const int d0 = 32 * c + 8 * g + 4 * h;
            const h16x4 z4 = *(const h16x4*)((const char*)PROJ + (size_t)(HS_SBZ + head) * SLOT_BYTES + prow + d0 * 2); const f32x4v g4 = *(const f32x4v*)(gsb + head * HD + d0);
            h16x4 o4;
#pragma unroll
            for (int e = 0; e < 4; ++e) { const float z = (float)z4[e]; o4[e] = (_Float16)(oacc[c][4 * g + e] * g4[e] * (z / (1.f + __expf(-z)))); }
            *(h16x4*)((char*)OG + mrow * 4096u + (head * HD + d0) * 2) = o4;
        }
}


constexpr float LOG2E = 1.4426950408889634f;
constexpr int NS_BT = 2 * AT_BUF, NS_IMPG = NS_BT + 16384, NS_IMPL = NS_IMPG + 16384, NS_OFIN = NS_IMPG;
static_assert(NS_OFIN + 65536 <= 157696, "NSA LDS map");
constexpr int BT_SHIFT = 96;
template <int CTRL> __device__ __forceinline__ float dpp_f(float x) { return __builtin_bit_cast(float, __builtin_amdgcn_update_dpp(0, __builtin_bit_cast(int, x), CTRL, 0xf, 0xf, true)); }
__device__ __forceinline__ float quad_sum(float x) { x += dpp_f<0xB1>(x); x += dpp_f<0x4E>(x); return x; }
template <int MODE>
__device__ __forceinline__ unsigned nsa_scores(const f32x16& sacc, float (&sv)[16], const LAS float* BTr, float b31, int d0, int h, bool selbit, bool far) {
    unsigned vm = 0u;
    const LAS float* bp = BTr + 4 * (d0 + BT_SHIFT - 4 * h - 27);
#pragma unroll
    for (int i = 0; i < 16; ++i) {
        const int dist = d0 - (MODE == 0 ? 16 : 1) * crow(i, h);
        bool ok = dist >= 0; if (MODE == 2) ok = ok && selbit; if (MODE == 3) ok = ok && dist < 512;
        float bias;
        if (MODE == 0) bias = far ? b31 : BTr[4 * (min(max(dist, 0), 1023 - BT_SHIFT) + BT_SHIFT)];
        else bias = far ? b31 : bp[4 * (27 - (i & 3) - 8 * (i >> 2))];
        sv[i] = ok ? sacc[i] + bias : -1e30f; vm |= ok ? (1u << i) : 0u;
    }
    return vm;
}
__device__ __forceinline__ float max16(const float (&sv)[16]) {
    float a = fmaxf(fmaxf(sv[0], sv[1]), fmaxf(sv[2], sv[3])), b = fmaxf(fmaxf(sv[4], sv[5]), fmaxf(sv[6], sv[7])), c = fmaxf(fmaxf(sv[8], sv[9]), fmaxf(sv[10], sv[11])), d = fmaxf(fmaxf(sv[12], sv[13]), fmaxf(sv[14], sv[15]));
    return fmaxf(fmaxf(a, b), fmaxf(c, d));
}
__device__ __forceinline__ void online_step(const float (&sv)[16], unsigned vm, float& m, float& l, float (&pv)[16], f32x16 (&oacc)[4]) {
    float bm = max16(sv); bm = fmaxf(bm, lane_partner(bm));
    const float mn = fmaxf(m, bm), alpha = __builtin_amdgcn_exp2f(m - mn);
    float ps = 0.f;
#pragma unroll
    for (int i = 0; i < 16; ++i) { pv[i] = ((vm >> i) & 1u) ? __builtin_amdgcn_exp2f(sv[i] - mn) : 0.f; ps += pv[i]; }
    ps += lane_partner(ps);
    l = l * alpha + ps; m = mn;
#pragma unroll
    for (int c = 0; c < 4; ++c)
#pragma unroll
        for (int i = 0; i < 16; ++i) oacc[c][i] *= alpha;
}
__device__ __forceinline__ void pack_p(const float (&pv)[16], float scale, h16x8 (&pf)[2]) {
#pragma unroll
    for (int s = 0; s < 2; ++s)
#pragma unroll
        for (int j = 0; j < 8; ++j) pf[s][j] = (_Float16)(pv[8 * s + j] * scale);
}
#define NSA_LOOP_BEGIN(GK, GV, PITCH, J0, J1) { \
    const h16* _gk = (GK); const h16* _gv = (GV); const int _j0 = (J0), _j1 = (J1); const unsigned _pitch = (PITCH); v4u _kr[2], _vr[2]; \
    __syncthreads(); \
    tile_gload(_gk + (size_t)(64 * _j0) * _pitch, _gv + (size_t)(64 * _j0) * _pitch, _pitch, _kr, _vr, tid); tile_lstore(lds, _kr, _vr, tid); \
    __syncthreads(); \
    for (int j = _j0; j <= _j1; ++j) { LAS unsigned char* buf = lds + ((j - _j0) & 1) * AT_BUF; \
        if (j < _j1) tile_gload(_gk + (size_t)(64 * (j + 1)) * _pitch, _gv + (size_t)(64 * (j + 1)) * _pitch, _pitch, _kr, _vr, tid);
#define NSA_LOOP_END() \
        if (j < _j1) tile_lstore(lds + (((j - _j0) & 1) ^ 1) * AT_BUF, _kr, _vr, tid); \
        __syncthreads(); } }

__device__ __forceinline__ void nsa_unit(LAS unsigned char* lds, const h16* PROJ, const h16* KCC, const h16* VCC, const float* rel_bias, const float* gnsa, h16* OG, float* SSQ16,
                                         int b, int g, int cur, int tid, int lane, int wave) {
    const int h = lane >> 5, n = lane & 31, tl = n >> 2, r = n & 3, hh = 4 * g + r, tw0 = 64 * cur + 8 * wave, t = tw0 + tl;
    const unsigned mrow = (unsigned)b * S + t;
    const unsigned prow = mrow * 256u;
    LAS float* BT = (LAS float*)(lds + NS_BT); LAS float* IMPG = (LAS float*)(lds + NS_IMPG); LAS float* IMPL = (LAS float*)(lds + NS_IMPL);
    __syncthreads();
    for (int i = tid; i < 4096; i += NTHR) BT[i] = rel_bias[rel_bucket(max((i >> 2) - BT_SHIFT, 0)) * NHEAD + 4 * g + (i & 3)] * LOG2E;
    for (int i = tid; i < 8192; i += NTHR) IMPG[i] = 0.f;
    h16x8 qf[8];
#pragma unroll
    for (int s = 0; s < 8; ++s) qf[s] = *(const h16x8*)((const char*)PROJ + ((unsigned)(HS_NQ + hh) * SLOT_BYTES + prow + (16 * s + 8 * h) * 2));
#define NSA_GATE(k) (1.f / (1.f + __expf(-(float)*(const h16*)((const char*)PROJ + ((unsigned)HS_GATE * SLOT_BYTES + prow + (hh * 3 + (k)) * 2)))))
    f32x16 oacc[4];
    LAS unsigned char* OFIN = lds + NS_OFIN + wave * 8192 + lane * 16;
#pragma unroll
    for (int c = 0; c < 4; ++c)
#pragma unroll
        for (int i = 0; i < 16; ++i) oacc[c][i] = 0.f;
    __syncthreads();
    const LAS float* BTr = BT + r; const float b31 = BT[4 * 1023 + r];

    const h16* gKC = KCC + (size_t)(b * NG + g) * NCBP * HD; const h16* gVC = VCC + (size_t)(b * NG + g) * NCBP * HD;
    const int jc1 = (4 * cur + 2) >> 6;
    float mc = -1e30f, lc = 0.f;
    NSA_LOOP_BEGIN(gKC, gVC, HD, 0, jc1)
#pragma unroll
        for (int kb = 0; kb < 2; ++kb) {
            const int nb = 64 * j + 32 * kb;
            if (16 * nb + 31 <= tw0 + 7) {
                const f32x16 sacc = qk_block(buf, kb, qf, lane); float sv[16];
                const bool far = (tw0 - 31 - 16 * (nb + 31)) >= 790;
                const unsigned vm = nsa_scores<0>(sacc, sv, BTr, b31, t - 31 - 16 * nb, h, true, far);
                float bm = max16(sv); bm = fmaxf(bm, lane_partner(bm));
                const float mn = fmaxf(mc, bm), alpha = __builtin_amdgcn_exp2f(mc - mn); float ps = 0.f;
#pragma unroll
                for (int i = 0; i < 16; ++i) ps += ((vm >> i) & 1u) ? __builtin_amdgcn_exp2f(sv[i] - mn) : 0.f;
                ps += lane_partner(ps); lc = lc * alpha + ps; mc = mn;
            }
        }
    NSA_LOOP_END()
    const float invlc = lc > 0.f ? 1.f / lc : 0.f, g0 = NSA_GATE(0);
    NSA_LOOP_BEGIN(gKC, gVC, HD, 0, jc1)
#pragma unroll
        for (int kb = 0; kb < 2; ++kb) {
            const int nb = 64 * j + 32 * kb;
            if (16 * nb + 31 <= tw0 + 7) {
                const f32x16 sacc = qk_block(buf, kb, qf, lane); float sv[16], pv[16];
                const bool far = (tw0 - 31 - 16 * (nb + 31)) >= 790;
                const unsigned vm = nsa_scores<0>(sacc, sv, BTr, b31, t - 31 - 16 * nb, h, true, far);
#pragma unroll
                for (int i = 0; i < 16; ++i) pv[i] = ((vm >> i) & 1u) ? __builtin_amdgcn_exp2f(sv[i] - mc) * invlc : 0.f;
#pragma unroll
                for (int gq = 0; gq < 4; ++gq) {
                    const float gs = quad_sum((pv[4 * gq] + pv[4 * gq + 1]) + (pv[4 * gq + 2] + pv[4 * gq + 3])), ls = quad_sum(pv[4 * gq + 3]);
                    const int jsel = (nb >> 2) + 2 * gq + h;
                    if (r == 0) { IMPG[(8 * wave + tl) * 64 + jsel] = gs; if (jsel + 1 < 64) IMPL[(8 * wave + tl) * 64 + jsel + 1] = ls; }
                }
                h16x8 pf[2]; pack_p(pv, g0, pf);
                pv_block(buf + AT_V, kb, pf, oacc, lane);
            }
        }
    NSA_LOOP_END()
    unsigned sel_lo = 0u, sel_hi = 0u;
#pragma unroll 1
    for (int tk = 0; tk < 8; ++tk) {
        const int jb = lane; const float imp = IMPG[(8 * wave + tk) * 64 + jb] + IMPL[(8 * wave + tk) * 64 + jb];
        const bool valid = jb <= cur, forced = (jb == 0) || (jb == cur) || (jb == cur - 1);
        const unsigned key = (valid ? ((forced ? 0x4e6e6b28u   : __builtin_bit_cast(unsigned, imp)) & ~63u) : 0u) | (unsigned)(63 - jb);
        int rank = 0;
#pragma unroll
        for (int i = 0; i < 64; ++i) rank += ((unsigned)__builtin_amdgcn_readlane((int)key, i) > key) ? 1 : 0;
        const u64 mask = __ballot(rank < 16);
        if (tl == tk) { sel_lo = (unsigned)mask; sel_hi = (unsigned)(mask >> 32); }
    }
    __syncthreads();
#pragma unroll
    for (int c = 0; c < 4; ++c)
#pragma unroll
        for (int k = 0; k < 2; ++k) { h16x8 w;
#pragma unroll
            for (int e = 0; e < 8; ++e) w[e] = (_Float16)oacc[c][8 * k + e];
            *(LAS h16x8*)(OFIN + (2 * c + k) * 1024) = w; }
    {
#pragma unroll
        for (int c = 0; c < 4; ++c)
#pragma unroll
            for (int i = 0; i < 16; ++i) oacc[c][i] = 0.f;
        float m = -1e30f, l = 0.f;
        const h16* gK = PROJ + ((size_t)(HS_KS + g) * M + (size_t)b * S) * HD; const h16* gV = PROJ + ((size_t)(HS_VS + g) * M + (size_t)b * S) * HD;
        NSA_LOOP_BEGIN(gK, gV, HD, 0, cur)
            const bool selbit = (((j < 32) ? (sel_lo >> j) : (sel_hi >> (j - 32))) & 1u) != 0u;
            if (__any(selbit)) {
#pragma unroll
                for (int kb = 0; kb < 2; ++kb) {
                    const int pos0 = 64 * j + 32 * kb;
                    if (pos0 <= tw0 + 7) {
                        const f32x16 sacc = qk_block(buf, kb, qf, lane); float sv[16], pv[16];
                        const bool far = (tw0 - (pos0 + 31)) >= 790;
                        const unsigned vm = nsa_scores<2>(sacc, sv, BTr, b31, t - pos0, h, selbit, far);
                        online_step(sv, vm, m, l, pv, oacc);
                        h16x8 pf[2]; pack_p(pv, 1.f, pf);
                        pv_block(buf + AT_V, kb, pf, oacc, lane);
                    }
                }
            }
    NSA_LOOP_END()
        const float cs = NSA_GATE(1) / l;
#pragma unroll
        for (int c = 0; c < 4; ++c)
#pragma unroll
            for (int k = 0; k < 2; ++k) { h16x8 w = *(const LAS h16x8*)(OFIN + (2 * c + k) * 1024);
#pragma unroll
                for (int e = 0; e < 8; ++e) w[e] = (_Float16)((float)w[e] + cs * oacc[c][8 * k + e]);
                *(LAS h16x8*)(OFIN + (2 * c + k) * 1024) = w; }
    }
    {
#pragma unroll
        for (int c = 0; c < 4; ++c)
#pragma unroll
            for (int i = 0; i < 16; ++i) oacc[c][i] = 0.f;
        float m = -1e30f, l = 0.f;
        const h16* gK = PROJ + ((size_t)(HS_KW + g) * M + (size_t)b * S) * HD; const h16* gV = PROJ + ((size_t)(HS_VW + g) * M + (size_t)b * S) * HD;
        NSA_LOOP_BEGIN(gK, gV, HD, max(0, cur - 8), cur)
#pragma unroll
            for (int kb = 0; kb < 2; ++kb) {
                const int pos0 = 64 * j + 32 * kb;
                if (pos0 <= tw0 + 7 && (tw0 - (pos0 + 31)) < 512) {
                    const f32x16 sacc = qk_block(buf, kb, qf, lane); float sv[16], pv[16];
                    const unsigned vm = nsa_scores<3>(sacc, sv, BTr, b31, t - pos0, h, true, false);
                    online_step(sv, vm, m, l, pv, oacc);
                    h16x8 pf[2]; pack_p(pv, 1.f, pf);
                    pv_block(buf + AT_V, kb, pf, oacc, lane);
                }
            }
    NSA_LOOP_END()
        const float cs = NSA_GATE(2) / l;
#pragma unroll
        for (int c = 0; c < 4; ++c)
#pragma unroll
            for (int k = 0; k < 2; ++k) { const h16x8 w = *(const LAS h16x8*)(OFIN + (2 * c + k) * 1024);
#pragma unroll
                for (int e = 0; e < 8; ++e) oacc[c][8 * k + e] = (float)w[e] + cs * oacc[c][8 * k + e]; }
    }
    float ss = 0.f;
#pragma unroll
    for (int c = 0; c < 4; ++c)
#pragma unroll
        for (int i = 0; i < 16; ++i) ss += oacc[c][i] * oacc[c][i];
    ss += lane_partner(ss);
    if (h == 0) *(float*)((char*)SSQ16 + (mrow * 16u + 8 + hh) * 4u) = ss;
#pragma unroll
    for (int c = 0; c < 4; ++c)
#pragma unroll
        for (int gq = 0; gq < 4; ++gq) {
            const int d0 = 32 * c + 8 * gq + 4 * h;
            const h16x4 z4 = *(const h16x4*)((const char*)PROJ + ((unsigned)(HS_NZ + hh) * SLOT_BYTES + prow + d0 * 2)); const f32x4v g4 = *(const f32x4v*)(gnsa + hh * HD + d0);
            h16x4 o4;
#pragma unroll
            for (int e = 0; e < 4; ++e) { const float z = (float)z4[e]; o4[e] = (_Float16)(oacc[c][4 * gq + e] * g4[e] * (z / (1.f + __expf(-z)))); }
            *(h16x4*)((char*)OG + mrow * 4096u + (1024 + hh * HD + d0) * 2) = o4;
        }
}


constexpr int CP_PITCH = 272, CP_HID = 0, CP_HPITCH = 528;
static_assert(16 * 33 * CP_PITCH <= RING_BYTES, "compress LDS map");
__device__ __forceinline__ void compress_unit(LAS unsigned char* lds, const h16* PROJ, const h16* W1T, const h16* W2T, const float* PB, h16* out, int b, int g, int kv, int ch, int tid, int lane, int wave) {
    const int n0 = 32 * ch, h = lane >> 5, r = lane & 31;
    const h16* src = PROJ + ((size_t)((kv ? HS_VC : HS_KC) + g) * M + (size_t)(b * S + 16 * n0)) * HD;
    __syncthreads();
    for (int i = tid; i < 528 * 16; i += NTHR) {
        const int row = i >> 4, chn = i & 15; v4u v = {0u, 0u, 0u, 0u};
        if (16 * n0 + row < S) v = *(const v4u*)(src + row * HD + chn * 8);
        *(LAS v4u*)(lds + ((row & 15) * 33 + (row >> 4)) * CP_PITCH + chn * 16) = v;
    }
    __syncthreads();
    f32x16 acc;
#pragma unroll
    for (int i = 0; i < 16; ++i) acc[i] = 0.f;
    const h16* wrow = W1T + (size_t)(32 * wave + r) * 4096 + 8 * h;
    LAS unsigned char* abase = lds + r * CP_PITCH + h * 16;
#pragma unroll 2
    for (int l = 0; l < 32; ++l) {
        LAS unsigned char* ap = abase + ((l & 15) * 33 + (l >> 4)) * CP_PITCH;
#pragma unroll
        for (int s = 0; s < 8; ++s) {
            const h16x8 af = *(const LAS h16x8*)(ap + 32 * s), bf = *(const h16x8*)(wrow + l * 128 + 16 * s);
            acc = __builtin_amdgcn_mfma_f32_32x32x16_f16(af, bf, acc, 0, 0, 0);
        }
    }
    __syncthreads();
    { const int e = 32 * wave + r; float pb = 0.f;
#pragma unroll
      for (int k = 0; k < 32; ++k) pb += PB[(k * 2 + kv) * 256 + e];
#pragma unroll
      for (int i = 0; i < 16; ++i) { const float x = acc[i] + pb, u = 0.7978845608028654f * (x + 0.044715f * x * x * x);
          const float th = 1.f - 2.f / (1.f + __expf(2.f * u));
          *(LAS h16*)(lds + CP_HID + crow(i, h) * CP_HPITCH + e * 2) = (h16)(0.5f * x * (1.f + th)); } }
    __syncthreads();
    if (wave < 4) {
        f32x16 o;
#pragma unroll
        for (int i = 0; i < 16; ++i) o[i] = 0.f;
        const h16* w2row = W2T + (size_t)(32 * wave + r) * 256 + 8 * h;
        LAS unsigned char* hb = lds + CP_HID + r * CP_HPITCH + h * 16;
#pragma unroll
        for (int s = 0; s < 16; ++s) { const h16x8 af = *(const LAS h16x8*)(hb + 32 * s), bf = *(const h16x8*)(w2row + 16 * s); o = __builtin_amdgcn_mfma_f32_32x32x16_f16(af, bf, o, 0, 0, 0); }
        h16* dst = out + ((size_t)(b * NG + g) * NCBP + n0) * HD + 32 * wave + r;
#pragma unroll
        for (int i = 0; i < 16; ++i) { const int row = crow(i, h); dst[(size_t)row * HD] = (n0 + row < NCB) ? (h16)o[i] : (h16)0.f; }
    }
}

#ifndef PROBE_PHASE
#define PROBE_PHASE -1
#endif
#define NREP(k) ((PROBE_PHASE == (k)) ? 2 : 1)
struct Args { const float* in[14]; float* out; unsigned char* ws; int ph_lo, ph_hi; };

__global__ void __launch_bounds__(NTHR, 2) fwd(Args args) {
    extern __shared__ __attribute__((aligned(16))) unsigned char lds_raw[];
    LAS unsigned char* lds = (LAS unsigned char*)lds_raw;
    volatile LAS unsigned* MISC = (volatile LAS unsigned*)(lds + MISC_OFF);
    const int tid = threadIdx.x, lane = tid & 63, wave = __builtin_amdgcn_readfirstlane(tid >> 6);
    const int G = gridDim.x; const int bx = blockIdx.x; const int vcu = (G % 8 == 0) ? (bx % 8) * (G / 8) + bx / 8 : bx;
    unsigned char* ws = args.ws;
    unsigned* ctl = (unsigned*)(ws + WS_CTL);
    for (int u = tid; u < (LDS_BYTES - LDSCTL_OFF) / 4; u += NTHR) ((LAS unsigned*)(lds + LDSCTL_OFF))[u] = 0u;
    __syncthreads();
    XcdBarrier bar = xcd_barrier_post(ctl + CW_BAR, MISC + 8);
    const int lo = args.ph_lo, hi = args.ph_hi;
#define IN(k) (lo <= (k) && (k) < hi)
#define BOTH(k) (IN(k) && IN((k) + 1))
    h16* XN = (h16*)(ws + WS_XN); h16* WINT = (h16*)(ws + WS_WINT); h16* WOUTT = (h16*)(ws + WS_WOUTT); h16* PROJ = (h16*)(ws + WS_PROJ);

    if (IN(0)) for (int rep = 0; rep < NREP(0); ++rep) { if (rep) xcd_barrier(bar);
        LAS float* scr = (LAS float*)(lds + RING_OFF + wave * 16384);
        const int gw = vcu * NWAVES + wave, NGW = G * NWAVES;
        constexpr int I_IN = (D / 64) * (LDP / 32), I_OUT = (D / 64) * (D / 32), I_W1 = (4096 / 64) * (256 / 32), I_W2 = (256 / 64) * (128 / 32), I_PB = 2 * 32 * 4;
        h16* W1T = (h16*)(ws + WS_W1T); h16* W2T = (h16*)(ws + WS_W2T); float* PB = (float*)(ws + WS_PB);
        for (int it = gw; it < I_IN + I_OUT + 2 * I_W1 + 2 * I_W2 + I_PB; it += NGW) {
            int q = it;
            if (q < I_IN) { p0_transpose_item(args.in[2], D, NPROJ, true, WINT, scr, q, LDP / 32, lane); continue; } q -= I_IN;
            if (q < I_OUT) { p0_transpose_item(args.in[12], D, D, false, WOUTT, scr, q, D / 32, lane); continue; } q -= I_OUT;
            if (q < 2 * I_W1) { const int kv = q / I_W1; p0_transpose_item(args.in[kv ? 7 : 4], 4096, 256, false, W1T + (size_t)kv * 256 * 4096, scr, q % I_W1, 256 / 32, lane); continue; } q -= 2 * I_W1;
            if (q < 2 * I_W2) { const int kv = q / I_W2; p0_transpose_item(args.in[kv ? 8 : 5], 256, 128, false, W2T + (size_t)kv * 128 * 256, scr, q % I_W2, 128 / 32, lane); continue; } q -= 2 * I_W2;
            { const int kv = q & 1, ec = (q >> 1) & 3, kc = q >> 3;
              const float* pos = args.in[kv ? 6 : 3] + 128 * kc; const float* w1 = args.in[kv ? 7 : 4] + (size_t)(128 * kc) * 256 + 64 * ec + lane; float a[4] = {0.f, 0.f, 0.f, 0.f};
#pragma unroll 4
              for (int k = 0; k < 128; k += 4) {
#pragma unroll
                  for (int u = 0; u < 4; ++u) a[u] += pos[k + u] * w1[(size_t)(k + u) * 256]; }
              PB[(kc * 2 + kv) * 256 + 64 * ec + lane] = (a[0] + a[1]) + (a[2] + a[3]); }
        }
        for (int m = 4 * gw; m < M; m += 4 * NGW) p0_rms_rows<4>(args.in[0] + (size_t)m * D, args.in[1], XN + (size_t)m * D, lane);
        if (BOTH(0) && rep == NREP(0) - 1) xcd_barrier(bar);
    }
    if (IN(1)) for (int rep = 0; rep < NREP(1); ++rep) { if (rep) xcd_barrier(bar);
        pg8::Gemm g{(const pg8::bf16_t*)XN, (const pg8::bf16_t*)WINT, M, LDP, D}; pg8::StaticOrder SO; SO.init(M, LDP, G, bx);
        pg8::EpiF16 E{PROJ, M, QSCALE};
        pg8::gemm_phase<pg8::EpiF16, pg8::StaticOrder, true, true>(lds + RING_OFF, g, SO, E);
        if (BOTH(1) && rep == NREP(1) - 1) xcd_barrier(bar);
    }
    h16* OG = (h16*)(ws + WS_OG); float* SSQ16 = (float*)(ws + WS_SSQ16); h16* KCC = (h16*)(ws + WS_KCC); h16* VCC = (h16*)(ws + WS_VCC); float* SSQ = (float*)(ws + WS_SSQ);
    if (IN(2)) for (int rep = 0; rep < NREP(2); ++rep) { if (rep) xcd_barrier(bar);
        const h16* W1T = (const h16*)(ws + WS_W1T); const h16* W2T = (const h16*)(ws + WS_W2T); const float* PB = (const float*)(ws + WS_PB);
        for (int idx = vcu; idx < 256; idx += G) {
            const int ch = idx & 7, kv = (idx >> 3) & 1, g = (idx >> 4) & 1, b = idx >> 5;
            compress_unit(lds + RING_OFF, PROJ, W1T + (size_t)kv * 256 * 4096, W2T + (size_t)kv * 128 * 256, PB, kv ? VCC : KCC, b, g, kv, ch, tid, lane, wave);
        }
        if (BOTH(2) && rep == NREP(2) - 1) xcd_barrier(bar);
    }
    if (IN(3)) for (int rep = 0; rep < NREP(3); ++rep) { if (rep) xcd_barrier(bar);
        for (int idx = vcu; idx < 1024; idx += G) {
            const int r = idx >> 8, v = idx & 255, c = (v >> 3) & 3, bh = 8 * (v >> 5) + (v & 7);
            const int qt = (r == 0) ? 15 - c : (r == 1) ? 8 + c : (r == 2) ? 7 - c : c;
            sb_attn_unit(lds + RING_OFF, PROJ, args.in[10], OG, SSQ16, bh >> 3, bh & 7, qt, tid, lane, wave);
        }
    }
    if (IN(4)) for (int rep = 0; rep < NREP(4); ++rep) { if (rep) xcd_barrier(bar);
        for (int idx = vcu; idx < 1024; idx += G) {
            const int rr = idx >> 8, v = idx & 255, c = v & 15, bg = v >> 4;
            const int cur = (rr == 0) ? 63 - c : (rr == 1) ? 32 + c : (rr == 2) ? 31 - c : c;
            nsa_unit(lds + RING_OFF, PROJ, KCC, VCC, args.in[9], args.in[11], OG, SSQ16, bg >> 1, bg & 1, cur, tid, lane, wave);
        }
        if (BOTH(4) && rep == NREP(4) - 1) xcd_barrier(bar);
    }
    if (IN(5)) for (int rep = 0; rep < NREP(5); ++rep) { if (rep) xcd_barrier(bar);
        const int gw = vcu * NWAVES + wave, NGW = G * NWAVES;
        for (int m = gw; m < M; m += NGW) {
            const float4v sq = ((const float4v*)(SSQ16 + (size_t)m * 16))[lane & 3];
            float s4 = (sq[0] + sq[1]) + (sq[2] + sq[3]);
            s4 += __shfl_xor(s4, 1);
            const float r_sb = rsqrtf(__shfl(s4, 0) * (1.f / 1024.f) + RMS_EPS), r_ns = rsqrtf(__shfl(s4, 2) * (1.f / 1024.f) + RMS_EPS);
            const h16x8* src = (const h16x8*)(OG + (size_t)m * 2048); h16x8* dst = (h16x8*)(XN + (size_t)m * D);
#pragma unroll
            for (int k = 0; k < 4; ++k) { const int ci = lane + 64 * k; const float rr = (ci < 128) ? r_sb : r_ns; h16x8 v = src[ci];
#pragma unroll
                for (int e = 0; e < 8; ++e) v[e] = (_Float16)((float)v[e] * rr);
                dst[ci] = v; }
        }
        if (BOTH(5) && rep == NREP(5) - 1) xcd_barrier(bar);
    }
    if (IN(6)) for (int rep = 0; rep < NREP(6); ++rep) { if (rep) xcd_barrier(bar);
        pg8::Gemm g{(const pg8::bf16_t*)XN, (const pg8::bf16_t*)WOUTT, M, D, D}; pg8::StaticOrder SO; SO.init(M, D, G, bx);
        pg8::EpiResF32 E{args.in[0], args.out, D, SSQ};
        pg8::gemm_phase<pg8::EpiResF32, pg8::StaticOrder, true, true>(lds + RING_OFF, g, SO, E);
        if (BOTH(6) && rep == NREP(6) - 1) xcd_barrier(bar);
    }
    if (IN(7)) {
        const int gw = vcu * NWAVES + wave, NGW = G * NWAVES;
        for (int m0 = 2 * gw; m0 < M; m0 += 2 * NGW) {
            float4v v[2][8]; float r[2];
#pragma unroll
            for (int q = 0; q < 2; ++q) { const float4v* xr = (const float4v*)(args.out + (size_t)(m0 + q) * D) + lane;
#pragma unroll
                for (int j = 0; j < 8; ++j) v[q][j] = xr[64 * j];
                r[q] = (lane < 32) ? SSQ[(size_t)(m0 + q) * 32 + lane] : 0.f; }
#pragma unroll
            for (int q = 0; q < 2; ++q) r[q] = rsqrtf(wave_sum(r[q]) * (1.f / D) + RMS_EPS);
            const float4v* gr = (const float4v*)args.in[13] + lane;
#pragma unroll
            for (int j = 0; j < 8; ++j) { const float4v gg = gr[64 * j];
#pragma unroll
                for (int q = 0; q < 2; ++q) __builtin_nontemporal_store(v[q][j] * r[q] * gg, (float4v*)(args.out + (size_t)(m0 + q) * D) + lane + 64 * j); }
        }
    }
#undef IN
#undef BOTH
}

extern "C" void kernel_launch(void* const* d_in, const int* in_sizes, int n_in, void* d_out, int out_size, void* d_ws, size_t ws_size, hipStream_t stream) {
    static int grid = 0;
    if (grid == 0) {
        if (n_in != 14 || in_sizes[0] != M * D || out_size != M * D || ws_size < WS_END) { fprintf(stderr, "kernel_launch: unexpected shapes (n_in %d in0 %d out %d ws %zu need %zu)\n", n_in, n_in > 0 ? in_sizes[0] : -1, out_size, ws_size, (size_t)WS_END); grid = -1; return; }
        int dev = 0, cus = 0, per_cu = 0;
        if (hipGetDevice(&dev) != hipSuccess || hipDeviceGetAttribute(&cus, hipDeviceAttributeMultiprocessorCount, dev) != hipSuccess) { grid = -1; return; }
        if (hipFuncSetAttribute((const void*)fwd, hipFuncAttributeMaxDynamicSharedMemorySize, LDS_BYTES) != hipSuccess) { fprintf(stderr, "kernel_launch: hipFuncSetAttribute failed\n"); grid = -1; return; }
        if (hipOccupancyMaxActiveBlocksPerMultiprocessor(&per_cu, (const void*)fwd, NTHR, LDS_BYTES) != hipSuccess || per_cu < 1) { fprintf(stderr, "kernel_launch: occupancy query says %d blocks per CU\n", per_cu); grid = -1; return; }
        (void)hipGetLastError();
        grid = cus;
    }
    if (grid < 0) return;
    const float* x = (const float*)d_in[0];
    const float* kpos = (const float*)d_in[3]; const float* kw1 = (const float*)d_in[4]; const float* kw2 = (const float*)d_in[5];
    const float* vpos = (const float*)d_in[6]; const float* vw1 = (const float*)d_in[7]; const float* vw2 = (const float*)d_in[8];
    const float* rel_bias = (const float*)d_in[9]; const float* norm_sb = (const float*)d_in[10]; const float* norm_nsa = (const float*)d_in[11];
    const float* norm_final = (const float*)d_in[13];
    unsigned char* ws = (unsigned char*)d_ws; float* out = (float*)d_out;
    h16* XN = (h16*)(ws + WS_XN); h16* WOUTT = (h16*)(ws + WS_WOUTT); h16* PROJ = (h16*)(ws + WS_PROJ);
    h16* KCC = (h16*)(ws + WS_KCC); h16* VCC = (h16*)(ws + WS_VCC); u64* SEL = (u64*)(ws + WS_SEL); float* OC = (float*)(ws + WS_OC);
    float* ONSA = out + (size_t)M * 1024;

    (void)hipMemsetAsync(ws + WS_CTL, 0, CTL_ZERO_BYTES, stream);
    Args a{};
    for (int i = 0; i < 14; ++i) a.in[i] = (const float*)d_in[i];
    a.out = out; a.ws = ws; a.ph_lo = 0; a.ph_hi = 8;
    hipLaunchKernelGGL(fwd, dim3(grid), dim3(NTHR), LDS_BYTES, stream, a);
}
```
